# Optimizing an MI355X kernel written in HIP

```python
import jax, jax.numpy as jnp
from jax import lax
import numpy as np

D_MODEL = 1024
BATCH = 2
SEQ = 16384
DEPTH = 4

GRID_W = 64
CTX_LEN = 256
EPS = 1e-6

GROUP_DIM = 64
CONV_GROUPS = 4
CONV_W = CONV_GROUPS * GROUP_DIM
CONV_K = 3
SGU_GROUPS = 4
SGU_W = SGU_GROUPS * GROUP_DIM
CHUNK = 128
NA_HEADS = 8
NA_HEAD_DIM = GROUP_DIM
NA_W = NA_HEADS * NA_HEAD_DIM
NA_KH = 8
NA_KW = 16

MIX_W = CONV_W + SGU_W + NA_W
IN_W = 3 * CONV_W + 2 * SGU_W + 3 * NA_W

PEER_HEADS = 8
PEER_NKEYS = 128
PEER_N = PEER_NKEYS * PEER_NKEYS
PEER_DKEY = 256
PEER_TOPK = 16
TOKEN_BLOCK = 128

kernel_name = "hybrid_conv_sgu_natten_peer_dit"


def rmsnorm(x, g):
    xf = x.astype(jnp.float32)
    y = xf * lax.rsqrt(jnp.mean(xf * xf, axis=-1, keepdims=True) + EPS)
    return (y * g.astype(jnp.float32)).astype(x.dtype)


def group_rmsnorm(y, g, groups):
    shp = y.shape
    y = rmsnorm(y.reshape(*shp[:-1], groups, shp[-1] // groups), g.reshape(groups, -1))
    return y.reshape(shp)


def split_proj(p):
    a = p[..., :3 * CONV_W]
    s = p[..., 3 * CONV_W:3 * CONV_W + 2 * SGU_W]
    qkv = p[..., 3 * CONV_W + 2 * SGU_W:]
    return a, s, qkv


def to_heads(qkv):
    b, t, _ = qkv.shape
    q, k, v = jnp.split(qkv, 3, axis=-1)
    return (q.reshape(b, t, NA_HEADS, NA_HEAD_DIM), k.reshape(b, t, NA_HEADS, NA_HEAD_DIM),
            v.reshape(b, t, NA_HEADS, NA_HEAD_DIM))


def short_conv_mixer(p, w):
    gate_b, gate_c, xin = jnp.split(p, 3, axis=-1)
    z = jnp.pad(gate_c * xin, ((0, 0), (1, 1), (0, 0)))
    conv = z[:, :-2] * w[0] + z[:, 1:-1] * w[1] + z[:, 2:] * w[2]
    return gate_b * conv


def spatial_gating_mixer(p, w_s, b_s, g_v):
    b, t, _ = p.shape
    u, v = jnp.split(jax.nn.gelu(p), 2, axis=-1)
    v = group_rmsnorm(v, g_v, SGU_GROUPS)
    v = v.reshape(b, t // CHUNK, CHUNK, SGU_GROUPS, GROUP_DIM)
    mixed = jnp.einsum('gpq,bnqgc->bnpgc', w_s, v) + b_s.T[None, None, :, :, None]
    return u * mixed.reshape(b, t, SGU_W)


def neighbourhood_attention(q, k, v, kc, vc, rpb):
    b, t, h, dh = q.shape
    rows = t // GRID_W
    kh = min(NA_KH, rows)
    scale = dh ** -0.5
    qg = q.reshape(b, rows, GRID_W, h, dh)
    kg = k.reshape(b, rows, GRID_W, h, dh)
    vg = v.reshape(b, rows, GRID_W, h, dh)
    cols = jnp.arange(GRID_W)
    col_start = jnp.clip(cols - NA_KW // 2, 0, GRID_W - NA_KW)
    col_idx = col_start[:, None] + jnp.arange(NA_KW)[None, :]
    rpb_c = rpb[:, :, col_idx - cols[:, None] + (NA_KW - 1)]

    def row_step(r):
        rs = jnp.clip(r - kh // 2, 0, rows - kh)
        q_r = lax.dynamic_index_in_dim(qg, r, axis=1, keepdims=False)
        k_n = lax.dynamic_slice_in_dim(kg, rs, kh, axis=1)[:, :, col_idx]
        v_n = lax.dynamic_slice_in_dim(vg, rs, kh, axis=1)[:, :, col_idx]
        bias = rpb_c[:, rs + jnp.arange(kh) - r + (NA_KH - 1)]
        s_loc = jnp.einsum('bqhd,biqjhd->bhqij', q_r, k_n) * scale
        s_loc = s_loc + jnp.transpose(bias, (0, 2, 1, 3))[None]
        s_ctx = jnp.einsum('bqhd,bkhd->bhqk', q_r, kc) * scale
        s = jnp.concatenate([s_loc.reshape(b, h, GRID_W, kh * NA_KW), s_ctx], axis=-1)
        pr = jax.nn.softmax(s.astype(jnp.float32), axis=-1).astype(v.dtype)
        p_loc = pr[..., :kh * NA_KW].reshape(b, h, GRID_W, kh, NA_KW)
        p_ctx = pr[..., kh * NA_KW:]
        return (jnp.einsum('bhqij,biqjhd->bqhd', p_loc, v_n)
                + jnp.einsum('bhqk,bkhd->bqhd', p_ctx, vc))

    out = lax.map(row_step, jnp.arange(rows))
    return jnp.transpose(out, (1, 0, 2, 3, 4)).reshape(b, t, h * dh)


def context_attention(qc, kc, vc):
    s = jnp.einsum('bqhd,bkhd->bhqk', qc, kc) * (NA_HEAD_DIM ** -0.5)
    pr = jax.nn.softmax(s.astype(jnp.float32), axis=-1).astype(vc.dtype)
    return jnp.einsum('bhqk,bkhd->bqhd', pr, vc).reshape(qc.shape[0], qc.shape[1], NA_W)


def merge_heads(y_conv, y_sgu, y_na, out_norm_g, w_out):
    y = jnp.concatenate([y_conv, y_sgu, y_na], axis=-1)
    return group_rmsnorm(y, out_norm_g, MIX_W // GROUP_DIM) @ w_out


def peer_ffn(h, w_q, sub_keys, u_tab, v_tab):
    n, d = h.shape
    blocks = h.reshape(n // TOKEN_BLOCK, TOKEN_BLOCK, d)

    def block_step(hb):
        q = (hb @ w_q).reshape(TOKEN_BLOCK, PEER_HEADS, 2, PEER_DKEY // 2)
        s = jnp.einsum('thpd,hpkd->thpk', q, sub_keys).astype(jnp.float32)
        top_s, top_i = lax.top_k(s, PEER_TOPK)
        cand_s = (top_s[:, :, 0, :, None] + top_s[:, :, 1, None, :]).reshape(TOKEN_BLOCK, PEER_HEADS, -1)
        cand_i = (top_i[:, :, 0, :, None] * PEER_NKEYS + top_i[:, :, 1, None, :]).reshape(TOKEN_BLOCK, PEER_HEADS, -1)
        best_s, best_pos = lax.top_k(cand_s, PEER_TOPK)
        expert = jnp.take_along_axis(cand_i, best_pos, axis=-1)
        g = jax.nn.softmax(best_s, axis=-1)
        act = jax.nn.gelu(jnp.einsum('thkd,td->thk', u_tab[expert], hb))
        wgt = g.astype(act.dtype) * act
        return jnp.einsum('thk,thkd->td', wgt, v_tab[expert])

    return lax.map(block_step, blocks).reshape(n, d)


def setup_inputs(seed: int = 0) -> dict:
    key = jax.random.key(seed)
    ks = jax.random.split(key, 21)
    D = D_MODEL

    def nrm(k, shape, s):
        return jax.random.normal(k, shape, jnp.float32) * s

    return {
        "x": nrm(ks[0], (BATCH, SEQ, D), 1.0),
        "c": nrm(ks[1], (BATCH, D), 1.0),
        "ctx": nrm(ks[2], (BATCH, CTX_LEN, D), 1.0),
        "c_ctx": nrm(ks[3], (D,), 1.0),
        "ada_w": nrm(ks[4], (DEPTH, D, 6 * D), 0.5 * D ** -0.5),
        "ada_b": nrm(ks[5], (DEPTH, 6 * D), 0.02),
        "norm1_g": 1.0 + nrm(ks[6], (DEPTH, D), 0.05),
        "w_in": nrm(ks[7], (DEPTH, D, IN_W), D ** -0.5),
        "conv_w": nrm(ks[8], (DEPTH, CONV_K, CONV_W), CONV_K ** -0.5),
        "sgu_w": nrm(ks[9], (DEPTH, SGU_GROUPS, CHUNK, CHUNK), CHUNK ** -0.5),
        "sgu_b": 1.0 + nrm(ks[10], (DEPTH, SGU_GROUPS, CHUNK), 0.1),
        "sgu_norm_g": 1.0 + nrm(ks[11], (DEPTH, SGU_W), 0.05),
        "na_rpb": nrm(ks[12], (DEPTH, NA_HEADS, 2 * NA_KH - 1, 2 * NA_KW - 1), 0.2),
        "out_norm_g": 1.0 + nrm(ks[13], (DEPTH, MIX_W), 0.05),
        "w_out": nrm(ks[14], (DEPTH, MIX_W, D), MIX_W ** -0.5),
        "norm2_g": 1.0 + nrm(ks[15], (DEPTH, D), 0.05),
        "peer_wq": nrm(ks[16], (DEPTH, D, PEER_HEADS * PEER_DKEY), D ** -0.5),
        "peer_subkeys": nrm(ks[17], (DEPTH, PEER_HEADS, 2, PEER_NKEYS, PEER_DKEY // 2), (PEER_DKEY // 2) ** -0.5),
        "peer_u": nrm(ks[18], (DEPTH, PEER_N, D), D ** -0.5),
        "peer_v": nrm(ks[19], (DEPTH, PEER_N, D), 0.5),
        "final_norm_g": 1.0 + nrm(ks[20], (D,), 0.05),
    }


def reference(x, c, ctx, c_ctx, ada_w, ada_b, norm1_g, w_in, conv_w, sgu_w, sgu_b, sgu_norm_g,
              na_rpb, out_norm_g, w_out, norm2_g, peer_wq, peer_subkeys, peer_u, peer_v,
              final_norm_g):
    b, t, d = x.shape
    xc = ctx
    for l in range(DEPTH):
        last = l == DEPTH - 1
        sh1, sc1, g1, sh2, sc2, g2 = jnp.split((jax.nn.silu(c) @ ada_w[l] + ada_b[l])[:, None, :], 6, axis=-1)
        csh1, csc1, cg1, csh2, csc2, cg2 = jnp.split(jax.nn.silu(c_ctx) @ ada_w[l] + ada_b[l], 6, axis=-1)

        h = rmsnorm(x, norm1_g[l]) * (1.0 + sc1) + sh1
        hc = rmsnorm(xc, norm1_g[l]) * (1.0 + csc1) + csh1
        a_l, s_l, qkv_l = split_proj(h @ w_in[l])
        a_c, s_c, qkv_c = split_proj(hc @ w_in[l])
        q, k, v = to_heads(qkv_l)
        qc, kc, vc = to_heads(qkv_c)
        y = merge_heads(short_conv_mixer(a_l, conv_w[l]),
                        spatial_gating_mixer(s_l, sgu_w[l], sgu_b[l], sgu_norm_g[l]),
                        neighbourhood_attention(q, k, v, kc, vc, na_rpb[l]),
                        out_norm_g[l], w_out[l])
        x = x + g1 * y
        h2 = rmsnorm(x, norm2_g[l]) * (1.0 + sc2) + sh2

        if last:
            x = x + g2 * peer_ffn(h2.reshape(-1, d), peer_wq[l], peer_subkeys[l], peer_u[l], peer_v[l]).reshape(x.shape)
        else:
            yc = merge_heads(short_conv_mixer(a_c, conv_w[l]),
                             spatial_gating_mixer(s_c, sgu_w[l], sgu_b[l], sgu_norm_g[l]),
                             context_attention(qc, kc, vc),
                             out_norm_g[l], w_out[l])
            xc = xc + cg1 * yc
            hc2 = rmsnorm(xc, norm2_g[l]) * (1.0 + csc2) + csh2
            f = peer_ffn(jnp.concatenate([h2.reshape(-1, d), hc2.reshape(-1, d)], axis=0),
                         peer_wq[l], peer_subkeys[l], peer_u[l], peer_v[l])
            n_lat = b * t
            x = x + g2 * f[:n_lat].reshape(x.shape)
            xc = xc + cg2 * f[n_lat:].reshape(xc.shape)
    return rmsnorm(x, final_norm_g)
```

```cpp
#include <hip/hip_runtime.h>
#include <cstdio>
#include <cstdint>

#ifndef ONE_LAUNCH
#define ONE_LAUNCH 0
#endif

namespace pg8 {
#define PG8_LAS __attribute__((address_space(3)))
typedef unsigned short bf16_t;
typedef short bf16x8 __attribute__((ext_vector_type(8)));
typedef float f32x4 __attribute__((ext_vector_type(4)));
typedef unsigned u32x4 __attribute__((ext_vector_type(4)));
constexpr int BM = 256, BK = 64, HALF = 128, HTB = HALF * BK * 2  , STAGE_BYTES = 8 * HTB, NXCD = 8, WGM = 8;

__host__ __device__ __forceinline__ int lds_byte(int r, int c) { const int st = (r >> 4) * 2 + (c >> 5), rr = r & 15, cc = c & 31, ob = rr * 64 + cc * 2; return st * 1024 + (ob ^ (((ob >> 9) & 1) << 5)); }
__host__ __device__ __forceinline__ void stage_rc(int b, int& R, int& C) { const int st = b / 1024, sb = b % 1024, swz = sb ^ (((sb >> 9) & 1) << 5); R = (st >> 1) * 16 + swz / 64; C = (st & 1) * 32 + (swz % 64) / 2; }
__host__ __device__ __forceinline__ int perm32(int rho) { const int n = rho >> 4, i = rho & 15; return 8 * (i >> 2) + 4 * n + (i & 3); }

struct Unit { int pm, pn; };
struct Gemm { const bf16_t* A; const bf16_t* Bt; int M, N, K; };

struct StaticOrder {
    int nM, nN, nwg, G, c;
    __host__ __device__ void init(int M, int N, int G_, int c_) { nM = M / BM; nN = N / BM; nwg = nM * nN; G = G_; c = c_; }
    __host__ __device__ bool next(int i, Unit& u) const {
        const long L = (long)i * G + c; if (L >= nwg) return false;
        int wgid = (int)L; { const int q = nwg / NXCD, r = nwg % NXCD, xcd = wgid % NXCD, off = wgid / NXCD; wgid = (xcd < r ? xcd * (q + 1) : r * (q + 1) + (xcd - r) * q) + off; }
        const int nig = WGM * nN, gid = wgid / nig, fm = gid * WGM, gsz = (nM - fm) < WGM ? (nM - fm) : WGM;
        u.pm = fm + ((wgid % nig) % gsz); u.pn = (wgid % nig) / gsz; return true;
    }
    __device__ __forceinline__ void a_ready(const Unit&) const {}
    __device__ __forceinline__ void done(const Unit&) const {}
};

__device__ __forceinline__ unsigned cvt_pk_bf16(float lo, float hi) { unsigned r; asm volatile("v_cvt_pk_bf16_f32 %0, %1, %2" : "=v"(r) : "v"(lo), "v"(hi)); return r; }

struct EpiStoreBf16 {
    static constexpr bool PERM = true, AFTER_DRAIN = false;
    bf16_t* O; int ldc;
    __device__ __forceinline__ void operator()(const f32x4 (&acc)[2][2][4][2], const Unit& u, int wr, int wc, int fr, int fq) const {
        const int row0 = u.pm * BM + wr * 64 + fr, col0 = u.pn * BM + wc * 32 + 8 * fq;
#pragma unroll
        for (int ai = 0; ai < 2; ++ai)
#pragma unroll
            for (int m = 0; m < 4; ++m) { bf16_t* rowp = O + (size_t)(row0 + ai * HALF + m * 16) * ldc + col0;
#pragma unroll
                for (int bj = 0; bj < 2; ++bj) { const f32x4 v0 = acc[ai][bj][m][0], v1 = acc[ai][bj][m][1];
                    u32x4 w; w.x = cvt_pk_bf16(v0[0], v0[1]); w.y = cvt_pk_bf16(v0[2], v0[3]); w.z = cvt_pk_bf16(v1[0], v1[1]); w.w = cvt_pk_bf16(v1[2], v1[3]);
                    *(u32x4*)(rowp + bj * HALF) = w; } }
    }
};
struct EpiResid {
    static constexpr bool PERM = false, AFTER_DRAIN = false;
    float* X; int ldc; const float* gate; int gate_stride;
    __device__ __forceinline__ void operator()(const f32x4 (&acc)[2][2][4][2], const Unit& u, int wr, int wc, int fr, int fq) const {
        const int row0 = u.pm * BM + wr * 64 + fr, col0 = u.pn * BM + wc * 32 + 4 * fq;
        const float* gp = gate + (size_t)(u.pm < 64 ? 0 : (u.pm < 128 ? 1 : 2)) * gate_stride;
        f32x4 gv[2][2];
#pragma unroll
        for (int bj = 0; bj < 2; ++bj)
#pragma unroll
            for (int n = 0; n < 2; ++n) gv[bj][n] = *(const f32x4*)(gp + col0 + bj * HALF + n * 16);
#pragma unroll
        for (int ai = 0; ai < 2; ++ai)
#pragma unroll
            for (int m = 0; m < 4; ++m) { float* rowp = X + (size_t)(row0 + ai * HALF + m * 16) * ldc + col0;
#pragma unroll
                for (int bj = 0; bj < 2; ++bj)
#pragma unroll
                    for (int n = 0; n < 2; ++n) { f32x4* q = (f32x4*)(rowp + bj * HALF + n * 16); *q = *q + gv[bj][n] * acc[ai][bj][m][n]; } }
    }
};

template <class Epi, class Sched, bool STAMP = false>
__device__ __forceinline__ void gemm_phase(PG8_LAS unsigned char* lds, const Gemm g, const Sched& S, const Epi& E, unsigned long long* stamps) {
    const int tid = threadIdx.x, wid = __builtin_amdgcn_readfirstlane(tid >> 6), lane = tid & 63, wr = wid >> 2, wc = wid & 3, fr = lane & 15, fq = lane >> 4;
    const int K = g.K, nt = K / BK;
    int ts_lo = 0, ts_hi = 0, nts = 0; const unsigned long long rt_entry = STAMP ? (unsigned long long)wall_clock64() : 0ull;
#define PG8_STAMP() do { if (STAMP && wid == 0 && nts < 64) { const unsigned long long _c = (unsigned long long)clock64(); \
        ts_lo = (lane == nts) ? (int)(unsigned)_c : ts_lo; ts_hi = (lane == nts) ? (int)(unsigned)(_c >> 32) : ts_hi; ++nts; } } while (0)
    PG8_STAMP();
    unsigned voffA[2], voffB[2];
#pragma unroll
    for (int i = 0; i < 2; ++i) { int R, C; stage_rc(tid * 16 + i * 8192, R, C); const int Rb = Epi::PERM ? ((R & ~31) + perm32(R & 31)) : R;
        voffA[i] = (unsigned)(R * K + C) * 2u; voffB[i] = (unsigned)(Rb * K + C) * 2u; }
    const size_t kstep = (size_t)(BK * 2);
    const size_t hstep = (size_t)HALF * K * 2;
    const size_t tstep = 2 * hstep;
    const unsigned ldsw = (unsigned)wid * 1024u;
    const int aoff = lds_byte(wr * 64 + fr, fq * 8), boff = lds_byte(wc * 32 + fr, fq * 8);
#define PG8_SA(b, h) (((b) * 2 + (h)) * HTB)
#define PG8_SB(b, h) ((4 + (b) * 2 + (h)) * HTB)
#define PG8_STAGE(bufoff, gbase, voff) do { _Pragma("unroll") for (int _i = 0; _i < 2; ++_i) \
        __builtin_amdgcn_global_load_lds((const unsigned*)((const char*)(gbase) + (voff)[_i]), (PG8_LAS unsigned*)(lds + (bufoff) + ldsw + _i * 8192), 16, 0, 0); } while (0)
#define PG8_LDA(dst, b, h) do { _Pragma("unroll") for (int m = 0; m < 4; ++m) _Pragma("unroll") for (int k = 0; k < 2; ++k) dst[m][k] = *(const PG8_LAS bf16x8*)(lds + PG8_SA(b, h) + aoff + m * 2048 + k * 1024); } while (0)
#define PG8_LDB(dst, b, h) do { _Pragma("unroll") for (int n = 0; n < 2; ++n) _Pragma("unroll") for (int k = 0; k < 2; ++k) dst[n][k] = *(const PG8_LAS bf16x8*)(lds + PG8_SB(b, h) + boff + n * 2048 + k * 1024); } while (0)
#define PG8_MMA(ai, bj, At, Bt) do { __builtin_amdgcn_s_setprio(1); _Pragma("unroll") for (int m = 0; m < 4; ++m) _Pragma("unroll") for (int n = 0; n < 2; ++n) _Pragma("unroll") for (int k = 0; k < 2; ++k) \
        acc[ai][bj][m][n] = __builtin_amdgcn_mfma_f32_16x16x32_bf16(Bt[n][k], At[m][k], acc[ai][bj][m][n], 0, 0, 0); __builtin_amdgcn_s_setprio(0); } while (0)
#define PG8_WAIT_V(n) asm volatile("s_waitcnt vmcnt(" #n ")" ::: "memory")
#define PG8_WAIT_L(n) asm volatile("s_waitcnt lgkmcnt(" #n ")" ::: "memory")
#define PG8_BAR __builtin_amdgcn_s_barrier()
#define PG8_SCHED __builtin_amdgcn_sched_barrier(0)
    Unit cur, nxt; int ui = 0;
    if (!S.next(0, cur)) return;
    f32x4 acc[2][2][4][2];
#pragma unroll
    for (int a = 0; a < 2; ++a)
#pragma unroll
        for (int b = 0; b < 2; ++b)
#pragma unroll
            for (int m = 0; m < 4; ++m)
#pragma unroll
                for (int n = 0; n < 2; ++n) acc[a][b][m][n] = (f32x4){0.f, 0.f, 0.f, 0.f};
    bf16x8 At[4][2], B0[2][2], B1[2][2];
    const char* cA = (const char*)g.A + (size_t)cur.pm * tstep; const char* cB = (const char*)g.Bt + (size_t)cur.pn * tstep;
    S.a_ready(cur);
    PG8_STAGE(PG8_SB(0, 0), cB, voffB); PG8_STAGE(PG8_SA(0, 0), cA, voffA); PG8_STAGE(PG8_SB(0, 1), cB + hstep, voffB); PG8_STAGE(PG8_SA(0, 1), cA + hstep, voffA);
    if (wr == 1) PG8_BAR;
    PG8_WAIT_V(4); PG8_BAR;
    PG8_STAGE(PG8_SB(1, 0), cB + kstep, voffB); PG8_STAGE(PG8_SA(1, 0), cA + kstep, voffA); PG8_STAGE(PG8_SB(1, 1), cB + hstep + kstep, voffB);
    PG8_WAIT_V(6); PG8_BAR;
    PG8_STAMP();
    for (;;) {
        const bool has_next = S.next(ui + 1, nxt);
        const char* nA = has_next ? (const char*)g.A + (size_t)nxt.pm * tstep : cA; const char* nB = has_next ? (const char*)g.Bt + (size_t)nxt.pn * tstep : cB;
        for (int t = 0; t < nt; t += 2) {
            const bool last = (t == nt - 2);
            const char* a1 = cA + (size_t)(t + 1) * kstep;
            const char* a2 = last ? nA : cA + (size_t)(t + 2) * kstep; const char* b2 = last ? nB : cB + (size_t)(t + 2) * kstep;
            const char* a3 = a2 + kstep; const char* b3 = b2 + kstep;
            if (last && has_next) S.a_ready(nxt);
            PG8_LDB(B0, 0, 0); PG8_SCHED; PG8_LDA(At, 0, 0); PG8_STAGE(PG8_SA(1, 1), a1 + hstep, voffA);
            PG8_WAIT_L(8); PG8_BAR; PG8_WAIT_L(0); PG8_MMA(0, 0, At, B0); PG8_BAR; PG8_SCHED;
            PG8_LDB(B1, 0, 1); PG8_STAGE(PG8_SB(0, 0), b2, voffB);
            PG8_BAR; PG8_WAIT_L(0); PG8_MMA(0, 1, At, B1); PG8_BAR;
            PG8_LDA(At, 0, 1); PG8_STAGE(PG8_SA(0, 0), a2, voffA);
            PG8_BAR; PG8_WAIT_L(0); PG8_MMA(1, 0, At, B0); PG8_BAR; PG8_SCHED;
            PG8_STAGE(PG8_SB(0, 1), b2 + hstep, voffB);
            PG8_WAIT_V(6); PG8_BAR; PG8_MMA(1, 1, At, B1); PG8_BAR;
            PG8_LDB(B0, 1, 0); PG8_SCHED; PG8_LDA(At, 1, 0); PG8_STAGE(PG8_SA(0, 1), a2 + hstep, voffA);
            PG8_WAIT_L(8); PG8_BAR; PG8_WAIT_L(0); PG8_MMA(0, 0, At, B0); PG8_BAR; PG8_SCHED;
            PG8_LDB(B1, 1, 1); PG8_STAGE(PG8_SB(1, 0), b3, voffB);
            PG8_BAR; PG8_WAIT_L(0); PG8_MMA(0, 1, At, B1); PG8_BAR;
            PG8_LDA(At, 1, 1); PG8_STAGE(PG8_SA(1, 0), a3, voffA);
            PG8_BAR; PG8_WAIT_L(0); PG8_MMA(1, 0, At, B0); PG8_BAR; PG8_SCHED;
            PG8_STAGE(PG8_SB(1, 1), b3 + hstep, voffB);
            PG8_WAIT_V(6); PG8_BAR; PG8_MMA(1, 1, At, B1); PG8_BAR;
        }
        PG8_STAMP();
        if constexpr (!Epi::AFTER_DRAIN) { E(acc, cur, wr, wc, fr, fq); S.done(cur); }
        PG8_STAMP();
        if (!has_next) break;
#pragma unroll
        for (int a = 0; a < 2; ++a)
#pragma unroll
            for (int b = 0; b < 2; ++b)
#pragma unroll
                for (int m = 0; m < 4; ++m)
#pragma unroll
                    for (int n = 0; n < 2; ++n) acc[a][b][m][n] = (f32x4){0.f, 0.f, 0.f, 0.f};
        cur = nxt; cA = nA; cB = nB; ++ui;
    }
    PG8_WAIT_V(0);
    if (wr == 0) PG8_BAR;
    PG8_BAR;
    if constexpr (Epi::AFTER_DRAIN) { E.fused(acc, cur, wr, wc, fr, fq, lds, wid, lane); S.done(cur); }
    PG8_STAMP();
    if (STAMP && wid == 0) { stamps[lane] = lane < nts ? (((unsigned long long)(unsigned)ts_hi << 32) | (unsigned)ts_lo) : 0ull;
        if (lane == 62) stamps[62] = rt_entry; if (lane == 63) stamps[63] = (unsigned long long)wall_clock64(); }
#undef PG8_STAMP
#undef PG8_SA
#undef PG8_SB
#undef PG8_STAGE
#undef PG8_LDA
#undef PG8_LDB
#undef PG8_MMA
#undef PG8_WAIT_V
#undef PG8_WAIT_L
#undef PG8_BAR
#undef PG8_SCHED
}
}

#define LAS __attribute__((address_space(3)))
typedef unsigned short bf16_t;
constexpr int D = 1024, T = 16384, NLAT = 32768, CTXL = 256, NTOK = 33280, DEPTH = 4;
constexpr int IN_W = 2816, QW = 2048;
constexpr int C_GB = 0, C_GC = 256, C_XI = 512, C_SU = 768, C_SV = 1024, C_Q = 1280, C_K = 1792, C_V = 2304;
constexpr int MODW = 6144;
constexpr float EPS = 1e-6f;
constexpr int NTHR = 512, NWAVE = 8;
constexpr int LDS_BYTES = 131072 + 1024;

constexpr size_t MiB = 1u << 20;
constexpr size_t WS_CTL = 0;
constexpr size_t WS_MOD = 1 * MiB;
constexpr size_t WS_WIN = 2 * MiB;
constexpr size_t WS_WOUT = WS_WIN + 22 * MiB;
constexpr size_t WS_WQ = WS_WOUT + 8 * MiB;
constexpr size_t WS_SUBK = WS_WQ + 16 * MiB;
constexpr size_t WS_UT = WS_SUBK + 2 * MiB;
constexpr size_t WS_VT = WS_UT + 128 * MiB;
constexpr size_t WS_XRES = WS_VT + 128 * MiB;
constexpr size_t WS_H = WS_XRES + 130 * MiB;
constexpr size_t WS_PROJ = WS_H + 65 * MiB;
constexpr size_t WS_YCAT = WS_PROJ + 179 * MiB;
constexpr size_t WS_Q = WS_YCAT + 65 * MiB;
constexpr size_t WS_PIDX = WS_Q + 130 * MiB;
constexpr size_t WS_PG = WS_PIDX + 17 * MiB;
constexpr size_t WS_END = WS_PG + 17 * MiB;

struct P {
    const float *x, *c, *ctx, *c_ctx, *ada_w, *ada_b, *norm1_g, *w_in, *conv_w, *sgu_w, *sgu_b, *sgu_norm_g, *na_rpb, *out_norm_g, *w_out, *norm2_g,
                *peer_wq, *peer_subkeys, *peer_u, *peer_v, *final_norm_g;
    float* out; unsigned char* ws;
};

__device__ __forceinline__ float bf_lo(unsigned u) { return __uint_as_float(u << 16); }
__device__ __forceinline__ float bf_hi(unsigned u) { return __uint_as_float(u & 0xffff0000u); }
__device__ __forceinline__ float bf1(bf16_t b) { return __uint_as_float(((unsigned)b) << 16); }
__device__ __forceinline__ unsigned pk_bf16(float lo, float hi) { return pg8::cvt_pk_bf16(lo, hi); }
__device__ __forceinline__ float wave_sum(float v) {
#pragma unroll
    for (int o = 32; o >= 1; o >>= 1) v += __shfl_xor(v, o);
    return v; }
__device__ __forceinline__ float wave_max(float v) {
#pragma unroll
    for (int o = 32; o >= 1; o >>= 1) v = fmaxf(v, __shfl_xor(v, o));
    return v; }
__device__ __forceinline__ float gelu_tanh(float x) {
    const float y = 0.7978845608f * (x + 0.044715f * x * x * x);
    const float e = __expf(2.0f * y);
    const float th = 1.0f - 2.0f / (1.0f + e);
    return 0.5f * x * (1.0f + th); }
__device__ __forceinline__ void unpack8(const uint4 v, float (&f)[8]) {
    f[0] = bf_lo(v.x); f[1] = bf_hi(v.x); f[2] = bf_lo(v.y); f[3] = bf_hi(v.y); f[4] = bf_lo(v.z); f[5] = bf_hi(v.z); f[6] = bf_lo(v.w); f[7] = bf_hi(v.w); }
__device__ __forceinline__ float dot8(const uint4 a, const uint4 b, float acc) {
    acc = fmaf(bf_lo(a.x), bf_lo(b.x), acc); acc = fmaf(bf_hi(a.x), bf_hi(b.x), acc);
    acc = fmaf(bf_lo(a.y), bf_lo(b.y), acc); acc = fmaf(bf_hi(a.y), bf_hi(b.y), acc);
    acc = fmaf(bf_lo(a.z), bf_lo(b.z), acc); acc = fmaf(bf_hi(a.z), bf_hi(b.z), acc);
    acc = fmaf(bf_lo(a.w), bf_lo(b.w), acc); acc = fmaf(bf_hi(a.w), bf_hi(b.w), acc);
    return acc; }
__device__ __forceinline__ int row_sel(int r) { return r < T ? 0 : (r < NLAT ? 1 : 2); }

__device__ __forceinline__ void transpose_cvt(const float* src, int K, int N, bf16_t* dst, LAS float* tile) {
    const int tid = threadIdx.x, tn = N / 64, ntile = (K / 64) * tn;
    for (int t = blockIdx.x; t < ntile; t += gridDim.x) {
        const int k0 = (t / tn) * 64, n0 = (t % tn) * 64;
        const int kk = tid >> 4, nn = (tid & 15) * 4;
#pragma unroll
        for (int i = 0; i < 2; ++i) { const int k = kk + 32 * i; const float4 v = *(const float4*)(src + (size_t)(k0 + k) * N + n0 + nn);
            tile[k * 65 + nn + 0] = v.x; tile[k * 65 + nn + 1] = v.y; tile[k * 65 + nn + 2] = v.z; tile[k * 65 + nn + 3] = v.w; }
        __syncthreads();
        const int n = tid >> 3, kc = (tid & 7) * 8;
        uint4 w;
        w.x = pk_bf16(tile[(kc + 0) * 65 + n], tile[(kc + 1) * 65 + n]); w.y = pk_bf16(tile[(kc + 2) * 65 + n], tile[(kc + 3) * 65 + n]);
        w.z = pk_bf16(tile[(kc + 4) * 65 + n], tile[(kc + 5) * 65 + n]); w.w = pk_bf16(tile[(kc + 6) * 65 + n], tile[(kc + 7) * 65 + n]);
        *(uint4*)(dst + (size_t)(n0 + n) * K + k0 + kc) = w;
        __syncthreads();
    }
}
__device__ __forceinline__ void cvt_copy(const float* src, bf16_t* dst, size_t n) {
    const size_t stride = (size_t)gridDim.x * NTHR;
    for (size_t i = (size_t)blockIdx.x * NTHR + threadIdx.x; i < n / 8; i += stride) {
        const float4 a = ((const float4*)src)[2 * i], b = ((const float4*)src)[2 * i + 1];
        uint4 w; w.x = pk_bf16(a.x, a.y); w.y = pk_bf16(a.z, a.w); w.z = pk_bf16(b.x, b.y); w.w = pk_bf16(b.z, b.w);
        ((uint4*)dst)[i] = w; }
}
__device__ __forceinline__ void f32_copy(const float* src, float* dst, size_t n) {
    const size_t stride = (size_t)gridDim.x * NTHR;
    for (size_t i = (size_t)blockIdx.x * NTHR + threadIdx.x; i < n / 4; i += stride) ((float4*)dst)[i] = ((const float4*)src)[i];
}
__device__ __forceinline__ void phase_prologue(const P& p, LAS unsigned char* lds) {
    unsigned char* ws = p.ws;
    for (int l = 0; l < DEPTH; ++l) {
        transpose_cvt(p.w_in + (size_t)l * D * IN_W, D, IN_W, (bf16_t*)(ws + WS_WIN) + (size_t)l * IN_W * D, (LAS float*)lds);
        transpose_cvt(p.w_out + (size_t)l * D * D, D, D, (bf16_t*)(ws + WS_WOUT) + (size_t)l * D * D, (LAS float*)lds);
        transpose_cvt(p.peer_wq + (size_t)l * D * QW, D, QW, (bf16_t*)(ws + WS_WQ) + (size_t)l * QW * D, (LAS float*)lds);
    }
    cvt_copy(p.peer_subkeys, (bf16_t*)(ws + WS_SUBK), (size_t)DEPTH * 8 * 2 * 128 * 128);
    cvt_copy(p.peer_u, (bf16_t*)(ws + WS_UT), (size_t)DEPTH * 16384 * 1024);
    cvt_copy(p.peer_v, (bf16_t*)(ws + WS_VT), (size_t)DEPTH * 16384 * 1024);
    f32_copy(p.x, (float*)(ws + WS_XRES), (size_t)NLAT * D);
    f32_copy(p.ctx, (float*)(ws + WS_XRES) + (size_t)NLAT * D, (size_t)(NTOK - NLAT) * D);
}
__device__ __forceinline__ void phase_adaln(const P& p, LAS unsigned char* lds) {
    LAS float* sl = (LAS float*)lds; LAS float* part = sl + 3072;
    const int tid = threadIdx.x, wave = tid >> 6, lane = tid & 63;
    for (int i = tid; i < 3072; i += NTHR) { const int m = i >> 10, j = i & 1023; const float cv = (m < 2) ? p.c[m * 1024 + j] : p.c_ctx[j]; sl[i] = cv / (1.0f + __expf(-cv)); }
    __syncthreads();
    float* MOD = (float*)(p.ws + WS_MOD);
    for (int item = blockIdx.x; item < DEPTH * 96; item += gridDim.x) {
        const int l = item / 96, j0 = (item % 96) * 64;
        const float* W = p.ada_w + (size_t)l * D * MODW + j0 + lane;
        float a0 = 0.f, a1 = 0.f, a2 = 0.f;
#pragma unroll 8
        for (int i = wave * 128; i < wave * 128 + 128; ++i) { const float w = W[(size_t)i * MODW]; a0 = fmaf(sl[i], w, a0); a1 = fmaf(sl[1024 + i], w, a1); a2 = fmaf(sl[2048 + i], w, a2); }
        part[(wave * 3 + 0) * 64 + lane] = a0; part[(wave * 3 + 1) * 64 + lane] = a1; part[(wave * 3 + 2) * 64 + lane] = a2;
        __syncthreads();
        if (tid < 192) { const int m = tid >> 6; float s = 0.f;
#pragma unroll
            for (int w = 0; w < 8; ++w) s += part[(w * 3 + m) * 64 + lane];
            MOD[(size_t)(l * 3 + m) * MODW + j0 + lane] = s + p.ada_b[l * MODW + j0 + lane]; }
        __syncthreads();
    }
}
__device__ __forceinline__ void phase_norm(const P& p, int l, int which) {
    const float* g = (which ? p.norm2_g : p.norm1_g) + l * D;
    const float* mod = (const float*)(p.ws + WS_MOD) + (size_t)l * 3 * MODW + (which ? 3 * D : 0);
    const float* X = (const float*)(p.ws + WS_XRES); bf16_t* H = (bf16_t*)(p.ws + WS_H);
    const int lane = threadIdx.x & 63, gw = blockIdx.x * NWAVE + (threadIdx.x >> 6), nw = gridDim.x * NWAVE;
    for (int r = gw; r < NTOK; r += nw) {
        const float* xr = X + (size_t)r * D; const float* mr = mod + (size_t)row_sel(r) * MODW;
        float4 v[4]; float ss = 0.f;
#pragma unroll
        for (int i = 0; i < 4; ++i) { v[i] = *(const float4*)(xr + i * 256 + lane * 4); ss += v[i].x * v[i].x + v[i].y * v[i].y + v[i].z * v[i].z + v[i].w * v[i].w; }
        ss = wave_sum(ss); const float rs = rsqrtf(ss * (1.0f / D) + EPS);
#pragma unroll
        for (int i = 0; i < 4; ++i) { const int col = i * 256 + lane * 4;
            const float4 gv = *(const float4*)(g + col), sh = *(const float4*)(mr + col), sc = *(const float4*)(mr + D + col);
            uint2 w; w.x = pk_bf16(v[i].x * rs * gv.x * (1.0f + sc.x) + sh.x, v[i].y * rs * gv.y * (1.0f + sc.y) + sh.y);
                     w.y = pk_bf16(v[i].z * rs * gv.z * (1.0f + sc.z) + sh.z, v[i].w * rs * gv.w * (1.0f + sc.w) + sh.w);
            *(uint2*)(H + (size_t)r * D + col) = w; }
    }
}
__device__ __forceinline__ void phase_conv(const P& p, int l) {
    const bf16_t* PR = (const bf16_t*)(p.ws + WS_PROJ); bf16_t* Y = (bf16_t*)(p.ws + WS_YCAT);
    const int lane = threadIdx.x & 63, gw = blockIdx.x * NWAVE + (threadIdx.x >> 6), nw = gridDim.x * NWAVE, ch = lane * 4;
    const float4 cw0 = *(const float4*)(p.conv_w + (size_t)(l * 3 + 0) * 256 + ch), cw1 = *(const float4*)(p.conv_w + (size_t)(l * 3 + 1) * 256 + ch), cw2 = *(const float4*)(p.conv_w + (size_t)(l * 3 + 2) * 256 + ch);
    const float4 og = *(const float4*)(p.out_norm_g + (size_t)l * D + ch);
    for (int r = gw; r < NTOK; r += nw) {
        int pos, len; if (r < NLAT) { pos = r & (T - 1); len = T; } else { pos = (r - NLAT) & (CTXL - 1); len = CTXL; }
        const bf16_t* pr = PR + (size_t)r * IN_W + ch;
        const uint2 gb = *(const uint2*)(pr + C_GB), gc = *(const uint2*)(pr + C_GC), xi = *(const uint2*)(pr + C_XI);
        uint2 gcm = make_uint2(0u, 0u), xim = gcm, gcp = gcm, xip = gcm;
        if (pos > 0) { gcm = *(const uint2*)(pr - IN_W + C_GC); xim = *(const uint2*)(pr - IN_W + C_XI); }
        if (pos < len - 1) { gcp = *(const uint2*)(pr + IN_W + C_GC); xip = *(const uint2*)(pr + IN_W + C_XI); }
        float y[4];
        y[0] = bf_lo(gb.x) * (bf_lo(gcm.x) * bf_lo(xim.x) * cw0.x + bf_lo(gc.x) * bf_lo(xi.x) * cw1.x + bf_lo(gcp.x) * bf_lo(xip.x) * cw2.x);
        y[1] = bf_hi(gb.x) * (bf_hi(gcm.x) * bf_hi(xim.x) * cw0.y + bf_hi(gc.x) * bf_hi(xi.x) * cw1.y + bf_hi(gcp.x) * bf_hi(xip.x) * cw2.y);
        y[2] = bf_lo(gb.y) * (bf_lo(gcm.y) * bf_lo(xim.y) * cw0.z + bf_lo(gc.y) * bf_lo(xi.y) * cw1.z + bf_lo(gcp.y) * bf_lo(xip.y) * cw2.z);
        y[3] = bf_hi(gb.y) * (bf_hi(gcm.y) * bf_hi(xim.y) * cw0.w + bf_hi(gc.y) * bf_hi(xi.y) * cw1.w + bf_hi(gcp.y) * bf_hi(xip.y) * cw2.w);
        float ss = y[0] * y[0] + y[1] * y[1] + y[2] * y[2] + y[3] * y[3];
        ss += __shfl_xor(ss, 1); ss += __shfl_xor(ss, 2); ss += __shfl_xor(ss, 4); ss += __shfl_xor(ss, 8);
        const float rs = rsqrtf(ss * (1.0f / 64.0f) + EPS);
        uint2 w; w.x = pk_bf16(y[0] * rs * og.x, y[1] * rs * og.y); w.y = pk_bf16(y[2] * rs * og.z, y[3] * rs * og.w);
        *(uint2*)(Y + (size_t)r * D + ch) = w;
    }
}
__device__ __forceinline__ void phase_sgu(const P& p, int l, LAS unsigned char* lds) {
    LAS float* Wl = (LAS float*)lds; LAS float* Vn = Wl + 128 * 128;
    const bf16_t* PR = (const bf16_t*)(p.ws + WS_PROJ); bf16_t* Y = (bf16_t*)(p.ws + WS_YCAT);
    const int tid = threadIdx.x, wave = tid >> 6, lane = tid & 63;
    for (int item = blockIdx.x; item < (NTOK / 128) * 4; item += gridDim.x) {
        const int chunk = item >> 2, g = item & 3, row0 = chunk * 128;
        const float4* Wsrc = (const float4*)(p.sgu_w + (size_t)(l * 4 + g) * 128 * 128);
#pragma unroll
        for (int i = 0; i < 8; ++i) { const float4 v = Wsrc[tid + NTHR * i]; LAS float* d = Wl + (tid + NTHR * i) * 4; d[0] = v.x; d[1] = v.y; d[2] = v.z; d[3] = v.w; }
        { const int tok = tid >> 2, cg = (tid & 3) * 16;
          const bf16_t* src = PR + (size_t)(row0 + tok) * IN_W + C_SV + g * 64 + cg;
          float f[16]; { float a[8], b[8]; unpack8(((const uint4*)src)[0], a); unpack8(((const uint4*)src)[1], b);
#pragma unroll
              for (int j = 0; j < 8; ++j) { f[j] = gelu_tanh(a[j]); f[8 + j] = gelu_tanh(b[j]); } }
          float ss = 0.f;
#pragma unroll
          for (int j = 0; j < 16; ++j) ss += f[j] * f[j];
          ss += __shfl_xor(ss, 1); ss += __shfl_xor(ss, 2);
          const float rs = rsqrtf(ss * (1.0f / 64.0f) + EPS);
          const float* gn = p.sgu_norm_g + (size_t)l * 256 + g * 64 + cg;
#pragma unroll
          for (int j = 0; j < 16; ++j) Vn[tok * 64 + cg + j] = f[j] * rs * gn[j]; }
        __syncthreads();
        const float ogv = p.out_norm_g[(size_t)l * D + 256 + g * 64 + lane];
        for (int i = 0; i < 16; ++i) {
            const int pp = wave + 8 * i; float acc = 0.f;
#pragma unroll 8
            for (int q = 0; q < 128; ++q) acc = fmaf(Wl[pp * 128 + q], Vn[q * 64 + lane], acc);
            const float mixed = acc + p.sgu_b[(size_t)(l * 4 + g) * 128 + pp];
            const float uval = gelu_tanh(bf1(PR[(size_t)(row0 + pp) * IN_W + C_SU + g * 64 + lane]));
            const float o = uval * mixed;
            const float ss = wave_sum(o * o); const float rs = rsqrtf(ss * (1.0f / 64.0f) + EPS);
            Y[(size_t)(row0 + pp) * D + 256 + g * 64 + lane] = (bf16_t)(pk_bf16(o * rs * ogv, 0.f) & 0xffffu);
        }
        __syncthreads();
    }
}
__device__ __forceinline__ void phase_na(const P& p, int l, LAS unsigned char* lds) {
    const bf16_t* PR = (const bf16_t*)(p.ws + WS_PROJ); bf16_t* Y = (bf16_t*)(p.ws + WS_YCAT);
    const int lane = threadIdx.x & 63, wave = threadIdx.x >> 6, gw = blockIdx.x * NWAVE + wave, nw = gridDim.x * NWAVE;
    LAS float* pl = (LAS float*)lds + wave * 384;
    for (int item = gw; item < NTOK * 8; item += nw) {
        const int r = item >> 3, h = item & 7;
        const bool lat = r < NLAT;
        int b, gr = 0, gc = 0, rs_ = 0, cs_ = 0;
        if (lat) { b = r >> 14; const int pos = r & (T - 1); gr = pos >> 6; gc = pos & 63; rs_ = min(max(gr - 4, 0), 248); cs_ = min(max(gc - 8, 0), 48); }
        else b = (r - NLAT) >> 8;
        const int ctxbase = NLAT + b * CTXL;
        const uint4* qp = (const uint4*)(PR + (size_t)r * IN_W + C_Q + h * 64);
        uint4 qv[8];
#pragma unroll
        for (int j = 0; j < 8; ++j) qv[j] = qp[j];
        float s[6];
#pragma unroll
        for (int kk = 0; kk < 2; ++kk) {
            s[kk] = -3.0e38f;
            if (lat) { const int key = lane + 64 * kk, i = key >> 4, j = key & 15; const int krow = b * T + (rs_ + i) * 64 + cs_ + j;
                const uint4* kp = (const uint4*)(PR + (size_t)krow * IN_W + C_K + h * 64); float d = 0.f;
#pragma unroll
                for (int c = 0; c < 8; ++c) d = dot8(qv[c], kp[c], d);
                s[kk] = d * 0.125f + p.na_rpb[((size_t)(l * 8 + h) * 15 + (rs_ + i - gr + 7)) * 31 + (cs_ + j - gc + 15)]; }
        }
#pragma unroll
        for (int kk = 0; kk < 4; ++kk) { const int krow = ctxbase + lane + 64 * kk;
            const uint4* kp = (const uint4*)(PR + (size_t)krow * IN_W + C_K + h * 64); float d = 0.f;
#pragma unroll
            for (int c = 0; c < 8; ++c) d = dot8(qv[c], kp[c], d);
            s[2 + kk] = d * 0.125f; }
        float mx = s[0];
#pragma unroll
        for (int i = 1; i < 6; ++i) mx = fmaxf(mx, s[i]);
        mx = wave_max(mx);
        float e[6], sum = 0.f;
#pragma unroll
        for (int i = 0; i < 6; ++i) { e[i] = __expf(s[i] - mx); sum += e[i]; }
        sum = wave_sum(sum); const float inv = 1.0f / sum;
#pragma unroll
        for (int i = 0; i < 6; ++i) pl[lane + 64 * i] = e[i] * inv;
        __builtin_amdgcn_wave_barrier();
        float acc = 0.f;
        if (lat) {
            for (int i = 0; i < 8; ++i) { const bf16_t* vp = PR + (size_t)(b * T + (rs_ + i) * 64 + cs_) * IN_W + C_V + h * 64 + lane;
#pragma unroll
                for (int j = 0; j < 16; ++j) acc = fmaf(pl[i * 16 + j], bf1(vp[(size_t)j * IN_W]), acc); }
        }
        { const bf16_t* vp = PR + (size_t)ctxbase * IN_W + C_V + h * 64 + lane;
#pragma unroll 8
          for (int kk = 0; kk < CTXL; ++kk) acc = fmaf(pl[128 + kk], bf1(vp[(size_t)kk * IN_W]), acc); }
        __builtin_amdgcn_wave_barrier();
        const float ss = wave_sum(acc * acc); const float rs = rsqrtf(ss * (1.0f / 64.0f) + EPS);
        Y[(size_t)r * D + 512 + h * 64 + lane] = (bf16_t)(pk_bf16(acc * rs * p.out_norm_g[(size_t)l * D + 512 + h * 64 + lane], 0.f) & 0xffffu);
    }
}
__device__ __forceinline__ void phase_topk(const P& p, int l, LAS unsigned char* lds) {
    const bf16_t* Q = (const bf16_t*)(p.ws + WS_Q); const bf16_t* SK = (const bf16_t*)(p.ws + WS_SUBK);
    int* PIDX = (int*)(p.ws + WS_PIDX); float* PG = (float*)(p.ws + WS_PG);
    const int lane = threadIdx.x & 63, wave = threadIdx.x >> 6, gw = blockIdx.x * NWAVE + wave, nw = gridDim.x * NWAVE;
    LAS float* ql = (LAS float*)lds + wave * 320; LAS float* tsl = ql + 256; LAS int* til = (LAS int*)(ql + 288);
    for (int item = gw; item < NTOK * 8; item += nw) {
        const int t = item >> 3, h = item & 7;
        { const uint2 qq = ((const uint2*)(Q + (size_t)t * QW + h * 256))[lane];
          ql[lane * 4 + 0] = bf_lo(qq.x); ql[lane * 4 + 1] = bf_hi(qq.x); ql[lane * 4 + 2] = bf_lo(qq.y); ql[lane * 4 + 3] = bf_hi(qq.y); }
        __builtin_amdgcn_wave_barrier();
        float sc[2][2];
#pragma unroll
        for (int pp = 0; pp < 2; ++pp)
#pragma unroll
            for (int kk = 0; kk < 2; ++kk) { const int key = lane + 64 * kk;
                const uint4* kp = (const uint4*)(SK + ((size_t)((l * 8 + h) * 2 + pp) * 128 + key) * 128); float acc = 0.f;
#pragma unroll 4
                for (int c = 0; c < 16; ++c) { float f[8]; unpack8(kp[c], f);
#pragma unroll
                    for (int j = 0; j < 8; ++j) acc = fmaf(ql[pp * 128 + c * 8 + j], f[j], acc); }
                sc[pp][kk] = acc; }
#pragma unroll
        for (int pp = 0; pp < 2; ++pp) {
            float v0 = sc[pp][0], v1 = sc[pp][1];
            for (int it = 0; it < 16; ++it) {
                float bv = v0; int bi = lane; if (v1 > v0) { bv = v1; bi = lane + 64; }
#pragma unroll
                for (int o = 32; o >= 1; o >>= 1) { const float ov = __shfl_xor(bv, o); const int oi = __shfl_xor(bi, o); if (ov > bv || (ov == bv && oi < bi)) { bv = ov; bi = oi; } }
                if (lane == it) { tsl[pp * 16 + it] = bv; til[pp * 16 + it] = bi; }
                if (bi == lane) v0 = -3.0e38f; if (bi == lane + 64) v1 = -3.0e38f;
            }
        }
        __builtin_amdgcn_wave_barrier();
        float cs[4];
#pragma unroll
        for (int m = 0; m < 4; ++m) { const int c = lane + 64 * m; cs[m] = tsl[c >> 4] + tsl[16 + (c & 15)]; }
        float my_s = -3.0e38f; int my_c = 0;
        for (int it = 0; it < 16; ++it) {
            float bv = cs[0]; int bi = lane;
#pragma unroll
            for (int m = 1; m < 4; ++m) if (cs[m] > bv) { bv = cs[m]; bi = lane + 64 * m; }
#pragma unroll
            for (int o = 32; o >= 1; o >>= 1) { const float ov = __shfl_xor(bv, o); const int oi = __shfl_xor(bi, o); if (ov > bv || (ov == bv && oi < bi)) { bv = ov; bi = oi; } }
            if (lane == it) { my_s = bv; my_c = bi; }
#pragma unroll
            for (int m = 0; m < 4; ++m) if (bi == lane + 64 * m) cs[m] = -3.0e38f;
        }
        const float mx = __shfl(my_s, 0);
        const float e = (lane < 16) ? __expf(my_s - mx) : 0.f;
        const float sum = wave_sum(e);
        if (lane < 16) { const int a = my_c >> 4, bb = my_c & 15; const int expert = til[a] * 128 + til[16 + bb];
            PIDX[(size_t)t * 128 + h * 16 + lane] = expert; PG[(size_t)t * 128 + h * 16 + lane] = e / sum; }
        __builtin_amdgcn_wave_barrier();
    }
}
__device__ __forceinline__ void phase_gather(const P& p, int l) {
    const bf16_t* H = (const bf16_t*)(p.ws + WS_H);
    const bf16_t* UT = (const bf16_t*)(p.ws + WS_UT) + (size_t)l * 16384 * 1024; const bf16_t* VT = (const bf16_t*)(p.ws + WS_VT) + (size_t)l * 16384 * 1024;
    const int* PIDX = (const int*)(p.ws + WS_PIDX); const float* PG = (const float*)(p.ws + WS_PG);
    float* X = (float*)(p.ws + WS_XRES); const float* mod = (const float*)(p.ws + WS_MOD) + (size_t)l * 3 * MODW + 5 * D;
    const int lane = threadIdx.x & 63, gw = blockIdx.x * NWAVE + (threadIdx.x >> 6), nw = gridDim.x * NWAVE;
    for (int t = gw; t < NTOK; t += nw) {
        float hf[16]; { float a[8], b[8]; const uint4* hp = (const uint4*)(H + (size_t)t * D + lane * 16); unpack8(hp[0], a); unpack8(hp[1], b);
#pragma unroll
            for (int j = 0; j < 8; ++j) { hf[j] = a[j]; hf[8 + j] = b[j]; } }
        float acc[16];
#pragma unroll
        for (int j = 0; j < 16; ++j) acc[j] = 0.f;
#pragma unroll 4
        for (int k = 0; k < 128; ++k) {
            const int e = __builtin_amdgcn_readfirstlane(PIDX[(size_t)t * 128 + k]); const float gk = PG[(size_t)t * 128 + k];
            const uint4* up = (const uint4*)(UT + (size_t)e * D + lane * 16); const uint4* vp = (const uint4*)(VT + (size_t)e * D + lane * 16);
            const uint4 u0 = up[0], u1 = up[1], v0 = vp[0], v1 = vp[1];
            float ua[8], ub[8]; unpack8(u0, ua); unpack8(u1, ub);
            float d = 0.f;
#pragma unroll
            for (int j = 0; j < 8; ++j) { d = fmaf(ua[j], hf[j], d); d = fmaf(ub[j], hf[8 + j], d); }
            d = wave_sum(d);
            const float w = gk * gelu_tanh(d);
            float va[8], vb[8]; unpack8(v0, va); unpack8(v1, vb);
#pragma unroll
            for (int j = 0; j < 8; ++j) { acc[j] = fmaf(w, va[j], acc[j]); acc[8 + j] = fmaf(w, vb[j], acc[8 + j]); }
        }
        const float* g2 = mod + (size_t)row_sel(t) * MODW + lane * 16; float* xr = X + (size_t)t * D + lane * 16;
#pragma unroll
        for (int j = 0; j < 4; ++j) { float4 xv = ((float4*)xr)[j]; const float4 gv = ((const float4*)g2)[j];
            xv.x = fmaf(gv.x, acc[4 * j + 0], xv.x); xv.y = fmaf(gv.y, acc[4 * j + 1], xv.y); xv.z = fmaf(gv.z, acc[4 * j + 2], xv.z); xv.w = fmaf(gv.w, acc[4 * j + 3], xv.w);
            ((float4*)xr)[j] = xv; }
    }
}
__device__ __forceinline__ void phase_final(const P& p) {
    const float* X = (const float*)(p.ws + WS_XRES);
    const int lane = threadIdx.x & 63, gw = blockIdx.x * NWAVE + (threadIdx.x >> 6), nw = gridDim.x * NWAVE;
    for (int r = gw; r < NLAT; r += nw) {
        const float* xr = X + (size_t)r * D; float4 v[4]; float ss = 0.f;
#pragma unroll
        for (int i = 0; i < 4; ++i) { v[i] = *(const float4*)(xr + i * 256 + lane * 4); ss += v[i].x * v[i].x + v[i].y * v[i].y + v[i].z * v[i].z + v[i].w * v[i].w; }
        ss = wave_sum(ss); const float rs = rsqrtf(ss * (1.0f / D) + EPS);
#pragma unroll
        for (int i = 0; i < 4; ++i) { const int col = i * 256 + lane * 4; const float4 gv = *(const float4*)(p.final_norm_g + col);
            float4 o; o.x = v[i].x * rs * gv.x; o.y = v[i].y * rs * gv.y; o.z = v[i].z * rs * gv.z; o.w = v[i].w * rs * gv.w;
            *(float4*)(p.out + (size_t)r * D + col) = o; }
    }
}
__device__ __forceinline__ void phase_gemm_in(const P& p, int l, LAS unsigned char* lds) {
    pg8::Gemm g{(const bf16_t*)(p.ws + WS_H), (const bf16_t*)(p.ws + WS_WIN) + (size_t)l * IN_W * D, NTOK, IN_W, D};
    pg8::StaticOrder S; S.init(NTOK, IN_W, (int)gridDim.x, (int)blockIdx.x);
    pg8::EpiStoreBf16 E{(bf16_t*)(p.ws + WS_PROJ), IN_W};
    pg8::gemm_phase<pg8::EpiStoreBf16, pg8::StaticOrder, false>(lds, g, S, E, nullptr);
}
__device__ __forceinline__ void phase_gemm_out(const P& p, int l, LAS unsigned char* lds) {
    pg8::Gemm g{(const bf16_t*)(p.ws + WS_YCAT), (const bf16_t*)(p.ws + WS_WOUT) + (size_t)l * D * D, NTOK, D, D};
    pg8::StaticOrder S; S.init(NTOK, D, (int)gridDim.x, (int)blockIdx.x);
    pg8::EpiResid E{(float*)(p.ws + WS_XRES), D, (const float*)(p.ws + WS_MOD) + (size_t)l * 3 * MODW + 2 * D, MODW};
    pg8::gemm_phase<pg8::EpiResid, pg8::StaticOrder, false>(lds, g, S, E, nullptr);
}
__device__ __forceinline__ void phase_gemm_q(const P& p, int l, LAS unsigned char* lds) {
    pg8::Gemm g{(const bf16_t*)(p.ws + WS_H), (const bf16_t*)(p.ws + WS_WQ) + (size_t)l * QW * D, NTOK, QW, D};
    pg8::StaticOrder S; S.init(NTOK, QW, (int)gridDim.x, (int)blockIdx.x);
    pg8::EpiStoreBf16 E{(bf16_t*)(p.ws + WS_Q), QW};
    pg8::gemm_phase<pg8::EpiStoreBf16, pg8::StaticOrder, false>(lds, g, S, E, nullptr);
}

enum { PH_PRO = 0, PH_ADALN, PH_NORM1, PH_GEMM_IN, PH_CONV, PH_SGU, PH_NA, PH_GEMM_OUT, PH_NORM2, PH_GEMM_Q, PH_TOPK, PH_GATHER, PH_FINAL };
template <int PH> __global__ void __launch_bounds__(NTHR, 2) k_phase(P p, int l) {
    extern __shared__ __attribute__((aligned(16))) unsigned char shm[];
    LAS unsigned char* lds = (LAS unsigned char*)shm;
    if (PH == PH_PRO) phase_prologue(p, lds);
    if (PH == PH_ADALN) phase_adaln(p, lds);
    if (PH == PH_NORM1) phase_norm(p, l, 0);
    if (PH == PH_GEMM_IN) phase_gemm_in(p, l, lds);
    if (PH == PH_CONV) phase_conv(p, l);
    if (PH == PH_SGU) phase_sgu(p, l, lds);
    if (PH == PH_NA) phase_na(p, l, lds);
    if (PH == PH_GEMM_OUT) phase_gemm_out(p, l, lds);
    if (PH == PH_NORM2) phase_norm(p, l, 1);
    if (PH == PH_GEMM_Q) phase_gemm_q(p, l, lds);
    if (PH == PH_TOPK) phase_topk(p, l, lds);
    if (PH == PH_GATHER) phase_gather(p, l);
    if (PH == PH_FINAL) phase_final(p);
}

template <int PH> static void launch_phase(const P& p, int l, int grid, hipStream_t stream) {
    static bool attr_done = false;
    if (!attr_done) { (void)hipFuncSetAttribute((const void*)k_phase<PH>, hipFuncAttributeMaxDynamicSharedMemorySize, LDS_BYTES); attr_done = true; }
    hipLaunchKernelGGL(k_phase<PH>, dim3(grid), dim3(NTHR), LDS_BYTES, stream, p, l);
}

extern "C" void kernel_launch(void* const* d_in, const int* in_sizes, int n_in, void* d_out, int out_size, void* d_ws, size_t ws_size, hipStream_t stream) {
    static int grid = 0;
    if (grid == 0) {
        if (n_in != 21 || ws_size < WS_END) { fprintf(stderr, "kernel_launch: expected 21 inputs and >= %zu bytes of workspace, got %d and %zu\n", (size_t)WS_END, n_in, ws_size); grid = -1; return; }
        int dev = 0, cus = 0;
        if (hipGetDevice(&dev) != hipSuccess || hipDeviceGetAttribute(&cus, hipDeviceAttributeMultiprocessorCount, dev) != hipSuccess || cus <= 0) cus = 256;
        grid = cus;
    }
    if (grid < 0) return;
    P p{};
    const float** pf = (const float**)&p;
    for (int i = 0; i < 21; ++i) pf[i] = (const float*)d_in[i];
    p.out = (float*)d_out; p.ws = (unsigned char*)d_ws;
    launch_phase<PH_PRO>(p, 0, grid, stream);
    launch_phase<PH_ADALN>(p, 0, grid, stream);
    for (int l = 0; l < DEPTH; ++l) {
        launch_phase<PH_NORM1>(p, l, grid, stream);
        launch_phase<PH_GEMM_IN>(p, l, grid, stream);
        launch_phase<PH_CONV>(p, l, grid, stream);
        launch_phase<PH_SGU>(p, l, grid, stream);
        launch_phase<PH_NA>(p, l, grid, stream);
        launch_phase<PH_GEMM_OUT>(p, l, grid, stream);
        launch_phase<PH_NORM2>(p, l, grid, stream);
        launch_phase<PH_GEMM_Q>(p, l, grid, stream);
        launch_phase<PH_TOPK>(p, l, grid, stream);
        launch_phase<PH_GATHER>(p, l, grid, stream);
    }
    launch_phase<PH_FINAL>(p, 0, grid, stream);
}
```

```cpp
#include <hip/hip_runtime.h>
#include <cstdio>
#include <cstdint>
#include <utility>

#ifndef ONE_LAUNCH
#define ONE_LAUNCH 0
#endif

namespace pg8 {
#define PG8_LAS __attribute__((address_space(3)))
typedef unsigned short bf16_t;
typedef short bf16x8 __attribute__((ext_vector_type(8)));
typedef float f32x4 __attribute__((ext_vector_type(4)));
typedef unsigned u32x4 __attribute__((ext_vector_type(4)));
constexpr int BM = 256, BK = 64, HALF = 128, HTB = HALF * BK * 2  , STAGE_BYTES = 8 * HTB, NXCD = 8, WGM = 8;

__host__ __device__ __forceinline__ int lds_byte(int r, int c) { const int st = (r >> 4) * 2 + (c >> 5), rr = r & 15, cc = c & 31, ob = rr * 64 + cc * 2; return st * 1024 + (ob ^ (((ob >> 9) & 1) << 5)); }
__host__ __device__ __forceinline__ void stage_rc(int b, int& R, int& C) { const int st = b / 1024, sb = b % 1024, swz = sb ^ (((sb >> 9) & 1) << 5); R = (st >> 1) * 16 + swz / 64; C = (st & 1) * 32 + (swz % 64) / 2; }
__host__ __device__ __forceinline__ int perm32(int rho) { const int n = rho >> 4, i = rho & 15; return 8 * (i >> 2) + 4 * n + (i & 3); }

struct Unit { int pm, pn; };
struct Gemm { const bf16_t* A; const bf16_t* Bt; int M, N, K; size_t vbytes; };
__host__ __device__ __forceinline__ int panel_sel(int pm) { return pm < 64 ? 0 : (pm < 128 ? 1 : 2); }

struct StaticOrder {
    int nM, nN, nwg, G, c;
    __host__ __device__ void init(int M, int N, int G_, int c_) { nM = M / BM; nN = N / BM; nwg = nM * nN; G = G_; c = c_; }
    __host__ __device__ bool next(int i, Unit& u) const {
        const long L = (long)i * G + c; if (L >= nwg) return false;
        int wgid = (int)L; { const int q = nwg / NXCD, r = nwg % NXCD, xcd = wgid % NXCD, off = wgid / NXCD; wgid = (xcd < r ? xcd * (q + 1) : r * (q + 1) + (xcd - r) * q) + off; }
        const int nig = WGM * nN, gid = wgid / nig, fm = gid * WGM, gsz = (nM - fm) < WGM ? (nM - fm) : WGM;
        u.pm = fm + ((wgid % nig) % gsz); u.pn = (wgid % nig) / gsz; return true;
    }
    __device__ __forceinline__ void a_ready(const Unit&) const {}
    __device__ __forceinline__ void done(const Unit&) const {}
};

__device__ __forceinline__ unsigned cvt_pk_bf16(float lo, float hi) { unsigned r; asm volatile("v_cvt_pk_bf16_f32 %0, %1, %2" : "=v"(r) : "v"(lo), "v"(hi)); return r; }

struct EpiStoreBf16 {
    static constexpr bool PERM = true, AFTER_DRAIN = false;
    bf16_t* O; int ldc;
    __device__ __forceinline__ void operator()(const f32x4 (&acc)[2][2][4][2], const Unit& u, int wr, int wc, int fr, int fq) const {
        const int row0 = u.pm * BM + wr * 64 + fr, col0 = u.pn * BM + wc * 32 + 8 * fq;
#pragma unroll
        for (int ai = 0; ai < 2; ++ai)
#pragma unroll
            for (int m = 0; m < 4; ++m) { bf16_t* rowp = O + (size_t)(row0 + ai * HALF + m * 16) * ldc + col0;
#pragma unroll
                for (int bj = 0; bj < 2; ++bj) { const f32x4 v0 = acc[ai][bj][m][0], v1 = acc[ai][bj][m][1];
                    u32x4 w; w.x = cvt_pk_bf16(v0[0], v0[1]); w.y = cvt_pk_bf16(v0[2], v0[3]); w.z = cvt_pk_bf16(v1[0], v1[1]); w.w = cvt_pk_bf16(v1[2], v1[3]);
                    *(u32x4*)(rowp + bj * HALF) = w; } }
    }
};
__device__ __forceinline__ float sq8_bf16(const u32x4 w) {
    float s = 0.f;
#pragma unroll
    for (int i = 0; i < 4; ++i) { const float lo = __uint_as_float(w[i] << 16), hi = __uint_as_float(w[i] & 0xffff0000u); s = __builtin_fmaf(lo, lo, s); s = __builtin_fmaf(hi, hi, s); }
    return s; }
__device__ __forceinline__ float x4sum(float x) {
    auto s = __builtin_amdgcn_permlane16_swap(__float_as_uint(x), __float_as_uint(x), false, false); x = __uint_as_float(s[0]) + __uint_as_float(s[1]);
    auto t = __builtin_amdgcn_permlane32_swap(__float_as_uint(x), __float_as_uint(x), false, false); return __uint_as_float(t[0]) + __uint_as_float(t[1]); }
template <int NSS> struct EpiScaleBias {
    static constexpr bool PERM = true, AFTER_DRAIN = false;
    bf16_t* O; int ldc; const float* ssp; const float* bias;
    __device__ __forceinline__ void operator()(const f32x4 (&acc)[2][2][4][2], const Unit& u, int wr, int wc, int fr, int fq) const {
        const int row0 = u.pm * BM + wr * 64 + fr, col0 = u.pn * BM + wc * 32 + 8 * fq;
        const float* bp = bias + (size_t)panel_sel(u.pm) * 2 * ldc + col0;
        f32x4 bv[2][2];
#pragma unroll
        for (int bj = 0; bj < 2; ++bj)
#pragma unroll
            for (int n = 0; n < 2; ++n) bv[bj][n] = *(const f32x4*)(bp + bj * HALF + 4 * n) + *(const f32x4*)(bp + ldc + bj * HALF + 4 * n);
#pragma unroll
        for (int ai = 0; ai < 2; ++ai) {
            float rs[4];
#pragma unroll
            for (int m = 0; m < 4; ++m) { const float* sp = ssp + (size_t)(row0 + ai * HALF + m * 16) * NSS + (NSS / 4) * fq; float sq;
                if constexpr (NSS == 16) { const f32x4 pv = *(const f32x4*)sp; sq = (pv[0] + pv[1]) + (pv[2] + pv[3]); } else sq = sp[0];
                sq = x4sum(sq);
                rs[m] = __builtin_amdgcn_rsqf(sq * (1.0f / 1024.0f) + 1e-6f); }
#pragma unroll
            for (int m = 0; m < 4; ++m) { bf16_t* rowp = O + (size_t)(row0 + ai * HALF + m * 16) * ldc + col0;
#pragma unroll
                for (int bj = 0; bj < 2; ++bj) { const f32x4 v0 = rs[m] * acc[ai][bj][m][0] + bv[bj][0], v1 = rs[m] * acc[ai][bj][m][1] + bv[bj][1];
                    u32x4 w; w.x = cvt_pk_bf16(v0[0], v0[1]); w.y = cvt_pk_bf16(v0[2], v0[3]); w.z = cvt_pk_bf16(v1[0], v1[1]); w.w = cvt_pk_bf16(v1[2], v1[3]);
                    *(u32x4*)(rowp + bj * HALF) = w; } }
        }
    }
};
struct EpiResid {
    static constexpr bool PERM = true, AFTER_DRAIN = false;
    bf16_t* X; const float* Xlat; const float* Xctx; int ldc; const float* gate; int gate_stride; float* ssp;
    __device__ __forceinline__ void operator()(const f32x4 (&acc)[2][2][4][2], const Unit& u, int wr, int wc, int fr, int fq) const {
        const int row0 = u.pm * BM + wr * 64 + fr, col0 = u.pn * BM + wc * 32 + 8 * fq;
        const float* gp = gate + (size_t)(u.pm < 64 ? 0 : (u.pm < 128 ? 1 : 2)) * gate_stride + col0;
        f32x4 gv[2][2];
#pragma unroll
        for (int bj = 0; bj < 2; ++bj)
#pragma unroll
            for (int n = 0; n < 2; ++n) gv[bj][n] = *(const f32x4*)(gp + bj * HALF + 4 * n);
        float sq[2][4] = {{0.f, 0.f, 0.f, 0.f}, {0.f, 0.f, 0.f, 0.f}};
        if (Xlat != nullptr) {
#pragma unroll
            for (int am = 0; am < 2; ++am)
#pragma unroll
                for (int mh = 0; mh < 2; ++mh) {
                    f32x4 xv[2][2][2];
#pragma unroll
                    for (int m2 = 0; m2 < 2; ++m2) { const int row = row0 + am * HALF + (2 * mh + m2) * 16; const float* rowp = (u.pm < 128 ? Xlat + (size_t)row * ldc : Xctx + (size_t)(row - 32768) * ldc) + col0;
#pragma unroll
                        for (int bj = 0; bj < 2; ++bj)
#pragma unroll
                            for (int n = 0; n < 2; ++n) xv[m2][bj][n] = *(const f32x4*)(rowp + bj * HALF + 4 * n); }
#pragma unroll
                    for (int m2 = 0; m2 < 2; ++m2) { const int m = 2 * mh + m2; bf16_t* rowp = X + (size_t)(row0 + am * HALF + m * 16) * ldc + col0;
#pragma unroll
                        for (int bj = 0; bj < 2; ++bj) { const f32x4 v0 = xv[m2][bj][0] + gv[bj][0] * acc[am][bj][m][0], v1 = xv[m2][bj][1] + gv[bj][1] * acc[am][bj][m][1];
                            u32x4 w; w.x = cvt_pk_bf16(v0[0], v0[1]); w.y = cvt_pk_bf16(v0[2], v0[3]); w.z = cvt_pk_bf16(v1[0], v1[1]); w.w = cvt_pk_bf16(v1[2], v1[3]);
                            sq[am][m] += sq8_bf16(w);
                            *(u32x4*)(rowp + bj * HALF) = w; } }
                }
        } else {
#pragma unroll
            for (int am = 0; am < 2; ++am) {
                u32x4 xb[4][2];
#pragma unroll
                for (int m = 0; m < 4; ++m) { const bf16_t* rowp = X + (size_t)(row0 + am * HALF + m * 16) * ldc + col0;
#pragma unroll
                    for (int bj = 0; bj < 2; ++bj) xb[m][bj] = *(const u32x4*)(rowp + bj * HALF); }
#pragma unroll
                for (int m = 0; m < 4; ++m) { bf16_t* rowp = X + (size_t)(row0 + am * HALF + m * 16) * ldc + col0;
#pragma unroll
                    for (int bj = 0; bj < 2; ++bj) { const u32x4 b = xb[m][bj]; const f32x4 g0 = gv[bj][0], g1 = gv[bj][1], a0 = acc[am][bj][m][0], a1 = acc[am][bj][m][1];
                        u32x4 w;
                        w.x = cvt_pk_bf16(__uint_as_float(b.x << 16) + g0[0] * a0[0], __uint_as_float(b.x & 0xffff0000u) + g0[1] * a0[1]);
                        w.y = cvt_pk_bf16(__uint_as_float(b.y << 16) + g0[2] * a0[2], __uint_as_float(b.y & 0xffff0000u) + g0[3] * a0[3]);
                        w.z = cvt_pk_bf16(__uint_as_float(b.z << 16) + g1[0] * a1[0], __uint_as_float(b.z & 0xffff0000u) + g1[1] * a1[1]);
                        w.w = cvt_pk_bf16(__uint_as_float(b.w << 16) + g1[2] * a1[2], __uint_as_float(b.w & 0xffff0000u) + g1[3] * a1[3]);
                        sq[am][m] += sq8_bf16(w);
                        *(u32x4*)(rowp + bj * HALF) = w; } }
            }
        }
#pragma unroll
        for (int am = 0; am < 2; ++am)
#pragma unroll
            for (int m = 0; m < 4; ++m) { const float t = x4sum(sq[am][m]); if (fq == 0) ssp[(size_t)(row0 + am * HALF + m * 16) * 16 + 4 * u.pn + wc] = t; }
    }
};

template <class Epi, class Sched, bool STAMP = false>
__device__ __forceinline__ void gemm_phase(PG8_LAS unsigned char* lds, const Gemm g, const Sched& S, const Epi& E, unsigned long long* stamps) {
    int tid_ = threadIdx.x; asm volatile("" : "+v"(tid_));
    const int tid = tid_, wid = __builtin_amdgcn_readfirstlane(tid >> 6), lane = tid & 63, wr = wid >> 2, wc = wid & 3, fr = lane & 15, fq = lane >> 4;
    const int K = g.K, nt = K / BK;
    int ts_lo = 0, ts_hi = 0, nts = 0; const unsigned long long rt_entry = STAMP ? (unsigned long long)wall_clock64() : 0ull;
#define PG8_STAMP() do { if (STAMP && wid == 0 && nts < 64) { const unsigned long long _c = (unsigned long long)clock64(); \
        ts_lo = (lane == nts) ? (int)(unsigned)_c : ts_lo; ts_hi = (lane == nts) ? (int)(unsigned)(_c >> 32) : ts_hi; ++nts; } } while (0)
    PG8_STAMP();
    unsigned voffA[2], voffB[2];
#pragma unroll
    for (int i = 0; i < 2; ++i) { int R, C; stage_rc(tid * 16 + i * 8192, R, C); const int Rb = Epi::PERM ? ((R & ~31) + perm32(R & 31)) : R;
        voffA[i] = (unsigned)(R * K + C) * 2u; voffB[i] = (unsigned)(Rb * K + C) * 2u; }
    const size_t kstep = (size_t)(BK * 2);
    const size_t hstep = (size_t)HALF * K * 2;
    const size_t tstep = 2 * hstep;
    const unsigned ldsw = (unsigned)wid * 1024u;
    const int aoff = lds_byte(wr * 64 + fr, fq * 8), boff = lds_byte(wc * 32 + fr, fq * 8);
#define PG8_SA(b, h) (((b) * 2 + (h)) * HTB)
#define PG8_SB(b, h) ((4 + (b) * 2 + (h)) * HTB)
#define PG8_STAGE(bufoff, gbase, voff) do { _Pragma("unroll") for (int _i = 0; _i < 2; ++_i) \
        __builtin_amdgcn_global_load_lds((const unsigned*)((const char*)(gbase) + (voff)[_i]), (PG8_LAS unsigned*)(lds + (bufoff) + ldsw + _i * 8192), 16, 0, 0); } while (0)
#define PG8_LDA(dst, b, h) do { _Pragma("unroll") for (int m = 0; m < 4; ++m) _Pragma("unroll") for (int k = 0; k < 2; ++k) dst[m][k] = *(const PG8_LAS bf16x8*)(lds + PG8_SA(b, h) + aoff + m * 2048 + k * 1024); } while (0)
#define PG8_LDB(dst, b, h) do { _Pragma("unroll") for (int n = 0; n < 2; ++n) _Pragma("unroll") for (int k = 0; k < 2; ++k) dst[n][k] = *(const PG8_LAS bf16x8*)(lds + PG8_SB(b, h) + boff + n * 2048 + k * 1024); } while (0)
#define PG8_MMA(ai, bj, At, Bt) do { __builtin_amdgcn_s_setprio(1); _Pragma("unroll") for (int m = 0; m < 4; ++m) _Pragma("unroll") for (int n = 0; n < 2; ++n) _Pragma("unroll") for (int k = 0; k < 2; ++k) \
        acc[ai][bj][m][n] = __builtin_amdgcn_mfma_f32_16x16x32_bf16(Bt[n][k], At[m][k], acc[ai][bj][m][n], 0, 0, 0); __builtin_amdgcn_s_setprio(0); } while (0)
#define PG8_WAIT_V(n) asm volatile("s_waitcnt vmcnt(" #n ")" ::: "memory")
#define PG8_WAIT_L(n) asm volatile("s_waitcnt lgkmcnt(" #n ")" ::: "memory")
#define PG8_BAR __builtin_amdgcn_s_barrier()
#define PG8_SCHED __builtin_amdgcn_sched_barrier(0)
    Unit cur, nxt; int ui = 0;
    if (!S.next(0, cur)) return;
    f32x4 acc[2][2][4][2];
#pragma unroll
    for (int a = 0; a < 2; ++a)
#pragma unroll
        for (int b = 0; b < 2; ++b)
#pragma unroll
            for (int m = 0; m < 4; ++m)
#pragma unroll
                for (int n = 0; n < 2; ++n) acc[a][b][m][n] = (f32x4){0.f, 0.f, 0.f, 0.f};
    bf16x8 At[4][2], B0[2][2], B1[2][2];
    const char* cA = (const char*)g.A + (size_t)cur.pm * tstep; const char* cB = (const char*)g.Bt + (size_t)cur.pn * tstep + (size_t)panel_sel(cur.pm) * g.vbytes;
    S.a_ready(cur);
    PG8_STAGE(PG8_SB(0, 0), cB, voffB); PG8_STAGE(PG8_SA(0, 0), cA, voffA); PG8_STAGE(PG8_SB(0, 1), cB + hstep, voffB); PG8_STAGE(PG8_SA(0, 1), cA + hstep, voffA);
    if (wr == 1) PG8_BAR;
    PG8_WAIT_V(4); PG8_BAR;
    PG8_STAGE(PG8_SB(1, 0), cB + kstep, voffB); PG8_STAGE(PG8_SA(1, 0), cA + kstep, voffA); PG8_STAGE(PG8_SB(1, 1), cB + hstep + kstep, voffB);
    PG8_WAIT_V(6); PG8_BAR;
    PG8_STAMP();
    for (;;) {
        const bool has_next = S.next(ui + 1, nxt);
        const char* nA = has_next ? (const char*)g.A + (size_t)nxt.pm * tstep : cA; const char* nB = has_next ? (const char*)g.Bt + (size_t)nxt.pn * tstep + (size_t)panel_sel(nxt.pm) * g.vbytes : cB;
        for (int t = 0; t < nt; t += 2) {
            const bool last = (t == nt - 2);
            const char* a1 = cA + (size_t)(t + 1) * kstep;
            const char* a2 = last ? nA : cA + (size_t)(t + 2) * kstep; const char* b2 = last ? nB : cB + (size_t)(t + 2) * kstep;
            const char* a3 = a2 + kstep; const char* b3 = b2 + kstep;
            if (last && has_next) S.a_ready(nxt);
            PG8_LDB(B0, 0, 0); PG8_SCHED; PG8_LDA(At, 0, 0); PG8_STAGE(PG8_SA(1, 1), a1 + hstep, voffA);
            PG8_WAIT_L(8); PG8_BAR; PG8_WAIT_L(0); PG8_MMA(0, 0, At, B0); PG8_BAR; PG8_SCHED;
            PG8_LDB(B1, 0, 1); PG8_STAGE(PG8_SB(0, 0), b2, voffB);
            PG8_BAR; PG8_WAIT_L(0); PG8_MMA(0, 1, At, B1); PG8_BAR;
            PG8_LDA(At, 0, 1); PG8_STAGE(PG8_SA(0, 0), a2, voffA);
            PG8_BAR; PG8_WAIT_L(0); PG8_MMA(1, 0, At, B0); PG8_BAR; PG8_SCHED;
            PG8_STAGE(PG8_SB(0, 1), b2 + hstep, voffB);
            PG8_WAIT_V(6); PG8_BAR; PG8_MMA(1, 1, At, B1); PG8_BAR;
            PG8_LDB(B0, 1, 0); PG8_SCHED; PG8_LDA(At, 1, 0); PG8_STAGE(PG8_SA(0, 1), a2 + hstep, voffA);
            PG8_WAIT_L(8); PG8_BAR; PG8_WAIT_L(0); PG8_MMA(0, 0, At, B0); PG8_BAR; PG8_SCHED;
            PG8_LDB(B1, 1, 1); PG8_STAGE(PG8_SB(1, 0), b3, voffB);
            PG8_BAR; PG8_WAIT_L(0); PG8_MMA(0, 1, At, B1); PG8_BAR;
            PG8_LDA(At, 1, 1); PG8_STAGE(PG8_SA(1, 0), a3, voffA);
            PG8_BAR; PG8_WAIT_L(0); PG8_MMA(1, 0, At, B0); PG8_BAR; PG8_SCHED;
            PG8_STAGE(PG8_SB(1, 1), b3 + hstep, voffB);
            PG8_WAIT_V(6); PG8_BAR; PG8_MMA(1, 1, At, B1); PG8_BAR;
        }
        PG8_STAMP();
        if constexpr (!Epi::AFTER_DRAIN) { E(acc, cur, wr, wc, fr, fq); S.done(cur); }
        PG8_STAMP();
        if (!has_next) break;
#pragma unroll
        for (int a = 0; a < 2; ++a)
#pragma unroll
            for (int b = 0; b < 2; ++b)
#pragma unroll
                for (int m = 0; m < 4; ++m)
#pragma unroll
                    for (int n = 0; n < 2; ++n) acc[a][b][m][n] = (f32x4){0.f, 0.f, 0.f, 0.f};
        cur = nxt; cA = nA; cB = nB; ++ui;
    }
    PG8_WAIT_V(0);
    if (wr == 0) PG8_BAR;
    PG8_BAR;
    if constexpr (Epi::AFTER_DRAIN) { E.fused(acc, cur, wr, wc, fr, fq, lds, wid, lane); S.done(cur); }
    PG8_STAMP();
    if (STAMP && wid == 0) { stamps[lane] = lane < nts ? (((unsigned long long)(unsigned)ts_hi << 32) | (unsigned)ts_lo) : 0ull;
        if (lane == 62) stamps[62] = rt_entry; if (lane == 63) stamps[63] = (unsigned long long)wall_clock64(); }
#undef PG8_STAMP
#undef PG8_SA
#undef PG8_SB
#undef PG8_STAGE
#undef PG8_LDA
#undef PG8_LDB
#undef PG8_MMA
#undef PG8_WAIT_V
#undef PG8_WAIT_L
#undef PG8_BAR
#undef PG8_SCHED
}
}

#define LAS __attribute__((address_space(3)))
typedef unsigned short bf16_t;
constexpr int D = 1024, T = 16384, NLAT = 32768, CTXL = 256, NTOK = 33280, DEPTH = 4;
constexpr int IN_W = 2816, QW = 2048;
constexpr int C_GB = 0, C_GC = 256, C_XI = 512, C_SU = 768, C_SV = 1024, C_Q = 1280, C_K = 1792, C_V = 2304;
constexpr int MODW = 6144;
constexpr float EPS = 1e-6f;
constexpr int NTHR = 512, NWAVE = 8;
constexpr int ST_OFF = 131072 + 1024 + 20480 + 2048;
constexpr int LDS_BYTES = ST_OFF + 1024;

constexpr size_t MiB = 1u << 20;
constexpr size_t WS_CTL = 0;
constexpr size_t WS_MOD = 1 * MiB;
constexpr size_t WS_US = 1 * MiB + 512 * 1024;
constexpr size_t WS_VS = 1 * MiB + 768 * 1024;
constexpr size_t WS_WIN = 2 * MiB;
constexpr size_t WS_WOUT = WS_WIN + 22 * MiB;
constexpr size_t WS_WQ = WS_WOUT + 8 * MiB;
constexpr size_t WS_SUBK = WS_WQ + 16 * MiB;
constexpr size_t WS_UT = WS_SUBK + 2 * MiB;
constexpr size_t WS_VT = WS_UT + 128 * MiB;
constexpr size_t WS_XRES = WS_VT + 128 * MiB;
constexpr size_t WS_H = WS_XRES + 130 * MiB;
constexpr size_t WS_PROJ = WS_H + 65 * MiB;
constexpr size_t WS_H4 = WS_PROJ + 96 * MiB;
constexpr size_t WS_PW4 = WS_PROJ + 150 * MiB;
constexpr size_t WS_YCAT = WS_PROJ + 179 * MiB;
constexpr size_t WS_Q = WS_YCAT + 65 * MiB;
constexpr size_t WS_PIDX = WS_Q + 130 * MiB;
constexpr size_t WS_PG = WS_PIDX + 17 * MiB;
constexpr size_t WS_SGUW = WS_PG + 16 * MiB + 512 * 1024;
constexpr size_t WS_END = WS_PG + 17 * MiB;
constexpr size_t WS_WIN3 = WS_UT + 32 * MiB;
constexpr size_t WS_BIASP = WS_XRES + 65 * MiB;
constexpr size_t WS_WQ3 = WS_VT + 32 * MiB;
constexpr size_t WS_BIASP2 = WS_XRES + 65 * MiB + 512 * 1024;
constexpr size_t WS_SSP2 = WS_XRES + 70 * MiB;
constexpr size_t WS_SSP = WS_XRES + 66 * MiB;

struct P {
    const float *x, *c, *ctx, *c_ctx, *ada_w, *ada_b, *norm1_g, *w_in, *conv_w, *sgu_w, *sgu_b, *sgu_norm_g, *na_rpb, *out_norm_g, *w_out, *norm2_g,
                *peer_wq, *peer_subkeys, *peer_u, *peer_v, *final_norm_g;
    float* out; unsigned char* ws;
};

__device__ __forceinline__ float bf_lo(unsigned u) { return __uint_as_float(u << 16); }
__device__ __forceinline__ float bf_hi(unsigned u) { return __uint_as_float(u & 0xffff0000u); }
__device__ __forceinline__ float bf1(bf16_t b) { return __uint_as_float(((unsigned)b) << 16); }
__device__ __forceinline__ unsigned pk_bf16(float lo, float hi) { return pg8::cvt_pk_bf16(lo, hi); }
__device__ __forceinline__ float wave_sum(float v) {
#pragma unroll
    for (int o = 32; o >= 1; o >>= 1) v += __shfl_xor(v, o);
    return v; }
__device__ __forceinline__ float wave_max(float v) {
#pragma unroll
    for (int o = 32; o >= 1; o >>= 1) v = fmaxf(v, __shfl_xor(v, o));
    return v; }
__device__ __forceinline__ float gelu_tanh(float x) {
    const float y = 0.7978845608f * (x + 0.044715f * x * x * x);
    const float e = __expf(2.0f * y);
    const float th = 1.0f - 2.0f * __builtin_amdgcn_rcpf(1.0f + e);
    return 0.5f * x * (1.0f + th); }
__device__ __forceinline__ void unpack8(const uint4 v, float (&f)[8]) {
    f[0] = bf_lo(v.x); f[1] = bf_hi(v.x); f[2] = bf_lo(v.y); f[3] = bf_hi(v.y); f[4] = bf_lo(v.z); f[5] = bf_hi(v.z); f[6] = bf_lo(v.w); f[7] = bf_hi(v.w); }
__device__ __forceinline__ float dot8(const uint4 a, const uint4 b, float acc) {
    acc = fmaf(bf_lo(a.x), bf_lo(b.x), acc); acc = fmaf(bf_hi(a.x), bf_hi(b.x), acc);
    acc = fmaf(bf_lo(a.y), bf_lo(b.y), acc); acc = fmaf(bf_hi(a.y), bf_hi(b.y), acc);
    acc = fmaf(bf_lo(a.z), bf_lo(b.z), acc); acc = fmaf(bf_hi(a.z), bf_hi(b.z), acc);
    acc = fmaf(bf_lo(a.w), bf_lo(b.w), acc); acc = fmaf(bf_hi(a.w), bf_hi(b.w), acc);
    return acc; }
__device__ __forceinline__ int row_sel(int r) { return r < T ? 0 : (r < NLAT ? 1 : 2); }

__device__ __forceinline__ int otid() { int t = threadIdx.x; asm volatile("" : "+v"(t)); return t; }

__device__ __forceinline__ int owave() { return __builtin_amdgcn_readfirstlane(otid() >> 6); }

__device__ __forceinline__ void transpose_cvt(const float* src, int K, int N, bf16_t* dst, LAS float* tile) {
    const int tid = otid(), tn = N / 64, ntile = (K / 64) * tn;
    const int kk = tid >> 4, nn = (tid & 15) * 4;
    float4 v[2];
    if ((int)blockIdx.x < ntile) { const int k0 = ((int)blockIdx.x / tn) * 64, n0 = ((int)blockIdx.x % tn) * 64;
#pragma unroll
        for (int i = 0; i < 2; ++i) v[i] = *(const float4*)(src + (size_t)(k0 + kk + 32 * i) * N + n0 + nn); }
    for (int t = blockIdx.x; t < ntile; t += gridDim.x) {
        const int k0 = (t / tn) * 64, n0 = (t % tn) * 64;
#pragma unroll
        for (int i = 0; i < 2; ++i) { const int k = kk + 32 * i;
            tile[k * 65 + nn + 0] = v[i].x; tile[k * 65 + nn + 1] = v[i].y; tile[k * 65 + nn + 2] = v[i].z; tile[k * 65 + nn + 3] = v[i].w; }
        __syncthreads();
        { const int t2 = t + (int)gridDim.x;
          if (t2 < ntile) { const int k2 = (t2 / tn) * 64, n2 = (t2 % tn) * 64;
#pragma unroll
              for (int i = 0; i < 2; ++i) v[i] = *(const float4*)(src + (size_t)(k2 + kk + 32 * i) * N + n2 + nn); } }
        const int n = tid >> 3, kc = (tid & 7) * 8;
        uint4 w;
        w.x = pk_bf16(tile[(kc + 0) * 65 + n], tile[(kc + 1) * 65 + n]); w.y = pk_bf16(tile[(kc + 2) * 65 + n], tile[(kc + 3) * 65 + n]);
        w.z = pk_bf16(tile[(kc + 4) * 65 + n], tile[(kc + 5) * 65 + n]); w.w = pk_bf16(tile[(kc + 6) * 65 + n], tile[(kc + 7) * 65 + n]);
        *(uint4*)(dst + (size_t)(n0 + n) * K + k0 + kc) = w;
        __syncthreads();
    }
}
__device__ __forceinline__ void cvt_copy(const float* src, bf16_t* dst, size_t n) {
    const size_t stride = (size_t)gridDim.x * NTHR;
    for (size_t i = (size_t)blockIdx.x * NTHR + otid(); i < n / 8; i += stride) {
        const float4 a = ((const float4*)src)[2 * i], b = ((const float4*)src)[2 * i + 1];
        uint4 w; w.x = pk_bf16(a.x, a.y); w.y = pk_bf16(a.z, a.w); w.z = pk_bf16(b.x, b.y); w.w = pk_bf16(b.z, b.w);
        ((uint4*)dst)[i] = w; }
}
typedef float f32x2_t __attribute__((ext_vector_type(2)));
__device__ __forceinline__ void quant_rows_fp4(const float* src, unsigned char* dst, float* scale, int nrows) {
    const int lane = otid() & 63, gw = blockIdx.x * NWAVE + owave(), nw = gridDim.x * NWAVE;
    float4 nx[4];
    { const float4* sp = (const float4*)(src + (size_t)(gw < nrows ? gw : 0) * 1024 + lane * 16); nx[0] = sp[0]; nx[1] = sp[1]; nx[2] = sp[2]; nx[3] = sp[3]; }
    for (int r = gw; r < nrows; r += nw) {
        const float4 a = nx[0], b = nx[1], c = nx[2], d = nx[3];
        { const int r2 = (r + nw < nrows) ? r + nw : r; const float4* sp = (const float4*)(src + (size_t)r2 * 1024 + lane * 16); nx[0] = sp[0]; nx[1] = sp[1]; nx[2] = sp[2]; nx[3] = sp[3]; }
        float m = fmaxf(fmaxf(fmaxf(fabsf(a.x), fabsf(a.y)), fmaxf(fabsf(a.z), fabsf(a.w))), fmaxf(fmaxf(fabsf(b.x), fabsf(b.y)), fmaxf(fabsf(b.z), fabsf(b.w))));
        m = fmaxf(m, fmaxf(fmaxf(fmaxf(fabsf(c.x), fabsf(c.y)), fmaxf(fabsf(c.z), fabsf(c.w))), fmaxf(fmaxf(fabsf(d.x), fabsf(d.y)), fmaxf(fabsf(d.z), fabsf(d.w)))));
        m = wave_max(m); m = fmaxf(m, 1e-30f);
        const float inv = 6.0f / m;
        unsigned w0 = 0u, w1 = 0u;
        w0 = __builtin_amdgcn_cvt_scalef32_pk_fp4_f32(w0, a.x * inv, a.y * inv, 1.0f, 0); w0 = __builtin_amdgcn_cvt_scalef32_pk_fp4_f32(w0, a.z * inv, a.w * inv, 1.0f, 1);
        w0 = __builtin_amdgcn_cvt_scalef32_pk_fp4_f32(w0, b.x * inv, b.y * inv, 1.0f, 2); w0 = __builtin_amdgcn_cvt_scalef32_pk_fp4_f32(w0, b.z * inv, b.w * inv, 1.0f, 3);
        w1 = __builtin_amdgcn_cvt_scalef32_pk_fp4_f32(w1, c.x * inv, c.y * inv, 1.0f, 0); w1 = __builtin_amdgcn_cvt_scalef32_pk_fp4_f32(w1, c.z * inv, c.w * inv, 1.0f, 1);
        w1 = __builtin_amdgcn_cvt_scalef32_pk_fp4_f32(w1, d.x * inv, d.y * inv, 1.0f, 2); w1 = __builtin_amdgcn_cvt_scalef32_pk_fp4_f32(w1, d.z * inv, d.w * inv, 1.0f, 3);
        *(uint2*)(dst + (size_t)r * 512 + lane * 8) = make_uint2(w0, w1);
        if (lane == 0) scale[r] = m * (1.0f / 6.0f);
    }
}
__device__ __forceinline__ void phase_prologue(const P& p, LAS unsigned char* lds) {
    unsigned char* ws = p.ws;
    transpose_cvt(p.w_in, D, IN_W, (bf16_t*)(ws + WS_WIN), (LAS float*)lds);
    transpose_cvt(p.w_out, D, D, (bf16_t*)(ws + WS_WOUT), (LAS float*)lds);
    cvt_copy(p.peer_subkeys, (bf16_t*)(ws + WS_SUBK), (size_t)DEPTH * 8 * 2 * 128 * 128);
    cvt_copy(p.sgu_w, (bf16_t*)(ws + WS_SGUW), (size_t)DEPTH * 4 * 128 * 128);
    quant_rows_fp4(p.peer_u, ws + WS_UT, (float*)(ws + WS_US), 16384);
    quant_rows_fp4(p.peer_v, ws + WS_VT, (float*)(ws + WS_VS), 16384);
}
constexpr int DEF_NCHUNK = 256 + 184;
__device__ __forceinline__ void deferred_chunk(const P& p, int L, int c, LAS unsigned char* lds) {
    unsigned char* ws = p.ws;
    const int tid = otid(), wave = __builtin_amdgcn_readfirstlane(tid >> 6), lane = tid & 63;
    if (c < 256) {
        const bool isv = c >= 128; const int row0 = (c & 127) * 128 + wave * 16;
        const float* src = (isv ? p.peer_v : p.peer_u) + ((size_t)L * 16384 + row0) * 1024 + lane * 16;
        unsigned char* dst = ws + (isv ? WS_VT : WS_UT) + ((size_t)L * 16384 + row0) * 512 + lane * 8;
        float* scale = (float*)(ws + (isv ? WS_VS : WS_US)) + (size_t)L * 16384 + row0;
        for (int r4 = 0; r4 < 16; r4 += 4) {
            float4 x[4][4];
#pragma unroll
            for (int q = 0; q < 4; ++q) { const float4* sp = (const float4*)(src + (size_t)(r4 + q) * 1024); x[q][0] = sp[0]; x[q][1] = sp[1]; x[q][2] = sp[2]; x[q][3] = sp[3]; }
#pragma unroll
            for (int q = 0; q < 4; ++q) {
                const float4 a = x[q][0], b = x[q][1], cc = x[q][2], d = x[q][3];
                float m = fmaxf(fmaxf(fmaxf(fabsf(a.x), fabsf(a.y)), fmaxf(fabsf(a.z), fabsf(a.w))), fmaxf(fmaxf(fabsf(b.x), fabsf(b.y)), fmaxf(fabsf(b.z), fabsf(b.w))));
                m = fmaxf(m, fmaxf(fmaxf(fmaxf(fabsf(cc.x), fabsf(cc.y)), fmaxf(fabsf(cc.z), fabsf(cc.w))), fmaxf(fmaxf(fabsf(d.x), fabsf(d.y)), fmaxf(fabsf(d.z), fabsf(d.w)))));
                m = wave_max(m); m = fmaxf(m, 1e-30f);
                const float inv = 6.0f / m;
                unsigned w0 = 0u, w1 = 0u;
                w0 = __builtin_amdgcn_cvt_scalef32_pk_fp4_f32(w0, a.x * inv, a.y * inv, 1.0f, 0); w0 = __builtin_amdgcn_cvt_scalef32_pk_fp4_f32(w0, a.z * inv, a.w * inv, 1.0f, 1);
                w0 = __builtin_amdgcn_cvt_scalef32_pk_fp4_f32(w0, b.x * inv, b.y * inv, 1.0f, 2); w0 = __builtin_amdgcn_cvt_scalef32_pk_fp4_f32(w0, b.z * inv, b.w * inv, 1.0f, 3);
                w1 = __builtin_amdgcn_cvt_scalef32_pk_fp4_f32(w1, cc.x * inv, cc.y * inv, 1.0f, 0); w1 = __builtin_amdgcn_cvt_scalef32_pk_fp4_f32(w1, cc.z * inv, cc.w * inv, 1.0f, 1);
                w1 = __builtin_amdgcn_cvt_scalef32_pk_fp4_f32(w1, d.x * inv, d.y * inv, 1.0f, 2); w1 = __builtin_amdgcn_cvt_scalef32_pk_fp4_f32(w1, d.z * inv, d.w * inv, 1.0f, 3);
                *(uint2*)(dst + (size_t)(r4 + q) * 512) = make_uint2(w0, w1);
                if (lane == 0) scale[r4 + q] = m * (1.0f / 6.0f);
            }
        }
    } else {
        LAS float* tile = (LAS float*)lds;
        const int kk = tid >> 4, nn = (tid & 15) * 4, n = tid >> 3, kc = (tid & 7) * 8;
        auto tile_of = [&](int q, const float*& src, bf16_t*& dst, int& N, int& k0, int& n0) { int t = (c - 256) * 8 + q;
            if (t < 704) { src = p.w_in + (size_t)L * D * IN_W; dst = (bf16_t*)(ws + WS_WIN3) + (size_t)(L - 1) * 3 * IN_W * D; N = IN_W; k0 = (t & 15) * 64; n0 = (t >> 4) * 64; return; }
            else if (t < 960) { t -= 704; src = p.w_out + (size_t)L * D * D; dst = (bf16_t*)(ws + WS_WOUT) + (size_t)L * D * D; N = D; }
            else { t -= 960; src = p.peer_wq + (size_t)L * D * QW; dst = (bf16_t*)(ws + WS_WQ3) + (size_t)L * 3 * QW * D; N = QW; k0 = (t & 15) * 64; n0 = (t >> 4) * 64; return; }
            const int tn = N / 64; k0 = (t / tn) * 64; n0 = (t % tn) * 64; };
        const int t0_ = (c - 256) * 8;
        const bool isq = t0_ >= 960, win = t0_ < 704 || isq;
        const float* gvec = (isq ? p.norm2_g : p.norm1_g) + (size_t)L * D; const int modoff = isq ? 3 * D : 0, Nw = isq ? QW : IN_W;
        float bacc[3] = {0.f, 0.f, 0.f};
        float4 v[2];
        { const float* src; bf16_t* dst; int N, k0, n0; tile_of(0, src, dst, N, k0, n0);
#pragma unroll
          for (int i = 0; i < 2; ++i) v[i] = *(const float4*)(src + (size_t)(k0 + kk + 32 * i) * N + n0 + nn); }
        for (int q = 0; q < 8; ++q) {
            const float* src; bf16_t* dst; int N, k0, n0; tile_of(q, src, dst, N, k0, n0);
#pragma unroll
            for (int i = 0; i < 2; ++i) { const int k = kk + 32 * i; tile[k * 65 + nn + 0] = v[i].x; tile[k * 65 + nn + 1] = v[i].y; tile[k * 65 + nn + 2] = v[i].z; tile[k * 65 + nn + 3] = v[i].w; }
            __syncthreads();
            if (q + 1 < 8) { const float* s2; bf16_t* d2; int N2, k2, n2; tile_of(q + 1, s2, d2, N2, k2, n2);
#pragma unroll
                for (int i = 0; i < 2; ++i) v[i] = *(const float4*)(s2 + (size_t)(k2 + kk + 32 * i) * N2 + n2 + nn); }
            float tv[8];
#pragma unroll
            for (int i = 0; i < 8; ++i) tv[i] = tile[(kc + i) * 65 + n];
            if (win) {
                const float4 g0 = *(const float4*)(gvec + k0 + kc), g1 = *(const float4*)(gvec + k0 + kc + 4);
#pragma unroll
                for (int m = 0; m < 3; ++m) { const float* mr = (const float*)(ws + WS_MOD) + (size_t)(L * 3 + m) * MODW + modoff + k0 + kc;
                    const float4 h0 = *(const float4*)mr, h1 = *(const float4*)(mr + 4), c0 = *(const float4*)(mr + D), c1 = *(const float4*)(mr + D + 4);
                    uint4 w;
                    w.x = pk_bf16(tv[0] * (g0.x * (1.0f + c0.x)), tv[1] * (g0.y * (1.0f + c0.y))); w.y = pk_bf16(tv[2] * (g0.z * (1.0f + c0.z)), tv[3] * (g0.w * (1.0f + c0.w)));
                    w.z = pk_bf16(tv[4] * (g1.x * (1.0f + c1.x)), tv[5] * (g1.y * (1.0f + c1.y))); w.w = pk_bf16(tv[6] * (g1.z * (1.0f + c1.z)), tv[7] * (g1.w * (1.0f + c1.w)));
                    *(uint4*)(dst + ((size_t)m * Nw + n0 + n) * D + k0 + kc) = w;
                    bacc[m] += ((tv[0] * h0.x + tv[1] * h0.y) + (tv[2] * h0.z + tv[3] * h0.w)) + ((tv[4] * h1.x + tv[5] * h1.y) + (tv[6] * h1.z + tv[7] * h1.w)); }
            } else {
                uint4 w;
                w.x = pk_bf16(tv[0], tv[1]); w.y = pk_bf16(tv[2], tv[3]); w.z = pk_bf16(tv[4], tv[5]); w.w = pk_bf16(tv[6], tv[7]);
                *(uint4*)(dst + (size_t)(n0 + n) * D + k0 + kc) = w; }
            __syncthreads();
        }
        if (win) {
            const int t0 = t0_ - (isq ? 960 : 0), n0 = (t0 >> 4) * 64, half = (t0 >> 3) & 1; float* bp_ = (float*)(ws + (isq ? WS_BIASP2 : WS_BIASP));
#pragma unroll
            for (int m = 0; m < 3; ++m) { float b = bacc[m]; b += __shfl_xor(b, 1); b += __shfl_xor(b, 2); b += __shfl_xor(b, 4);
                if ((tid & 7) == 0) bp_[((size_t)(L * 3 + m) * 2 + half) * Nw + n0 + n] = b; }
        }
    }
}
__device__ __forceinline__ void deferred_drain(const P& p, int L, LAS unsigned char* lds, int quota) {
    if (L >= DEPTH) return;
    volatile LAS unsigned* st = (volatile LAS unsigned*)(lds + ST_OFF);
    unsigned* ctr = (unsigned*)(p.ws + WS_CTL) + 6144 + 64 * L;
    for (int n = 0; n < quota; ++n) {
        __syncthreads();
        if (threadIdx.x == 0) st[12] = __hip_atomic_fetch_add(ctr, 1u, __ATOMIC_RELAXED, __HIP_MEMORY_SCOPE_AGENT);
        __syncthreads();
        const int c = (int)st[12];
        if (c >= DEF_NCHUNK) break;
        deferred_chunk(p, L, c, lds);
    }
    __syncthreads();
}
__device__ __forceinline__ void phase_adaln(const P& p, LAS unsigned char* lds) {
    LAS float* sl = (LAS float*)lds; LAS float* part = sl + 3072;
    const int tid = otid(), wave = __builtin_amdgcn_readfirstlane(tid >> 6), lane = tid & 63;
    for (int i = tid; i < 3072; i += NTHR) { const int m = i >> 10, j = i & 1023; const float cv = (m < 2) ? p.c[m * 1024 + j] : p.c_ctx[j]; sl[i] = cv / (1.0f + __expf(-cv)); }
    __syncthreads();
    float* MOD = (float*)(p.ws + WS_MOD);
    const int rs = lane < 24 ? 0 : 1, c4 = lane < 24 ? lane : (lane < 48 ? lane - 24 : lane - 48);
    for (int item = blockIdx.x; item < DEPTH * 64; item += gridDim.x) {
        const int l = item >> 6, j0 = (item & 63) * 96;
        const float* W = p.ada_w + (size_t)l * D * MODW + j0 + 4 * c4 + (size_t)(wave * 128 + rs) * MODW;
        LAS const float* s0 = sl + wave * 128 + rs;
        float4 a0 = make_float4(0.f, 0.f, 0.f, 0.f), a1 = a0, a2 = a0;
#pragma unroll 16
        for (int i = 0; i < 64; ++i) { const float4 w = *(const float4*)(W + (size_t)(2 * i) * MODW); const float x0 = s0[2 * i], x1 = s0[1024 + 2 * i], x2 = s0[2048 + 2 * i];
            a0.x = fmaf(x0, w.x, a0.x); a0.y = fmaf(x0, w.y, a0.y); a0.z = fmaf(x0, w.z, a0.z); a0.w = fmaf(x0, w.w, a0.w);
            a1.x = fmaf(x1, w.x, a1.x); a1.y = fmaf(x1, w.y, a1.y); a1.z = fmaf(x1, w.z, a1.z); a1.w = fmaf(x1, w.w, a1.w);
            a2.x = fmaf(x2, w.x, a2.x); a2.y = fmaf(x2, w.y, a2.y); a2.z = fmaf(x2, w.z, a2.z); a2.w = fmaf(x2, w.w, a2.w); }
        if (lane < 48) { LAS float* pp = part + (size_t)((wave * 2 + rs) * 3) * 96 + 4 * c4;
            pp[0] = a0.x; pp[1] = a0.y; pp[2] = a0.z; pp[3] = a0.w; pp[96] = a1.x; pp[97] = a1.y; pp[98] = a1.z; pp[99] = a1.w; pp[192] = a2.x; pp[193] = a2.y; pp[194] = a2.z; pp[195] = a2.w; }
        __syncthreads();
        if (tid < 288) { const int m = tid / 96, c = tid - 96 * m; float sum = 0.f;
#pragma unroll
            for (int g = 0; g < 16; ++g) sum += part[(g * 3 + m) * 96 + c];
            MOD[(size_t)(l * 3 + m) * MODW + j0 + c] = sum + p.ada_b[l * MODW + j0 + c]; }
        __syncthreads();
    }
}
__device__ __forceinline__ void phase_norm(const P& p, int l, int which) {
    const float* g = (which ? p.norm2_g : p.norm1_g) + l * D;
    const float* mod = (const float*)(p.ws + WS_MOD) + (size_t)l * 3 * MODW + (which ? 3 * D : 0);
    const bf16_t* X = (const bf16_t*)(p.ws + WS_XRES); bf16_t* H = (bf16_t*)(p.ws + WS_H);
    const int lane = otid() & 63, gw = blockIdx.x * NWAVE + owave(), nw = gridDim.x * NWAVE;
    const int nrow = (which == 1 && l == DEPTH - 1) ? NLAT : NTOK;
    const bool first = (l == 0 && which == 0);
    for (int r = gw; r < nrow; r += nw) {
        const float* xr = r < NLAT ? p.x + (size_t)r * D : p.ctx + (size_t)(r - NLAT) * D; const bf16_t* xb = X + (size_t)r * D; const float* mr = mod + (size_t)row_sel(r) * MODW;
        float4 v[4]; float ss = 0.f;
#pragma unroll
        for (int i = 0; i < 4; ++i) { if (first) v[i] = *(const float4*)(xr + i * 256 + lane * 4); else { const uint2 w = *(const uint2*)(xb + i * 256 + lane * 4); v[i] = make_float4(bf_lo(w.x), bf_hi(w.x), bf_lo(w.y), bf_hi(w.y)); }
            ss += v[i].x * v[i].x + v[i].y * v[i].y + v[i].z * v[i].z + v[i].w * v[i].w; }
        ss = wave_sum(ss); const float rs = rsqrtf(ss * (1.0f / D) + EPS);
#pragma unroll
        for (int i = 0; i < 4; ++i) { const int col = i * 256 + lane * 4;
            const float4 gv = *(const float4*)(g + col), sh = *(const float4*)(mr + col), sc = *(const float4*)(mr + D + col);
            uint2 w; w.x = pk_bf16(v[i].x * rs * gv.x * (1.0f + sc.x) + sh.x, v[i].y * rs * gv.y * (1.0f + sc.y) + sh.y);
                     w.y = pk_bf16(v[i].z * rs * gv.z * (1.0f + sc.z) + sh.z, v[i].w * rs * gv.w * (1.0f + sc.w) + sh.w);
            *(uint2*)(H + (size_t)r * D + col) = w; }
    }
}
template <int C> __device__ __forceinline__ void fp4x3_pair_f(float x0, float x1, unsigned& a0, unsigned& a1, unsigned& a2) {
    a0 = __builtin_amdgcn_cvt_scalef32_pk_fp4_f32(a0, x0 * 0.5f, x1 * 0.5f, 1.0f, C);
    const auto q0 = __builtin_amdgcn_cvt_scalef32_pk_f32_fp4(a0, 1.0f, C);
    const float r0 = x0 - 2.0f * q0[0], r1 = x1 - 2.0f * q0[1];
    a1 = __builtin_amdgcn_cvt_scalef32_pk_fp4_f32(a1, r0 * 4.0f, r1 * 4.0f, 1.0f, C);
}
__device__ __forceinline__ void phase_norm2(const P& p, int l) {
    const float* g = p.norm2_g + l * D;
    const float* mod = (const float*)(p.ws + WS_MOD) + (size_t)l * 3 * MODW + 3 * D;
    const bf16_t* X = (const bf16_t*)(p.ws + WS_XRES); bf16_t* H = (bf16_t*)(p.ws + WS_H); unsigned char* H4 = p.ws + WS_H4;
    const int lane = otid() & 63, gw = blockIdx.x * NWAVE + owave(), nw = gridDim.x * NWAVE;
    const int nrow = (l == DEPTH - 1) ? NLAT : NTOK;
    for (int r = gw; r < nrow; r += nw) {
        const bf16_t* xr = X + (size_t)r * D + lane * 16; const float* mr = mod + (size_t)row_sel(r) * MODW + lane * 16; const float* gr = g + lane * 16;
        float v[16]; float ss = 0.f;
#pragma unroll
        for (int i = 0; i < 4; ++i) { const uint2 w = ((const uint2*)xr)[i]; const float4 t = make_float4(bf_lo(w.x), bf_hi(w.x), bf_lo(w.y), bf_hi(w.y)); v[4 * i] = t.x; v[4 * i + 1] = t.y; v[4 * i + 2] = t.z; v[4 * i + 3] = t.w; ss += t.x * t.x + t.y * t.y + t.z * t.z + t.w * t.w; }
        ss = wave_sum(ss); const float rs = rsqrtf(ss * (1.0f / D) + EPS);
        unsigned hb[8], a0[2] = {0u, 0u}, a1[2] = {0u, 0u}, a2[2] = {0u, 0u};
#pragma unroll
        for (int i = 0; i < 4; ++i) { const float4 gv = ((const float4*)gr)[i], sh = ((const float4*)mr)[i], sc = ((const float4*)(mr + D))[i];
            v[4 * i] = v[4 * i] * rs * gv.x * (1.0f + sc.x) + sh.x; v[4 * i + 1] = v[4 * i + 1] * rs * gv.y * (1.0f + sc.y) + sh.y;
            v[4 * i + 2] = v[4 * i + 2] * rs * gv.z * (1.0f + sc.z) + sh.z; v[4 * i + 3] = v[4 * i + 3] * rs * gv.w * (1.0f + sc.w) + sh.w; }
#pragma unroll
        for (int i = 0; i < 8; ++i) hb[i] = pk_bf16(v[2 * i], v[2 * i + 1]);
        uint4* hw = (uint4*)(H + (size_t)r * D + lane * 16); hw[0] = make_uint4(hb[0], hb[1], hb[2], hb[3]); hw[1] = make_uint4(hb[4], hb[5], hb[6], hb[7]);
#pragma unroll
        for (int d = 0; d < 2; ++d) {
            fp4x3_pair_f<0>(bf_lo(hb[4 * d]), bf_hi(hb[4 * d]), a0[d], a1[d], a2[d]); fp4x3_pair_f<1>(bf_lo(hb[4 * d + 1]), bf_hi(hb[4 * d + 1]), a0[d], a1[d], a2[d]);
            fp4x3_pair_f<2>(bf_lo(hb[4 * d + 2]), bf_hi(hb[4 * d + 2]), a0[d], a1[d], a2[d]); fp4x3_pair_f<3>(bf_lo(hb[4 * d + 3]), bf_hi(hb[4 * d + 3]), a0[d], a1[d], a2[d]); }
        unsigned char* h4 = H4 + (size_t)r * 1536 + lane * 8;
        *(uint2*)(h4) = make_uint2(a0[0], a0[1]); *(uint2*)(h4 + 512) = make_uint2(a1[0], a1[1]);
    }
}
__device__ __forceinline__ void h4_rows(const P& p, int l, int first, int step, int nrow) {
    const float* g = p.norm2_g + l * D;
    const float* mod = (const float*)(p.ws + WS_MOD) + (size_t)l * 3 * MODW + 3 * D;
    const bf16_t* X = (const bf16_t*)(p.ws + WS_XRES); unsigned char* H4 = p.ws + WS_H4; const float* SS = (const float*)(p.ws + WS_SSP2);
    const int lane = otid() & 63;
    if (first >= nrow) return;
    float gm[16], sh[16]; int cur_sel = -1;
    uint4 xn[2]; float4 sn[4];
    { const uint4* xp = (const uint4*)(X + (size_t)first * D + lane * 16); xn[0] = xp[0]; xn[1] = xp[1]; const float4* sp = (const float4*)(SS + (size_t)first * 16); sn[0] = sp[0]; sn[1] = sp[1]; sn[2] = sp[2]; sn[3] = sp[3]; }
    for (int r = first; r < nrow; r += step) {
        const uint4 x0 = xn[0], x1 = xn[1]; const float4 p0 = sn[0], p1 = sn[1], p2 = sn[2], p3 = sn[3];
        { const int r2 = (r + step < nrow) ? r + step : r; const uint4* xp = (const uint4*)(X + (size_t)r2 * D + lane * 16); xn[0] = xp[0]; xn[1] = xp[1];
          const float4* sp = (const float4*)(SS + (size_t)r2 * 16); sn[0] = sp[0]; sn[1] = sp[1]; sn[2] = sp[2]; sn[3] = sp[3]; }
        const int sel = row_sel(r);
        if (sel != cur_sel) {
            cur_sel = sel; const float* mr = mod + (size_t)sel * MODW + lane * 16; const float* gr = g + lane * 16;
#pragma unroll
            for (int i = 0; i < 4; ++i) { const float4 gv = ((const float4*)gr)[i], s4 = ((const float4*)mr)[i], c4 = ((const float4*)(mr + D))[i];
                gm[4 * i] = gv.x * (1.0f + c4.x); gm[4 * i + 1] = gv.y * (1.0f + c4.y); gm[4 * i + 2] = gv.z * (1.0f + c4.z); gm[4 * i + 3] = gv.w * (1.0f + c4.w);
                sh[4 * i] = s4.x; sh[4 * i + 1] = s4.y; sh[4 * i + 2] = s4.z; sh[4 * i + 3] = s4.w; }
        }
        const float sq = (((p0.x + p0.y) + (p0.z + p0.w)) + ((p1.x + p1.y) + (p1.z + p1.w))) + (((p2.x + p2.y) + (p2.z + p2.w)) + ((p3.x + p3.y) + (p3.z + p3.w)));
        const float rs = __builtin_amdgcn_rsqf(sq * (1.0f / 1024.0f) + 1e-6f);
        float v[16]; { float a[8], b[8]; unpack8(x0, a); unpack8(x1, b);
#pragma unroll
            for (int j = 0; j < 8; ++j) { v[j] = a[j]; v[8 + j] = b[j]; } }
#pragma unroll
        for (int i = 0; i < 16; ++i) v[i] = fmaf(v[i] * rs, gm[i], sh[i]);
        unsigned hb[8], a0[2] = {0u, 0u}, a1[2] = {0u, 0u}, a2[2] = {0u, 0u};
#pragma unroll
        for (int i = 0; i < 8; ++i) hb[i] = pk_bf16(v[2 * i], v[2 * i + 1]);
#pragma unroll
        for (int d = 0; d < 2; ++d) {
            fp4x3_pair_f<0>(bf_lo(hb[4 * d]), bf_hi(hb[4 * d]), a0[d], a1[d], a2[d]); fp4x3_pair_f<1>(bf_lo(hb[4 * d + 1]), bf_hi(hb[4 * d + 1]), a0[d], a1[d], a2[d]);
            fp4x3_pair_f<2>(bf_lo(hb[4 * d + 2]), bf_hi(hb[4 * d + 2]), a0[d], a1[d], a2[d]); fp4x3_pair_f<3>(bf_lo(hb[4 * d + 3]), bf_hi(hb[4 * d + 3]), a0[d], a1[d], a2[d]); }
        unsigned char* h4 = H4 + (size_t)r * 1536 + lane * 8;
        *(uint2*)(h4) = make_uint2(a0[0], a0[1]); *(uint2*)(h4 + 512) = make_uint2(a1[0], a1[1]);
    }
}
__device__ __forceinline__ void phase_conv(const P& p, int l) {
    const bf16_t* PR = (const bf16_t*)(p.ws + WS_PROJ); bf16_t* Y = (bf16_t*)(p.ws + WS_YCAT);
    const int lane = otid() & 63, gw = blockIdx.x * NWAVE + owave(), nw = gridDim.x * NWAVE, ch = lane * 4;
    const float4 cw0 = *(const float4*)(p.conv_w + (size_t)(l * 3 + 0) * 256 + ch), cw1 = *(const float4*)(p.conv_w + (size_t)(l * 3 + 1) * 256 + ch), cw2 = *(const float4*)(p.conv_w + (size_t)(l * 3 + 2) * 256 + ch);
    const float4 og = *(const float4*)(p.out_norm_g + (size_t)l * D + ch);
    const int nblk = ((l == DEPTH - 1) ? NLAT : NTOK) / 4;
    for (int bk = gw; bk < nblk; bk += nw) {
        const int r0 = 4 * bk;
        int pos, len; if (r0 < NLAT) { pos = r0 & (T - 1); len = T; } else { pos = (r0 - NLAT) & (CTXL - 1); len = CTXL; }
        const bf16_t* pr = PR + (size_t)r0 * IN_W + ch;
        uint2 gb[4], gc[6], xi[6];
#pragma unroll
        for (int q = 0; q < 4; ++q) gb[q] = *(const uint2*)(pr + (size_t)q * IN_W + C_GB);
#pragma unroll
        for (int q = 0; q < 6; ++q) { const bool ok = (q == 0) ? (pos > 0) : ((q == 5) ? (pos + 4 < len) : true); const bf16_t* pq = pr + (ptrdiff_t)((ok ? q : 1) - 1) * IN_W;
            gc[q] = *(const uint2*)(pq + C_GC); xi[q] = *(const uint2*)(pq + C_XI);
            if (!ok) { gc[q] = make_uint2(0u, 0u); xi[q] = make_uint2(0u, 0u); } }
#pragma unroll
        for (int q = 0; q < 4; ++q) {
            const uint2 gcm = gc[q], xim = xi[q], gcc = gc[q + 1], xic = xi[q + 1], gcp = gc[q + 2], xip = xi[q + 2], gbq = gb[q];
            float y[4];
            y[0] = bf_lo(gbq.x) * (bf_lo(gcm.x) * bf_lo(xim.x) * cw0.x + bf_lo(gcc.x) * bf_lo(xic.x) * cw1.x + bf_lo(gcp.x) * bf_lo(xip.x) * cw2.x);
            y[1] = bf_hi(gbq.x) * (bf_hi(gcm.x) * bf_hi(xim.x) * cw0.y + bf_hi(gcc.x) * bf_hi(xic.x) * cw1.y + bf_hi(gcp.x) * bf_hi(xip.x) * cw2.y);
            y[2] = bf_lo(gbq.y) * (bf_lo(gcm.y) * bf_lo(xim.y) * cw0.z + bf_lo(gcc.y) * bf_lo(xic.y) * cw1.z + bf_lo(gcp.y) * bf_lo(xip.y) * cw2.z);
            y[3] = bf_hi(gbq.y) * (bf_hi(gcm.y) * bf_hi(xim.y) * cw0.w + bf_hi(gcc.y) * bf_hi(xic.y) * cw1.w + bf_hi(gcp.y) * bf_hi(xip.y) * cw2.w);
            float ss = y[0] * y[0] + y[1] * y[1] + y[2] * y[2] + y[3] * y[3];
            ss += __shfl_xor(ss, 1); ss += __shfl_xor(ss, 2); ss += __shfl_xor(ss, 4); ss += __shfl_xor(ss, 8);
            const float rs = rsqrtf(ss * (1.0f / 64.0f) + EPS);
            uint2 w; w.x = pk_bf16(y[0] * rs * og.x, y[1] * rs * og.y); w.y = pk_bf16(y[2] * rs * og.z, y[3] * rs * og.w);
            *(uint2*)(Y + (size_t)(r0 + q) * D + ch) = w;
        }
    }
}
typedef short s16x8_t __attribute__((ext_vector_type(8)));
typedef short s16x4_t __attribute__((ext_vector_type(4)));
typedef float f32x4_t __attribute__((ext_vector_type(4)));
typedef unsigned u32x4_t __attribute__((ext_vector_type(4)));
__device__ __forceinline__ float x4_max(float x) {
    auto s = __builtin_amdgcn_permlane16_swap(__float_as_uint(x), __float_as_uint(x), false, false); x = fmaxf(__uint_as_float(s[0]), __uint_as_float(s[1]));
    auto t = __builtin_amdgcn_permlane32_swap(__float_as_uint(x), __float_as_uint(x), false, false); return fmaxf(__uint_as_float(t[0]), __uint_as_float(t[1])); }
__device__ __forceinline__ float x4_sum(float x) {
    auto s = __builtin_amdgcn_permlane16_swap(__float_as_uint(x), __float_as_uint(x), false, false); x = __uint_as_float(s[0]) + __uint_as_float(s[1]);
    auto t = __builtin_amdgcn_permlane32_swap(__float_as_uint(x), __float_as_uint(x), false, false); return __uint_as_float(t[0]) + __uint_as_float(t[1]); }
template <int OFF> __device__ __forceinline__ s16x4_t tr_read(unsigned vb) { s16x4_t r; asm volatile("ds_read_b64_tr_b16 %0, %1 offset:%2" : "=&v"(r) : "v"(vb), "i"(OFF) : "memory"); return r; }
constexpr int NA_VSTRIDE = 144;
constexpr int NA_NSLOT = 9;
constexpr int NA_CTX_ROW = NA_NSLOT * 64;
constexpr int NA_CK_OFF = (NA_CTX_ROW + 256) * NA_VSTRIDE;
constexpr int NA_RPB_OFF = NA_CK_OFF + 256 * 128;
static_assert(NA_RPB_OFF + 465 * 4 + 64 <= ST_OFF, "attention LDS image overlaps the control words");
__device__ __forceinline__ void phase_na(const P& p, int l, LAS unsigned char* lds) {
    const bf16_t* PR = (const bf16_t*)(p.ws + WS_PROJ); bf16_t* Y = (bf16_t*)(p.ws + WS_YCAT);
    const int tid = otid(), wave = __builtin_amdgcn_readfirstlane(tid >> 6), lane = tid & 63, g = lane >> 4, lq = lane & 15;
    LAS float* rpbl = (LAS float*)(lds + NA_RPB_OFF);
    const unsigned vbase = (unsigned)(uintptr_t)lds;
    const int G = (int)gridDim.x, per = (2048 + G - 1) / G, nctx_it = (l == DEPTH - 1) ? 0 : (32 + G - 1) / G;
    const int qt = wave & 3, rsel = wave >> 2;
    f32x4_t mk[2];
    { const int gc_ = qt * 16 + lq, cs_ = min(max(gc_ - 8, 0), 48), cw_ = min(max(qt * 16 - 8, 0), 32);
#pragma unroll
      for (int pq = 0; pq < 2; ++pq)
#pragma unroll
          for (int r = 0; r < 4; ++r) { const int col = cw_ + 16 * pq + 4 * g + r; mk[pq][r] = ((col >= cs_) && (col < cs_ + 16)) ? 0.f : -3.0e38f; } }
    int cur_b = -1, cur_h = -1, lo_row = 0, hi_row = 0;
    for (int it = 0; it < per + nctx_it; ++it) {
        bool isctx, valid; int b, h, gr0 = 0, hb = 0;
        if (it < per) { const int ul = (int)blockIdx.x * per + it; valid = ul < 2048; isctx = false; b = ul >> 10; h = (ul >> 7) & 7; gr0 = (ul & 127) * 2; }
        else { const int uc = (G - 1 - (int)blockIdx.x) + (it - per) * G;        valid = uc < 32; isctx = true; b = uc >> 4; h = (uc >> 1) & 7; hb = uc & 1; }
        if (!valid) continue;
        const int tokb = b * T, tokc = NLAT + b * CTXL;
        const int need_lo = min(max(gr0 - 4, 0), 248), need_hi = min(max(gr0 + 1 - 4, 0), 248) + 8;
        if (b != cur_b || h != cur_h) {
#pragma unroll
            for (int c = tid; c < 256 * 8; c += NTHR) { const int R = c >> 3, ch = c & 7;
                const u32x4_t v = *(const u32x4_t*)(PR + (size_t)(tokc + R) * IN_W + C_V + h * 64 + ch * 8), k = *(const u32x4_t*)(PR + (size_t)(tokc + R) * IN_W + C_K + h * 64 + ch * 8);
                *(LAS u32x4_t*)(lds + (NA_CTX_ROW + R) * NA_VSTRIDE + ch * 16) = v; *(LAS u32x4_t*)(lds + NA_CK_OFF + R * 128 + 16 * (ch ^ ((R >> 1) & 7))) = k; }
            if (tid < 465) rpbl[tid] = p.na_rpb[(size_t)(l * 8 + h) * 465 + tid] * 1.44269504f;
            cur_b = b; cur_h = h; lo_row = 0; hi_row = 0;
        }
        if (!isctx) {
            for (int R = need_lo; R < need_hi; ++R)
                if (R < lo_row || R >= hi_row) { const u32x4_t v = *(const u32x4_t*)(PR + (size_t)(tokb + R * 64 + (tid >> 3)) * IN_W + C_V + h * 64 + (tid & 7) * 8);
                    *(LAS u32x4_t*)(lds + ((R % NA_NSLOT) * 64 + (tid >> 3)) * NA_VSTRIDE + (tid & 7) * 16) = v; }
            lo_row = need_lo; hi_row = need_hi;
        }
        asm volatile("s_waitcnt lgkmcnt(0)" ::: "memory"); __builtin_amdgcn_s_barrier(); asm volatile("" ::: "memory");
        int nx_lo = 0, nx_n = 0; u32x4_t vn0 = (u32x4_t){0u, 0u, 0u, 0u}, vn1 = vn0;
        if (!isctx && it + 1 < per) { const int ul1 = (int)blockIdx.x * per + it + 1;
            if (ul1 < 2048 && (ul1 >> 7) == (((int)blockIdx.x * per + it) >> 7)) { const int g1 = (ul1 & 127) * 2; const int nhi = min(max(g1 + 1 - 4, 0), 248) + 8;
                nx_lo = hi_row; nx_n = nhi - hi_row;
                if (nx_n > 0) vn0 = *(const u32x4_t*)(PR + (size_t)(tokb + nx_lo * 64 + (tid >> 3)) * IN_W + C_V + h * 64 + (tid & 7) * 8);
                if (nx_n > 1) vn1 = *(const u32x4_t*)(PR + (size_t)(tokb + (nx_lo + 1) * 64 + (tid >> 3)) * IN_W + C_V + h * 64 + (tid & 7) * 8); } }
        const int gr = gr0 + rsel, rs_ = min(max(gr - 4, 0), 248);
        const int tq = isctx ? (tokc + hb * 128 + wave * 16 + lq) : (tokb + gr * 64 + qt * 16 + lq);
        const int cw0 = min(max(qt * 16 - 8, 0), 32);
        const int tokl = tokb + rs_ * 64;
        const int qq = lq >> 2, pp4 = lq & 3;
        f32x4_t O[4]; float mrow = -3.0e38f, lrow = 0.f;
#pragma unroll
        for (int c = 0; c < 4; ++c) O[c] = (f32x4_t){0.f, 0.f, 0.f, 0.f};
        const bf16_t* qp = PR + (size_t)tq * IN_W + C_Q + h * 64 + g * 8;
        const s16x8_t qf0 = *(const s16x8_t*)qp, qf1 = *(const s16x8_t*)(qp + 32);
        s16x8_t kfa[8], kfb[8];
#pragma unroll
        for (int k8 = 0; k8 < 8; ++k8) asm volatile("" : "=v"(kfa[k8]), "=v"(kfb[k8]));
        if (!isctx) {
#pragma unroll
            for (int k8 = 0; k8 < 8; ++k8) { const int tk = tokl + (k8 >> 1) * 64 + cw0 + 16 * (k8 & 1) + lq; const bf16_t* kp = PR + (size_t)tk * IN_W + C_K + h * 64 + g * 8;
                kfa[k8] = *(const s16x8_t*)kp; kfb[k8] = *(const s16x8_t*)(kp + 32); } }
        __builtin_amdgcn_sched_barrier(0);
#define NA_TRRD(BUF, KB_) do { const int kb = (KB_); const int R0 = (ROW0_OF_KB_EXPR); \
                const unsigned a0 = vbase + (unsigned)((R0 + qq) * NA_VSTRIDE + pp4 * 8), a1 = a0 + 16 * NA_VSTRIDE; \
                vl[BUF][0] = tr_read<0>(a0); vl[BUF][1] = tr_read<32>(a0); vl[BUF][2] = tr_read<64>(a0); vl[BUF][3] = tr_read<96>(a0); \
                vh[BUF][0] = tr_read<0>(a1); vh[BUF][1] = tr_read<32>(a1); vh[BUF][2] = tr_read<64>(a1); vh[BUF][3] = tr_read<96>(a1); } while (0)
#define NA_MERGE_PV() do { \
            mx = x4_max(mx); \
            const float mnew = fmaxf(mrow, mx), resc = __builtin_amdgcn_exp2f(mrow - mnew); f32x4_t lsv = (f32x4_t){0.f, 0.f, 0.f, 0.f}; \
            f32x2_t nm2 = (f32x2_t){-mnew, -mnew}; asm volatile("" : "+v"(nm2)); const f32x4_t nm4 = (f32x4_t){nm2[0], nm2[1], nm2[0], nm2[1]}; \
            _Pragma("unroll") for (int kt = 0; kt < 16; ++kt) { f32x4_t d = sc[kt] + nm4; d[0] = __builtin_amdgcn_exp2f(d[0]); d[1] = __builtin_amdgcn_exp2f(d[1]); d[2] = __builtin_amdgcn_exp2f(d[2]); d[3] = __builtin_amdgcn_exp2f(d[3]); sc[kt] = d; lsv += d; } \
            float ls = (lsv[0] + lsv[1]) + (lsv[2] + lsv[3]); \
            ls = x4_sum(ls); lrow = lrow * resc + ls; mrow = mnew; \
            _Pragma("unroll") for (int c = 0; c < 4; ++c) O[c] = O[c] * resc; \
            s16x4_t vl[2][4], vh[2][4]; \
            NA_TRRD(0, 0); \
            _Pragma("unroll") for (int kb_ = 0; kb_ < 8; ++kb_) { \
                asm volatile("s_waitcnt lgkmcnt(0)" ::: "memory"); __builtin_amdgcn_sched_barrier(0); \
                if (kb_ < 7) NA_TRRD((kb_ + 1) & 1, kb_ + 1);                \
                s16x8_t pf; \
                { const unsigned u0 = pk_bf16(sc[2 * kb_][0], sc[2 * kb_][1]), u1 = pk_bf16(sc[2 * kb_][2], sc[2 * kb_][3]), u2 = pk_bf16(sc[2 * kb_ + 1][0], sc[2 * kb_ + 1][1]), u3 = pk_bf16(sc[2 * kb_ + 1][2], sc[2 * kb_ + 1][3]); \
                  pf = __builtin_bit_cast(s16x8_t, make_uint4(u0, u1, u2, u3)); } \
                O[0] = __builtin_amdgcn_mfma_f32_16x16x32_bf16(NA_PK(vl[kb_ & 1][0], vh[kb_ & 1][0]), pf, O[0], 0, 0, 0); \
                O[1] = __builtin_amdgcn_mfma_f32_16x16x32_bf16(NA_PK(vl[kb_ & 1][1], vh[kb_ & 1][1]), pf, O[1], 0, 0, 0); \
                O[2] = __builtin_amdgcn_mfma_f32_16x16x32_bf16(NA_PK(vl[kb_ & 1][2], vh[kb_ & 1][2]), pf, O[2], 0, 0, 0); \
                O[3] = __builtin_amdgcn_mfma_f32_16x16x32_bf16(NA_PK(vl[kb_ & 1][3], vh[kb_ & 1][3]), pf, O[3], 0, 0, 0); \
                __builtin_amdgcn_sched_barrier(0); } } while (0)
#define NA_PK(L, H) (s16x8_t){L[0], L[1], L[2], L[3], H[0], H[1], H[2], H[3]}
        {
            f32x4_t sc[16];
            const unsigned sw = (unsigned)((lq >> 1) & 7);
            const LAS unsigned char* ka = lds + NA_CK_OFF + lq * 128 + 16 * ((unsigned)g ^ sw); const LAS unsigned char* kb2 = lds + NA_CK_OFF + lq * 128 + 16 * ((unsigned)(4 + g) ^ sw);
#pragma unroll
            for (int q4 = 0; q4 < 4; ++q4) {
                s16x8_t c0[4], c1[4];
#pragma unroll
                for (int k4 = 0; k4 < 4; ++k4) { const int kt = q4 * 4 + k4; c0[k4] = *(const LAS s16x8_t*)(ka + 2048 * kt); c1[k4] = *(const LAS s16x8_t*)(kb2 + 2048 * kt); }
#pragma unroll
                for (int k4 = 0; k4 < 4; ++k4) { f32x4_t acc = (f32x4_t){0.f, 0.f, 0.f, 0.f};
                    acc = __builtin_amdgcn_mfma_f32_16x16x32_bf16(c0[k4], qf0, acc, 0, 0, 0);
                    acc = __builtin_amdgcn_mfma_f32_16x16x32_bf16(c1[k4], qf1, acc, 0, 0, 0);
                    sc[q4 * 4 + k4] = acc; }
            }
            float mx = -3.0e38f;
#pragma unroll
            for (int kt = 0; kt < 16; ++kt)
#pragma unroll
                for (int r = 0; r < 4; ++r) mx = fmaxf(mx, sc[kt][r]);
            mx *= 0.125f * 1.44269504f;
#pragma unroll
            for (int kt = 0; kt < 16; ++kt) sc[kt] = sc[kt] * (0.125f * 1.44269504f);
#define ROW0_OF_KB_EXPR (NA_CTX_ROW + 32 * kb + 4 * g)
            NA_MERGE_PV();
#undef ROW0_OF_KB_EXPR
        }
        if (!isctx) {
            f32x4_t sc[16];
#pragma unroll
            for (int k8 = 0; k8 < 8; ++k8) { f32x4_t acc = (f32x4_t){0.f, 0.f, 0.f, 0.f};
                acc = __builtin_amdgcn_mfma_f32_16x16x32_bf16(kfa[k8], qf0, acc, 0, 0, 0);
                acc = __builtin_amdgcn_mfma_f32_16x16x32_bf16(kfb[k8], qf1, acc, 0, 0, 0);
                sc[k8] = acc; }
            __builtin_amdgcn_sched_barrier(0);
#pragma unroll
            for (int k8 = 0; k8 < 8; ++k8) { const int kt = 8 + k8;
                const int tk = tokl + (kt >> 1) * 64 + cw0 + 16 * (kt & 1) + lq; const bf16_t* kp = PR + (size_t)tk * IN_W + C_K + h * 64 + g * 8;
                kfa[k8] = *(const s16x8_t*)kp; kfb[k8] = *(const s16x8_t*)(kp + 32); }
            __builtin_amdgcn_sched_barrier(0);
#pragma unroll
            for (int k8 = 0; k8 < 8; ++k8) { f32x4_t acc = (f32x4_t){0.f, 0.f, 0.f, 0.f};
                acc = __builtin_amdgcn_mfma_f32_16x16x32_bf16(kfa[k8], qf0, acc, 0, 0, 0);
                acc = __builtin_amdgcn_mfma_f32_16x16x32_bf16(kfb[k8], qf1, acc, 0, 0, 0);
                sc[8 + k8] = acc; }
            __builtin_amdgcn_sched_barrier(0);
            float mx = -3.0e38f;
            const int gc = qt * 16 + lq;
            const LAS float* rb_ = rpbl + ((rs_ - gr + 7) * 31 + (cw0 + 4 * g - gc + 15));
#pragma unroll
            for (int kq = 0; kq < 4; ++kq) {
                float bq[16];
#pragma unroll
                for (int e = 0; e < 16; ++e) { const int kt = 4 * kq + (e >> 2), r = e & 3; bq[e] = rb_[31 * (kt >> 1) + 16 * (kt & 1) + r]; }
                asm volatile("" : "+v"(bq[0]), "+v"(bq[1]), "+v"(bq[2]), "+v"(bq[3]), "+v"(bq[4]), "+v"(bq[5]), "+v"(bq[6]), "+v"(bq[7]),
                                  "+v"(bq[8]), "+v"(bq[9]), "+v"(bq[10]), "+v"(bq[11]), "+v"(bq[12]), "+v"(bq[13]), "+v"(bq[14]), "+v"(bq[15]));
#pragma unroll
                for (int e4 = 0; e4 < 4; ++e4) { const int kt = 4 * kq + e4;
                    const f32x4_t b4 = (f32x4_t){bq[4 * e4], bq[4 * e4 + 1], bq[4 * e4 + 2], bq[4 * e4 + 3]} + mk[kt & 1];
                    const f32x4_t sv = sc[kt] * (0.125f * 1.44269504f) + b4; sc[kt] = sv;
                    mx = fmaxf(fmaxf(mx, sv[0]), sv[1]); mx = fmaxf(fmaxf(mx, sv[2]), sv[3]); }
            }
#define ROW0_OF_KB_EXPR (((rs_ + kb) % NA_NSLOT) * 64 + cw0 + 4 * g)
            NA_MERGE_PV();
#undef ROW0_OF_KB_EXPR
        }
#undef NA_PK
#undef NA_MERGE_PV
#undef NA_TRRD
        { const float inv = 1.0f / lrow; float ss = 0.f;
#pragma unroll
          for (int c = 0; c < 4; ++c) { O[c] = O[c] * inv; ss += O[c][0] * O[c][0] + O[c][1] * O[c][1] + O[c][2] * O[c][2] + O[c][3] * O[c][3]; }
          ss = x4_sum(ss); const float rn = rsqrtf(ss * (1.0f / 64.0f) + EPS);
          const float* og = p.out_norm_g + (size_t)l * D + 512 + h * 64 + 4 * g; bf16_t* yp = Y + (size_t)tq * D + 512 + h * 64 + 4 * g;
#pragma unroll
          for (int c = 0; c < 4; ++c) { const float4 gv = *(const float4*)(og + 16 * c);
              uint2 w; w.x = pk_bf16(O[c][0] * rn * gv.x, O[c][1] * rn * gv.y); w.y = pk_bf16(O[c][2] * rn * gv.z, O[c][3] * rn * gv.w);
              *(uint2*)(yp + 16 * c) = w; } }
        asm volatile("s_waitcnt lgkmcnt(0)" ::: "memory"); __builtin_amdgcn_s_barrier(); asm volatile("" ::: "memory");
        if (nx_n > 0) *(LAS u32x4_t*)(lds + (((nx_lo) % NA_NSLOT) * 64 + (tid >> 3)) * NA_VSTRIDE + (tid & 7) * 16) = vn0;
        if (nx_n > 1) *(LAS u32x4_t*)(lds + (((nx_lo + 1) % NA_NSLOT) * 64 + (tid >> 3)) * NA_VSTRIDE + (tid & 7) * 16) = vn1;
        if (nx_n > 0) hi_row = nx_lo + nx_n;
    }
    __syncthreads();
}
__device__ __forceinline__ void phase_sgu(const P& p, int l, LAS unsigned char* lds) {
    const bf16_t* PR = (const bf16_t*)(p.ws + WS_PROJ); bf16_t* Y = (bf16_t*)(p.ws + WS_YCAT);
    const bf16_t* WB = (const bf16_t*)(p.ws + WS_SGUW) + (size_t)l * 4 * 128 * 128;
    const int tid = otid(), wave = __builtin_amdgcn_readfirstlane(tid >> 6), lane = tid & 63, g = lane >> 4, lq = lane & 15;
    const unsigned vbase = (unsigned)(uintptr_t)lds;
    const int nitem = (((l == DEPTH - 1) ? NLAT : NTOK) / 128) * 4;
    for (int item = blockIdx.x; item < nitem; item += gridDim.x) {
        const int chunk = item >> 2, grp = item & 3, row0 = chunk * 128;
        { const int tok = tid >> 2, cg = (tid & 3) * 16;
          const bf16_t* src = PR + (size_t)(row0 + tok) * IN_W + C_SV + grp * 64 + cg;
          float f[16]; { float a[8], b[8]; unpack8(((const uint4*)src)[0], a); unpack8(((const uint4*)src)[1], b);
#pragma unroll
              for (int j = 0; j < 8; ++j) { f[j] = gelu_tanh(a[j]); f[8 + j] = gelu_tanh(b[j]); } }
          float ss = 0.f;
#pragma unroll
          for (int j = 0; j < 16; ++j) ss += f[j] * f[j];
          ss += __shfl_xor(ss, 1); ss += __shfl_xor(ss, 2);
          const float rs = rsqrtf(ss * (1.0f / 64.0f) + EPS);
          const float* gn = p.sgu_norm_g + (size_t)l * 256 + grp * 64 + cg;
          unsigned o[8];
#pragma unroll
          for (int j = 0; j < 8; ++j) o[j] = pk_bf16(f[2 * j] * rs * gn[2 * j], f[2 * j + 1] * rs * gn[2 * j + 1]);
          LAS u32x4_t* dst = (LAS u32x4_t*)(lds + tok * NA_VSTRIDE + cg * 2);
          dst[0] = (u32x4_t){o[0], o[1], o[2], o[3]}; dst[1] = (u32x4_t){o[4], o[5], o[6], o[7]}; }
        __syncthreads();
        const int tokp = row0 + wave * 16 + lq;
        f32x4_t O[4];
#pragma unroll
        for (int c = 0; c < 4; ++c) O[c] = (f32x4_t){0.f, 0.f, 0.f, 0.f};
        const bf16_t* wp = WB + ((size_t)grp * 128 + wave * 16 + lq) * 128 + g * 8;
        const int qq = lq >> 2, pp4 = lq & 3;
#pragma unroll
        for (int ks = 0; ks < 4; ++ks) {
            const s16x8_t wf = *(const s16x8_t*)(wp + 32 * ks);
            const unsigned a0 = vbase + (unsigned)((32 * ks + 8 * g + qq) * NA_VSTRIDE + pp4 * 8), a1 = a0 + 4 * NA_VSTRIDE;
            const s16x4_t l0 = tr_read<0>(a0), l1 = tr_read<32>(a0), l2 = tr_read<64>(a0), l3 = tr_read<96>(a0);
            const s16x4_t h0 = tr_read<0>(a1), h1 = tr_read<32>(a1), h2 = tr_read<64>(a1), h3 = tr_read<96>(a1);
            asm volatile("s_waitcnt lgkmcnt(0)" ::: "memory"); __builtin_amdgcn_sched_barrier(0);
#define SG_PK(L, H) (s16x8_t){L[0], L[1], L[2], L[3], H[0], H[1], H[2], H[3]}
            O[0] = __builtin_amdgcn_mfma_f32_16x16x32_bf16(SG_PK(l0, h0), wf, O[0], 0, 0, 0);
            O[1] = __builtin_amdgcn_mfma_f32_16x16x32_bf16(SG_PK(l1, h1), wf, O[1], 0, 0, 0);
            O[2] = __builtin_amdgcn_mfma_f32_16x16x32_bf16(SG_PK(l2, h2), wf, O[2], 0, 0, 0);
            O[3] = __builtin_amdgcn_mfma_f32_16x16x32_bf16(SG_PK(l3, h3), wf, O[3], 0, 0, 0);
#undef SG_PK
        }
        const float bias = p.sgu_b[(size_t)(l * 4 + grp) * 128 + wave * 16 + lq];
        const bf16_t* up = PR + (size_t)tokp * IN_W + C_SU + grp * 64 + 4 * g;
        float ss = 0.f;
#pragma unroll
        for (int c = 0; c < 4; ++c) { const uint2 uu = *(const uint2*)(up + 16 * c);
            O[c][0] = gelu_tanh(bf_lo(uu.x)) * (O[c][0] + bias); O[c][1] = gelu_tanh(bf_hi(uu.x)) * (O[c][1] + bias);
            O[c][2] = gelu_tanh(bf_lo(uu.y)) * (O[c][2] + bias); O[c][3] = gelu_tanh(bf_hi(uu.y)) * (O[c][3] + bias);
            ss += O[c][0] * O[c][0] + O[c][1] * O[c][1] + O[c][2] * O[c][2] + O[c][3] * O[c][3]; }
        ss = x4_sum(ss); const float rn = rsqrtf(ss * (1.0f / 64.0f) + EPS);
        const float* og = p.out_norm_g + (size_t)l * D + 256 + grp * 64 + 4 * g; bf16_t* yp = Y + (size_t)tokp * D + 256 + grp * 64 + 4 * g;
#pragma unroll
        for (int c = 0; c < 4; ++c) { const float4 gv = *(const float4*)(og + 16 * c);
            uint2 w; w.x = pk_bf16(O[c][0] * rn * gv.x, O[c][1] * rn * gv.y); w.y = pk_bf16(O[c][2] * rn * gv.z, O[c][3] * rn * gv.w);
            *(uint2*)(yp + 16 * c) = w; }
        __syncthreads();
    }
}
__device__ __forceinline__ float vmaxf(float a, float b) { float r; asm("v_max_f32 %0, %1, %2" : "=v"(r) : "v"(a), "v"(b)); return r; }
__device__ __forceinline__ float vminf(float a, float b) { float r; asm("v_min_f32 %0, %1, %2" : "=v"(r) : "v"(a), "v"(b)); return r; }
__device__ __forceinline__ float vmed3f(float a, float b, float c) { float r; asm("v_med3_f32 %0, %1, %2, %3" : "=v"(r) : "v"(a), "v"(b), "v"(c)); return r; }
template <int A, int B> __device__ __forceinline__ void ce_desc(float (&v)[16]) { const float x = v[A], y = v[B]; v[A] = vmaxf(x, y); v[B] = vminf(x, y); }
__device__ __forceinline__ void sort16_desc(float (&v)[16]) {
    ce_desc<0, 13>(v); ce_desc<1, 12>(v); ce_desc<2, 15>(v); ce_desc<3, 14>(v); ce_desc<4, 8>(v); ce_desc<5, 6>(v); ce_desc<7, 11>(v); ce_desc<9, 10>(v);
    ce_desc<0, 5>(v); ce_desc<1, 7>(v); ce_desc<2, 9>(v); ce_desc<3, 4>(v); ce_desc<6, 13>(v); ce_desc<8, 14>(v); ce_desc<10, 15>(v); ce_desc<11, 12>(v);
    ce_desc<0, 1>(v); ce_desc<2, 3>(v); ce_desc<4, 5>(v); ce_desc<6, 8>(v); ce_desc<7, 9>(v); ce_desc<10, 11>(v); ce_desc<12, 13>(v); ce_desc<14, 15>(v);
    ce_desc<0, 2>(v); ce_desc<1, 3>(v); ce_desc<4, 10>(v); ce_desc<5, 11>(v); ce_desc<6, 7>(v); ce_desc<8, 9>(v); ce_desc<12, 14>(v); ce_desc<13, 15>(v);
    ce_desc<1, 2>(v); ce_desc<3, 12>(v); ce_desc<4, 6>(v); ce_desc<5, 7>(v); ce_desc<8, 10>(v); ce_desc<9, 11>(v); ce_desc<13, 14>(v);
    ce_desc<1, 4>(v); ce_desc<2, 6>(v); ce_desc<5, 8>(v); ce_desc<7, 10>(v); ce_desc<9, 13>(v); ce_desc<11, 14>(v);
    ce_desc<2, 4>(v); ce_desc<3, 6>(v); ce_desc<9, 12>(v); ce_desc<11, 13>(v);
    ce_desc<3, 5>(v); ce_desc<6, 8>(v); ce_desc<7, 9>(v); ce_desc<10, 12>(v);
    ce_desc<3, 4>(v); ce_desc<5, 6>(v); ce_desc<7, 8>(v); ce_desc<9, 10>(v); ce_desc<11, 12>(v);
    ce_desc<6, 7>(v); ce_desc<8, 9>(v);
}
template <int J, int I> __device__ __forceinline__ void bm_step(float (&v)[16]) { if constexpr ((I ^ J) > I) ce_desc<I, (I ^ J)>(v); }
template <int J, int... I> __device__ __forceinline__ void bm_layer(float (&v)[16], std::integer_sequence<int, I...>) { (bm_step<J, I>(v), ...); }
__device__ __forceinline__ void bmerge16_desc(float (&v)[16]) {
    using S = std::make_integer_sequence<int, 16>; bm_layer<8>(v, S{}); bm_layer<4>(v, S{}); bm_layer<2>(v, S{}); bm_layer<1>(v, S{}); }
template <int... I> __device__ __forceinline__ void mtop_(float (&A)[16], const float (&B)[16], std::integer_sequence<int, I...>) { ((A[I] = vmaxf(A[I], B[15 - I])), ...); }
__device__ __forceinline__ void merge_top16(float (&A)[16], const float (&B)[16]) {
    mtop_(A, B, std::make_integer_sequence<int, 16>{}); bmerge16_desc(A); }
constexpr int TK_ROW = 272;
__device__ __forceinline__ void phase_topk(const P& p, int l, LAS unsigned char* lds) {
    const bf16_t* Q = (const bf16_t*)(p.ws + WS_Q); const bf16_t* SK = (const bf16_t*)(p.ws + WS_SUBK) + (size_t)l * 8 * 2 * 128 * 128;
    int* PIDX = (int*)(p.ws + WS_PIDX); float* PG = (float*)(p.ws + WS_PG); float* PUS = (float*)(p.ws + WS_YCAT);
    const float* US = (const float*)(p.ws + WS_US) + (size_t)l * 16384; const float* VS = (const float*)(p.ws + WS_VS) + (size_t)l * 16384;
    const int tid = otid(), wave = __builtin_amdgcn_readfirstlane(tid >> 6), lane = tid & 63, g = lane >> 4, lq = lane & 15;
    const int h = (int)blockIdx.x & 7, ngrp = (int)gridDim.x >> 3, grp = (int)blockIdx.x >> 3;
    if (grp < ngrp) {
        const u32x4_t* src = (const u32x4_t*)(SK + (size_t)h * 2 * 128 * 128);
#pragma unroll
        for (int c = tid; c < 256 * 16; c += NTHR) { const int row = c >> 4, ch = c & 15; *(LAS u32x4_t*)(lds + row * TK_ROW + ch * 16) = src[c]; }
    }
    __syncthreads();
    const int wid = wave * ngrp + grp, nwid = ngrp * NWAVE;
    const int h4_nrow = (l == DEPTH - 1) ? NLAT : NTOK;
    if (wave < 4) h4_rows(p, l, (int)blockIdx.x * NWAVE + wave, (int)gridDim.x * NWAVE, h4_nrow);
    s16x8_t qn[2][4];
    { const int t0 = (grp < ngrp && wid < NTOK / 16) ? wid : 0; const bf16_t* qp = Q + (size_t)(t0 * 16 + lq) * QW + h * 256 + g * 8;
#pragma unroll
      for (int pp = 0; pp < 2; ++pp)
#pragma unroll
          for (int ks = 0; ks < 4; ++ks) qn[pp][ks] = *(const s16x8_t*)(qp + pp * 128 + 32 * ks); }
    const int ntile = ((l == DEPTH - 1) ? NLAT : NTOK) / 16;
    for (int tile0 = (grp < ngrp ? wid : NTOK); tile0 < ntile; tile0 += 4 * nwid) {
        float top0[16], top1[16];
#pragma unroll
        for (int i = 0; i < 16; ++i) { top0[i] = 0.f; top1[i] = 0.f; }
        for (int j = 0; j < 4; ++j) {
            const int tile = tile0 + j * nwid;
            if (tile >= ntile) break;
            s16x8_t qc[2][4];
#pragma unroll
            for (int pp = 0; pp < 2; ++pp)
#pragma unroll
                for (int ks = 0; ks < 4; ++ks) qc[pp][ks] = qn[pp][ks];
            { const int tn = (tile + nwid < ntile) ? tile + nwid : tile; const bf16_t* qp = Q + (size_t)(tn * 16 + lq) * QW + h * 256 + g * 8;
#pragma unroll
              for (int pp = 0; pp < 2; ++pp)
#pragma unroll
                  for (int ks = 0; ks < 4; ++ks) qn[pp][ks] = *(const s16x8_t*)(qp + pp * 128 + 32 * ks); }
            float own[2][16];
            s16x8_t fr[2][8];
#define TK_RD(STEP, F) do { _Pragma("unroll") for (int t_ = 0; t_ < 2; ++t_) { const LAS unsigned char* kp_ = lds + (((STEP) >> 2) * 128 + (2 * ((STEP) & 3) + t_) * 16 + lq) * TK_ROW + g * 16; \
                _Pragma("unroll") for (int ks = 0; ks < 4; ++ks) F[t_ * 4 + ks] = *(const LAS s16x8_t*)(kp_ + 64 * ks); } } while (0)
            TK_RD(0, fr[0]);
            __builtin_amdgcn_sched_barrier(0);
#pragma unroll
            for (int pp = 0; pp < 2; ++pp) {
                float sc[32];
#pragma unroll
                for (int s2 = 0; s2 < 4; ++s2) {
                    const int step = pp * 4 + s2;
                    if (step < 7) TK_RD(step + 1, fr[(step + 1) & 1]);
                    __builtin_amdgcn_sched_barrier(0);
                    f32x4_t acc0 = (f32x4_t){0.f, 0.f, 0.f, 0.f}, acc1 = (f32x4_t){0.f, 0.f, 0.f, 0.f};
#pragma unroll
                    for (int ks = 0; ks < 4; ++ks) { acc0 = __builtin_amdgcn_mfma_f32_16x16x32_bf16(fr[step & 1][ks], qc[pp][ks], acc0, 0, 0, 0);
                                                     acc1 = __builtin_amdgcn_mfma_f32_16x16x32_bf16(fr[step & 1][4 + ks], qc[pp][ks], acc1, 0, 0, 0); }
#pragma unroll
                    for (int r = 0; r < 4; ++r) { sc[s2 * 8 + r] = __uint_as_float((__float_as_uint(acc0[r]) & ~127u) | (unsigned)(s2 * 32 + 4 * g + r));
                                                  sc[s2 * 8 + 4 + r] = __uint_as_float((__float_as_uint(acc1[r]) & ~127u) | (unsigned)(s2 * 32 + 16 + 4 * g + r)); }
                    __builtin_amdgcn_sched_barrier(0);
                }
                float A[16], B[16];
#pragma unroll
                for (int i = 0; i < 16; ++i) { A[i] = sc[i]; B[i] = sc[16 + i]; }
                sort16_desc(A); sort16_desc(B);
                merge_top16(A, B);
#pragma unroll
                for (int i = 0; i < 16; ++i) own[pp][i] = A[i];
            }
#undef TK_RD
            float X[16], Y[16];
#pragma unroll
            for (int i = 0; i < 16; ++i) { auto r = __builtin_amdgcn_permlane16_swap(__float_as_uint(own[0][i]), __float_as_uint(own[1][i]), false, false); X[i] = __uint_as_float(r[0]); Y[i] = __uint_as_float(r[1]); }
            merge_top16(X, Y);
#pragma unroll
            for (int i = 0; i < 16; ++i) { auto r = __builtin_amdgcn_permlane32_swap(__float_as_uint(X[i]), __float_as_uint(X[i]), false, false); X[i] = __uint_as_float(r[0]); Y[i] = __uint_as_float(r[1]); }
            merge_top16(X, Y);
            const bool mine = (g == j);
#pragma unroll
            for (int i = 0; i < 16; ++i) { auto r = __builtin_amdgcn_permlane16_swap(__float_as_uint(X[i]), __float_as_uint(X[i]), false, false);
                top0[i] = mine ? __uint_as_float(r[0]) : top0[i]; top1[i] = mine ? __uint_as_float(r[1]) : top1[i]; }
        }
        const int mytile = tile0 + g * nwid, tok = mytile * 16 + lq;
        unsigned ia7[16], jb[16];
#pragma unroll
        for (int i = 0; i < 16; ++i) { ia7[i] = (__float_as_uint(top0[i]) & 127u) << 7; jb[i] = __float_as_uint(top1[i]) & 127u; }
#define CAND(a, b) __uint_as_float((__float_as_uint(top0[a] + top1[b]) & ~16383u) | (ia7[a] | jb[b]))
        float L0[16], L1[16], L2[16], L3[16];
#pragma unroll
        for (int i = 0; i < 16; ++i) L0[i] = CAND(0, i);
#pragma unroll
        for (int i = 0; i < 8; ++i) L1[i] = CAND(1, i);
#pragma unroll
        for (int i = 8; i < 16; ++i) L1[i] = -3.0e38f;
        L2[0] = CAND(2, 0); L2[1] = CAND(2, 1); L2[2] = CAND(2, 2); L2[3] = CAND(2, 3); L2[4] = CAND(2, 4); L2[5] = CAND(3, 0); L2[6] = CAND(3, 1); L2[7] = CAND(3, 2);
        L2[8] = CAND(3, 3); L2[9] = CAND(4, 0); L2[10] = CAND(4, 1); L2[11] = CAND(4, 2); L2[12] = CAND(5, 0); L2[13] = CAND(5, 1); L2[14] = CAND(6, 0); L2[15] = CAND(6, 1);
        {
          float S[9]; const float x71 = CAND(7, 1);
#pragma unroll
          for (int i = 0; i < 9; ++i) S[i] = CAND(7 + i, 0);
          L3[0] = S[0];
#pragma unroll
          for (int i = 1; i < 9; ++i) L3[i] = vmed3f(S[i - 1], S[i], x71);
          L3[9] = vminf(S[8], x71); }
#pragma unroll
        for (int i = 10; i < 16; ++i) L3[i] = -3.0e38f;
#undef CAND
        sort16_desc(L2);
        merge_top16(L0, L1); merge_top16(L2, L3); merge_top16(L0, L2);
        float e[16], sum = 0.f; const float mx = __uint_as_float(__float_as_uint(L0[0]) & ~16383u);
#pragma unroll
        for (int i = 0; i < 16; ++i) { e[i] = __expf(__uint_as_float(__float_as_uint(L0[i]) & ~16383u) - mx); sum += e[i]; }
        const float inv = 1.0f / sum;
        if (mytile < ntile) {
            int* ip = PIDX + (size_t)tok * 128 + h * 16; float* gp = PG + (size_t)tok * 128 + h * 16; unsigned pk16[8];
#pragma unroll
            for (int i = 0; i < 4; ++i) {
                const int ea = (int)(__float_as_uint(L0[4 * i]) & 16383u), eb = (int)(__float_as_uint(L0[4 * i + 1]) & 16383u), ec = (int)(__float_as_uint(L0[4 * i + 2]) & 16383u), ed = (int)(__float_as_uint(L0[4 * i + 3]) & 16383u);
                *(int4*)(ip + 4 * i) = make_int4((int)((pk_bf16(0.f, US[ea]) & 0xffff0000u) | (unsigned)ea), (int)((pk_bf16(0.f, US[eb]) & 0xffff0000u) | (unsigned)eb),
                                                 (int)((pk_bf16(0.f, US[ec]) & 0xffff0000u) | (unsigned)ec), (int)((pk_bf16(0.f, US[ed]) & 0xffff0000u) | (unsigned)ed));
                pk16[2 * i] = (unsigned)ea | ((unsigned)eb << 16); pk16[2 * i + 1] = (unsigned)ec | ((unsigned)ed << 16);
                *(float4*)(gp + 4 * i) = make_float4(e[4 * i] * inv * VS[ea], e[4 * i + 1] * inv * VS[eb], e[4 * i + 2] * inv * VS[ec], e[4 * i + 3] * inv * VS[ed]);
}
            { uint4* i16 = (uint4*)((unsigned short*)(p.ws + WS_YCAT) + (size_t)tok * 128 + h * 16); i16[0] = make_uint4(pk16[0], pk16[1], pk16[2], pk16[3]); i16[1] = make_uint4(pk16[4], pk16[5], pk16[6], pk16[7]); }
        }
    }
    if (wave >= 4) h4_rows(p, l, (int)blockIdx.x * NWAVE + wave, (int)gridDim.x * NWAVE, h4_nrow);
}
template <int CTRL> __device__ __forceinline__ float dppf(float x) { return __builtin_bit_cast(float, __builtin_amdgcn_mov_dpp(__builtin_bit_cast(int, x), CTRL, 0xf, 0xf, true)); }
struct PeerGeom { int slice_lo, nslice, wid, nworkers; };
__device__ __forceinline__ PeerGeom peer_geom(LAS unsigned char* lds, int wave) {
    volatile LAS unsigned* st = (volatile LAS unsigned*)(lds + ST_OFF);
    const unsigned nx = st[1], rank = st[4], dense = st[6], base = st[7], total = st[8];
    PeerGeom g;
    if (nx == 8u && total > 0u && base + rank < total) { g.slice_lo = (int)(dense & 3u); g.nslice = 1; g.wid = (int)(base + rank) * NWAVE + wave; g.nworkers = (int)total * NWAVE; }
    else { g.slice_lo = 0; g.nslice = 4; g.wid = (int)blockIdx.x * NWAVE + wave; g.nworkers = (int)gridDim.x * NWAVE; }
    return g;
}
template <bool VP> struct PeerRaw { int2 e2; float2 g2; uint4 h[4]; };
template <bool VP> __device__ __forceinline__ void peer_load_raw(PeerRaw<VP>& R, int t, int lane, int colbase, const int* PIDX, const float* PG, const float* UP, const bf16_t* H) {
    R.e2 = *(const int2*)(PIDX + (size_t)t * 128 + 2 * lane);
    if (VP) R.g2 = *(const float2*)(PG + (size_t)t * 128 + 2 * lane);
    if (!VP) { const uint4* hp = (const uint4*)(H + (size_t)t * D + colbase); R.h[0] = hp[0]; R.h[1] = hp[1]; R.h[2] = hp[2]; R.h[3] = hp[3]; }
}
template <bool VP> __device__ __forceinline__ void peer_stage(const PeerRaw<VP>& R, LAS float* lw, int lane, int rg, int (&E)[16], float (&W)[16]) {
    *(LAS f32x2_t*)(lw + 2 * lane) = (f32x2_t){__int_as_float(R.e2.x), __int_as_float(R.e2.y)};
    if (VP) *(LAS f32x2_t*)(lw + 128 + 2 * lane) = (f32x2_t){R.g2.x, R.g2.y};
    __builtin_amdgcn_wave_barrier();
#pragma unroll
    for (int i = 0; i < 4; ++i) { const f32x4_t v = *(LAS f32x4_t*)(lw + 16 * rg + 4 * i); E[4 * i] = __float_as_int(v[0]); E[4 * i + 1] = __float_as_int(v[1]); E[4 * i + 2] = __float_as_int(v[2]); E[4 * i + 3] = __float_as_int(v[3]); }
    if (VP) {
#pragma unroll
        for (int i = 0; i < 4; ++i) { const f32x4_t v = *(LAS f32x4_t*)(lw + 128 + 16 * rg + 4 * i); W[4 * i] = v[0]; W[4 * i + 1] = v[1]; W[4 * i + 2] = v[2]; W[4 * i + 3] = v[3]; } }
    __builtin_amdgcn_wave_barrier();
}
__device__ __forceinline__ void unpack32_bf16(const uint4 (&h)[4], float (&f)[32]) {
#pragma unroll
    for (int i = 0; i < 4; ++i) { float a[8]; unpack8(h[i], a);
#pragma unroll
        for (int j = 0; j < 8; ++j) f[8 * i + j] = a[j]; }
}
typedef _Float16 h2_t __attribute__((ext_vector_type(2)));
__device__ __forceinline__ void cvt32_fp4_h2(const u32x4_t w, h2_t (&f)[16]) {
#pragma unroll
    for (int d = 0; d < 4; ++d) {
        f[4 * d + 0] = __builtin_bit_cast(h2_t, __builtin_amdgcn_cvt_scalef32_pk_f16_fp4(w[d], 1.0f, 0)); f[4 * d + 1] = __builtin_bit_cast(h2_t, __builtin_amdgcn_cvt_scalef32_pk_f16_fp4(w[d], 1.0f, 1));
        f[4 * d + 2] = __builtin_bit_cast(h2_t, __builtin_amdgcn_cvt_scalef32_pk_f16_fp4(w[d], 1.0f, 2)); f[4 * d + 3] = __builtin_bit_cast(h2_t, __builtin_amdgcn_cvt_scalef32_pk_f16_fp4(w[d], 1.0f, 3)); }
}
__device__ __forceinline__ void pack32_h2(const float (&f)[32], h2_t (&h)[16]) {
#pragma unroll
    for (int i = 0; i < 16; ++i) h[i] = __builtin_bit_cast(h2_t, __builtin_amdgcn_cvt_pkrtz(f[2 * i], f[2 * i + 1]));
}
constexpr int PEER_STAGE_OFF = 131072 + 1024;
template <bool VP> __device__ __forceinline__ void peer_rows4(const u32x4_t (&r)[4], int i0, const h2_t (&hf)[16], const float (&W)[16], float (&acc)[16], h2_t (&acc2)[16]) {
#pragma unroll
    for (int k = 0; k < 4; ++k) { h2_t f[16]; cvt32_fp4_h2(r[k], f);
        if (VP) { const h2_t wk = __builtin_bit_cast(h2_t, __builtin_amdgcn_cvt_pkrtz(W[i0 + k], W[i0 + k]));
#pragma unroll
            for (int j = 0; j < 16; ++j) acc2[j] = f[j] * wk + acc2[j];
            asm volatile("" : "+v"(acc2[0]), "+v"(acc2[1]), "+v"(acc2[2]), "+v"(acc2[3]), "+v"(acc2[4]), "+v"(acc2[5]), "+v"(acc2[6]), "+v"(acc2[7]), "+v"(acc2[8]), "+v"(acc2[9]), "+v"(acc2[10]), "+v"(acc2[11]), "+v"(acc2[12]), "+v"(acc2[13]), "+v"(acc2[14]), "+v"(acc2[15]));
        } else { h2_t d0 = {0, 0}, d1 = d0, d2 = d0, d3 = d0;
#pragma unroll
            for (int j = 0; j < 4; ++j) { d0 = f[j] * hf[j] + d0; d1 = f[4 + j] * hf[4 + j] + d1; d2 = f[8 + j] * hf[8 + j] + d2; d3 = f[12 + j] * hf[12 + j] + d3; }
            const h2_t dd = (d0 + d1) + (d2 + d3);
            float d = (float)dd.x + (float)dd.y;
            asm volatile("" : "+v"(d)); acc[i0 + k] = d; } }
}
typedef unsigned u32x2_t __attribute__((ext_vector_type(2)));
__device__ __forceinline__ void ld8_nowait(u32x2_t& d, const void* q) { asm volatile("global_load_dwordx2 %0, %1, off" : "=v"(d) : "v"(q) : "memory"); }
__device__ __forceinline__ void ld16_nowait(u32x4_t& d, const void* q) { asm volatile("global_load_dwordx4 %0, %1, off" : "=v"(d) : "v"(q) : "memory"); }
template <bool VP> __device__ __forceinline__ void phase_peer(const P& p, int l, LAS unsigned char* lds) {
    const int tid = otid(), wave = __builtin_amdgcn_readfirstlane(tid >> 6), lane = tid & 63, rg = lane >> 3, pc = lane & 7;
    const bool last = (l == DEPTH - 1); const int ntok = last ? NLAT : NTOK;
    const unsigned char* T4 = p.ws + (VP ? WS_VT : WS_UT) + (size_t)l * 16384 * 512;
    const int* PIDX = (const int*)(p.ws + WS_PIDX); const float* PG = (const float*)(p.ws + (VP ? WS_PG : WS_YCAT)); const bf16_t* H = (const bf16_t*)(p.ws + WS_H);
    float* UP = (float*)(p.ws + WS_PROJ); bf16_t* X = (bf16_t*)(p.ws + WS_XRES); const float* MOD = (const float*)(p.ws + WS_MOD);
    LAS float* lwb = (LAS float*)(lds + PEER_STAGE_OFF + wave * 2048);
    LAS unsigned char* ring = lds + wave * 16384;
    const PeerGeom G = peer_geom(lds, wave);
    const bool b3 = (lane & 8) != 0, b2 = (lane & 4) != 0, b1 = (lane & 2) != 0, b0 = (lane & 1) != 0;
    for (int si = 0; si < G.nslice; ++si) {
        const int s = G.slice_lo + si, colbase = 256 * s + 32 * pc;
        if (G.wid >= ntok) continue;
        const int ntk = (ntok - 1 - G.wid) / G.nworkers + 1;
        const unsigned char* T4c = T4 + 128 * s + 16 * pc;
        PeerRaw<VP> R; int E0[16], En[16]; float W[16], Wn[16]; h2_t hf[16], hfn[16];
#pragma unroll
        for (int i = 0; i < 16; ++i) { W[i] = 0.f; Wn[i] = 0.f; hf[i] = (h2_t){0, 0}; hfn[i] = (h2_t){0, 0}; }
        peer_load_raw<VP>(R, G.wid, lane, colbase, PIDX, PG, UP, H);
        if (!VP) { float t32[32]; unpack32_bf16(R.h, t32); pack32_h2(t32, hf); }
        peer_stage<VP>(R, lwb, lane, rg, E0, W);
#pragma unroll
        for (int i = 0; i < 16; ++i) __builtin_amdgcn_global_load_lds((const unsigned*)(T4c + ((unsigned)E0[i] << 9)), (LAS unsigned*)(ring + i * 1024), 16, 0, 0);
        { const int t1 = G.wid + ((1 < ntk) ? 1 : 0) * G.nworkers; peer_load_raw<VP>(R, t1, lane, colbase, PIDX, PG, UP, H); }
        if (!VP) { float t32[32]; unpack32_bf16(R.h, t32); pack32_h2(t32, hfn); }
        peer_stage<VP>(R, lwb + 256, lane, rg, En, Wn);
        for (int j = 0; j < ntk; ++j) {
            const int t = G.wid + j * G.nworkers;
            const int j2 = (j + 2 < ntk) ? j + 2 : ntk - 1; const int t2 = G.wid + j2 * G.nworkers;
            u32x2_t e2r, g2r = (u32x2_t){0u, 0u}; u32x4_t z4 = (u32x4_t){0u, 0u, 0u, 0u}, hr[4] = {z4, z4, z4, z4}, gvr = z4; u32x2_t xvr = (u32x2_t){0u, 0u};
            ld8_nowait(e2r, PIDX + (size_t)t2 * 128 + 2 * lane);
            if (VP) ld8_nowait(g2r, PG + (size_t)t2 * 128 + 2 * lane);
            else { const bf16_t* hp = H + (size_t)t2 * D + colbase; ld16_nowait(hr[0], hp); ld16_nowait(hr[1], hp + 8); ld16_nowait(hr[2], hp + 16); ld16_nowait(hr[3], hp + 24); }
            if (VP) { const int col = colbase + 4 * rg; ld8_nowait(xvr, X + (size_t)t * D + col); ld16_nowait(gvr, MOD + (size_t)(l * 3 + row_sel(t)) * MODW + 5 * D + col); }
            else { u32x2_t g8; ld8_nowait(g8, PG + (size_t)t * 128 + 2 * lane); gvr[0] = g8[0]; gvr[1] = g8[1]; }
            float acc[16]; h2_t acc2[16];
#pragma unroll
            for (int i = 0; i < 16; ++i) { acc[i] = 0.f; acc2[i] = (h2_t){0, 0}; }
#pragma unroll
            for (int g4 = 0; g4 < 4; ++g4) {
                __builtin_amdgcn_sched_barrier(0);
                asm volatile("s_waitcnt vmcnt(12)" ::: "memory");
                u32x4_t r[4];
#pragma unroll
                for (int k = 0; k < 4; ++k) r[k] = *(LAS u32x4_t*)(ring + (4 * g4 + k) * 1024 + lane * 16);
                asm volatile("s_waitcnt lgkmcnt(0)" ::: "memory");
#pragma unroll
                for (int k = 0; k < 4; ++k) __builtin_amdgcn_global_load_lds((const unsigned*)(T4c + ((unsigned)En[4 * g4 + k] << 9)), (LAS unsigned*)(ring + (4 * g4 + k) * 1024), 16, 0, 0);
                __builtin_amdgcn_sched_barrier(0);
                peer_rows4<VP>(r, 4 * g4, hf, W, acc, acc2);
            }
            __builtin_amdgcn_sched_barrier(0);
            asm volatile("s_waitcnt vmcnt(16)" : "+v"(e2r), "+v"(g2r), "+v"(xvr), "+v"(gvr), "+v"(hr[0]), "+v"(hr[1]), "+v"(hr[2]), "+v"(hr[3]) :: "memory");
            if (!VP) {
#pragma unroll
                for (int k = 0; k < 8; ++k) { const float tt = b2 ? acc[k + 8] : acc[k], ss = b2 ? acc[k] : acc[k + 8]; acc[k] = tt + dppf<0x141>(ss); }
#pragma unroll
                for (int k = 0; k < 4; ++k) { const float tt = b1 ? acc[k + 4] : acc[k], ss = b1 ? acc[k] : acc[k + 4]; acc[k] = tt + dppf<0x4E>(ss); }
#pragma unroll
                for (int k = 0; k < 2; ++k) { const float tt = b0 ? acc[k + 2] : acc[k], ss = b0 ? acc[k] : acc[k + 2]; acc[k] = tt + dppf<0xB1>(ss); }
                *(float2*)(UP + ((size_t)s * NTOK + t) * 128 + 2 * lane) = make_float2(acc[0] * __uint_as_float(gvr[0]), acc[1] * __uint_as_float(gvr[1]));
            } else {
                float av[32];
#pragma unroll
                for (int k = 0; k < 16; ++k) { av[2 * k] = (float)acc2[k].x; av[2 * k + 1] = (float)acc2[k].y; }
#pragma unroll
                for (int k = 0; k < 16; ++k) { auto r = __builtin_amdgcn_permlane32_swap(__float_as_uint(av[k]), __float_as_uint(av[k + 16]), false, false); av[k] = __uint_as_float(r[0]) + __uint_as_float(r[1]); }
#pragma unroll
                for (int k = 0; k < 8; ++k) { auto r = __builtin_amdgcn_permlane16_swap(__float_as_uint(av[k]), __float_as_uint(av[k + 8]), false, false); av[k] = __uint_as_float(r[0]) + __uint_as_float(r[1]); }
#pragma unroll
                for (int k = 0; k < 4; ++k) { const float tt = b3 ? av[k + 4] : av[k], ss = b3 ? av[k] : av[k + 4]; acc[k] = tt + dppf<0x128>(ss); }
                const int col = colbase + 4 * rg; uint2* xp = (uint2*)(X + (size_t)t * D + col);
                float4 xv = make_float4(bf_lo(xvr[0]), bf_hi(xvr[0]), bf_lo(xvr[1]), bf_hi(xvr[1]));
                xv.x = fmaf(__uint_as_float(gvr[0]), acc[0], xv.x); xv.y = fmaf(__uint_as_float(gvr[1]), acc[1], xv.y); xv.z = fmaf(__uint_as_float(gvr[2]), acc[2], xv.z); xv.w = fmaf(__uint_as_float(gvr[3]), acc[3], xv.w);
                *xp = make_uint2(pk_bf16(xv.x, xv.y), pk_bf16(xv.z, xv.w));
            }
#pragma unroll
            for (int i = 0; i < 16; ++i) W[i] = Wn[i];
            if (!VP) {
#pragma unroll
                for (int i = 0; i < 16; ++i) hf[i] = hfn[i]; }
            R.e2 = make_int2((int)e2r[0], (int)e2r[1]); R.g2 = make_float2(__uint_as_float(g2r[0]), __uint_as_float(g2r[1]));
            if (!VP) { const uint4 hh[4] = {make_uint4(hr[0][0], hr[0][1], hr[0][2], hr[0][3]), make_uint4(hr[1][0], hr[1][1], hr[1][2], hr[1][3]), make_uint4(hr[2][0], hr[2][1], hr[2][2], hr[2][3]), make_uint4(hr[3][0], hr[3][1], hr[3][2], hr[3][3])};
                float t32[32]; unpack32_bf16(hh, t32); pack32_h2(t32, hfn); }
            peer_stage<VP>(R, lwb + 256 * (j & 1), lane, rg, En, Wn);
        }
        asm volatile("s_waitcnt vmcnt(0)" ::: "memory");
    }
}
typedef int i32x8_t __attribute__((ext_vector_type(8)));
template <int C> __device__ __forceinline__ void fp4x3_pair(unsigned w, unsigned& a0, unsigned& a1, unsigned& a2) {
    const float x0 = bf_lo(w), x1 = bf_hi(w);
    a0 = __builtin_amdgcn_cvt_scalef32_pk_fp4_f32(a0, x0 * 0.5f, x1 * 0.5f, 1.0f, C);
    const f32x2_t q0 = __builtin_amdgcn_cvt_scalef32_pk_f32_fp4(a0, 1.0f, C);
    const float r0 = x0 - 2.0f * q0.x, r1 = x1 - 2.0f * q0.y;
    a1 = __builtin_amdgcn_cvt_scalef32_pk_fp4_f32(a1, r0 * 4.0f, r1 * 4.0f, 1.0f, C);
    const f32x2_t q1 = __builtin_amdgcn_cvt_scalef32_pk_f32_fp4(a1, 1.0f, C);
    a2 = __builtin_amdgcn_cvt_scalef32_pk_fp4_f32(a2, (r0 - 0.25f * q1.x) * 32.0f, (r1 - 0.25f * q1.y) * 32.0f, 1.0f, C);
}
__device__ __forceinline__ void h2_to_fp4x3(const u32x4_t (&raw)[4], i32x8_t& t0, i32x8_t& t1, i32x8_t& t2) {
#pragma unroll
    for (int d = 0; d < 4; ++d) { unsigned a0 = 0u, a1 = 0u, a2 = 0u;
        fp4x3_pair<0>(raw[d][0], a0, a1, a2); fp4x3_pair<1>(raw[d][1], a0, a1, a2); fp4x3_pair<2>(raw[d][2], a0, a1, a2); fp4x3_pair<3>(raw[d][3], a0, a1, a2);
        t0[d] = (int)a0; t1[d] = (int)a1; t2[d] = (int)a2; t0[4 + d] = 0; t1[4 + d] = 0; t2[4 + d] = 0; }
}
__device__ __forceinline__ void phase_peer_u(const P& p, int l, LAS unsigned char* lds) {
    const int tid = otid(), wave = __builtin_amdgcn_readfirstlane(tid >> 6), lane = tid & 63, r16 = lane & 15, kq = lane >> 4;
    const bool last = (l == DEPTH - 1); const int ntok = last ? NLAT : NTOK;
    const unsigned char* T4 = p.ws + WS_UT + (size_t)l * 16384 * 512;
    const unsigned char* PIDXb = p.ws + WS_PIDX; const unsigned char* PUSb = p.ws + WS_YCAT; const unsigned char* H4 = p.ws + WS_H4;
    float* UP = (float*)(p.ws + WS_PROJ);
    LAS unsigned char* meta = lds + PEER_STAGE_OFF + wave * 2560;
    LAS unsigned char* ring = lds + wave * 16384;
    const PeerGeom G = peer_geom(lds, wave);
    const int isel = r16 & 3;
    const int dm = lane >> 3, di = lane & 7;
    const int pc0 = (di - (dm >> 1)) & 7, pc1 = (di - (dm >> 1) - 4) & 7;
    const int rm = r16 & 7, rsl = r16 >> 3;
    const int rd0 = (8 * rm + ((kq + (rm >> 1) + 4 * rsl) & 7)) * 16, rd1 = (8 * rm + ((kq + 4 + (rm >> 1) + 4 * rsl) & 7)) * 16;
    for (int si = 0; si < G.nslice; ++si) {
        const int s = G.slice_lo + si;
        if (G.wid >= ntok) continue;
        const int ntk = (ntok - 1 - G.wid) / G.nworkers + 1;
        const unsigned char* T4a = T4 + 128 * s + 16 * pc0; const unsigned char* T4b = T4 + 128 * s + 16 * pc1;
#define PU_META(K) do { const int tk_ = G.wid + ((K) < ntk ? (K) : ntk - 1) * G.nworkers; LAS unsigned char* ms_ = meta + ((K) & 1) * 1280; \
            if (lane < 48) __builtin_amdgcn_global_load_lds((const unsigned*)(lane < 32 ? PIDXb + (size_t)tk_ * 512 + 16 * lane : H4 + (size_t)tk_ * 1536 + 128 * s + (lane < 40 ? 16 * (lane - 32) : 512 + 16 * (lane - 40))), (LAS unsigned*)ms_, 16, 0, 0); \
            } while (0)
#define PU_IDS(K, E) do { const LAS unsigned char* ms_ = meta + ((K) & 1) * 1280 + 32 * dm; _Pragma("unroll") for (int q4 = 0; q4 < 4; ++q4) { const u32x4_t ev = *(const LAS u32x4_t*)(ms_ + 256 * (q4 >> 1) + 16 * (q4 & 1)); \
            E[4 * q4] = (int)(ev[0] & 16383u); E[4 * q4 + 1] = (int)(ev[1] & 16383u); E[4 * q4 + 2] = (int)(ev[2] & 16383u); E[4 * q4 + 3] = (int)(ev[3] & 16383u); } } while (0)
#define PU_REGS(K, B0_, B1_, U0_, U1_) do { const LAS unsigned char* ms_ = meta + ((K) & 1) * 1280; \
            B0_[0] = *(const LAS u32x4_t*)(ms_ + 512 + 16 * kq); B0_[1] = *(const LAS u32x4_t*)(ms_ + 512 + 64 + 16 * kq); B1_[0] = *(const LAS u32x4_t*)(ms_ + 640 + 16 * kq); B1_[1] = *(const LAS u32x4_t*)(ms_ + 640 + 64 + 16 * kq); \
            U0_ = *(const LAS u32x4_t*)(ms_ + 32 * (4 * kq + isel)) & 0xffff0000u; U1_ = *(const LAS u32x4_t*)(ms_ + 32 * (4 * kq + isel) + 16) & 0xffff0000u; } while (0)
        int En[16]; u32x4_t Bc0[2], Bc1[2], Uc0, Uc1;
        PU_META(0); PU_META(1);
        asm volatile("s_waitcnt vmcnt(0)" ::: "memory");
        __builtin_amdgcn_sched_barrier(0);
        PU_IDS(0, En); PU_REGS(0, Bc0, Bc1, Uc0, Uc1);
        asm volatile("s_waitcnt lgkmcnt(0)" : "+v"(Bc0[0]), "+v"(Bc0[1]), "+v"(Bc1[0]), "+v"(Bc1[1]), "+v"(Uc0), "+v"(Uc1) :: "memory");
        __builtin_amdgcn_sched_barrier(0);
#pragma unroll
        for (int gI = 0; gI < 8; ++gI) {
            __builtin_amdgcn_global_load_lds((const unsigned*)(T4a + ((unsigned)En[gI] << 9)), (LAS unsigned*)(ring + (2 * gI) * 1024), 16, 0, 0);
            __builtin_amdgcn_global_load_lds((const unsigned*)(T4b + ((unsigned)En[8 + gI] << 9)), (LAS unsigned*)(ring + (2 * gI + 1) * 1024), 16, 0, 0); }
        __builtin_amdgcn_sched_barrier(0);
        for (int j = 0; j < ntk; ++j) {
            const int t = G.wid + j * G.nworkers;
            PU_META(j + 2);
            __builtin_amdgcn_sched_barrier(0);
            u32x4_t Bn0[2], Bn1[2], Un0, Un1;
            f32x4_t acc[8];
#pragma unroll
            for (int gI = 0; gI < 8; ++gI) acc[gI] = (f32x4_t){0.f, 0.f, 0.f, 0.f};
#pragma unroll
            for (int gI = 0; gI < 8; ++gI) {
                __builtin_amdgcn_sched_barrier(0);
                asm volatile("s_waitcnt vmcnt(15)" ::: "memory");
                __builtin_amdgcn_sched_barrier(0);
                if (gI == 0) { PU_IDS(j + 1, En); PU_REGS(j + 1, Bn0, Bn1, Un0, Un1); }
                const u32x4_t r0 = *(LAS u32x4_t*)(ring + (2 * gI + rsl) * 1024 + rd0), r1 = *(LAS u32x4_t*)(ring + (2 * gI + rsl) * 1024 + rd1);
                if (gI == 0) asm volatile("s_waitcnt lgkmcnt(0)" : "+v"(Bn0[0]), "+v"(Bn0[1]), "+v"(Bn1[0]), "+v"(Bn1[1]), "+v"(Un0), "+v"(Un1) :: "memory");
                else asm volatile("s_waitcnt lgkmcnt(0)" ::: "memory");
                __builtin_amdgcn_global_load_lds((const unsigned*)(T4a + ((unsigned)En[gI] << 9)), (LAS unsigned*)(ring + (2 * gI) * 1024), 16, 0, 0);
                __builtin_amdgcn_global_load_lds((const unsigned*)(T4b + ((unsigned)En[8 + gI] << 9)), (LAS unsigned*)(ring + (2 * gI + 1) * 1024), 16, 0, 0);
                __builtin_amdgcn_sched_barrier(0);
                const i32x8_t A0 = {(int)r0[0], (int)r0[1], (int)r0[2], (int)r0[3], 0, 0, 0, 0}, A1 = {(int)r1[0], (int)r1[1], (int)r1[2], (int)r1[3], 0, 0, 0, 0};
                const i32x8_t B00 = {(int)Bc0[0][0], (int)Bc0[0][1], (int)Bc0[0][2], (int)Bc0[0][3], 0, 0, 0, 0}, B10 = {(int)Bc1[0][0], (int)Bc1[0][1], (int)Bc1[0][2], (int)Bc1[0][3], 0, 0, 0, 0};
                const i32x8_t B01 = {(int)Bc0[1][0], (int)Bc0[1][1], (int)Bc0[1][2], (int)Bc0[1][3], 0, 0, 0, 0}, B11 = {(int)Bc1[1][0], (int)Bc1[1][1], (int)Bc1[1][2], (int)Bc1[1][3], 0, 0, 0, 0};
                acc[gI] = __builtin_amdgcn_mfma_scale_f32_16x16x128_f8f6f4(A0, B00, acc[gI], 4, 4, 0, 127, 0, 128);
                acc[gI] = __builtin_amdgcn_mfma_scale_f32_16x16x128_f8f6f4(A0, B10, acc[gI], 4, 4, 0, 127, 0, 125);
                acc[gI] = __builtin_amdgcn_mfma_scale_f32_16x16x128_f8f6f4(A1, B01, acc[gI], 4, 4, 0, 127, 0, 128);
                acc[gI] = __builtin_amdgcn_mfma_scale_f32_16x16x128_f8f6f4(A1, B11, acc[gI], 4, 4, 0, 127, 0, 125);
            }
            __builtin_amdgcn_sched_barrier(0);
            { float v[8];
#pragma unroll
              for (int gI = 0; gI < 8; ++gI) v[gI] = isel == 0 ? acc[gI][0] : (isel == 1 ? acc[gI][1] : (isel == 2 ? acc[gI][2] : acc[gI][3]));
              if (r16 < 4) { uint4* up = (uint4*)((bf16_t*)UP + ((size_t)s * NTOK + t) * 128 + 8 * (4 * kq + isel));
                  *up = make_uint4(pk_bf16(v[0] * __uint_as_float(Uc0[0]), v[1] * __uint_as_float(Uc0[1])), pk_bf16(v[2] * __uint_as_float(Uc0[2]), v[3] * __uint_as_float(Uc0[3])),
                                   pk_bf16(v[4] * __uint_as_float(Uc1[0]), v[5] * __uint_as_float(Uc1[1])), pk_bf16(v[6] * __uint_as_float(Uc1[2]), v[7] * __uint_as_float(Uc1[3]))); } }
            Bc0[0] = Bn0[0]; Bc0[1] = Bn0[1]; Bc1[0] = Bn1[0]; Bc1[1] = Bn1[1]; Uc0 = Un0; Uc1 = Un1;
        }
        asm volatile("s_waitcnt vmcnt(0)" ::: "memory");
#undef PU_META
#undef PU_IDS
#undef PU_REGS
    }
}
__device__ __forceinline__ void phase_peer_w(const P& p, int l) {
    const float* UP = (const float*)(p.ws + WS_PROJ); float* PG = (float*)(p.ws + WS_PG);
    const int ntok = (l == DEPTH - 1) ? NLAT : NTOK;
    const size_t n4 = (size_t)ntok * 32, stride = (size_t)gridDim.x * NTHR;
    for (size_t i = (size_t)blockIdx.x * NTHR + otid(); i < n4; i += stride) {
        float4 a = ((const float4*)UP)[i];
#pragma unroll
        for (int s = 1; s < 4; ++s) { const float4 b = ((const float4*)UP)[(size_t)s * NTOK * 32 + i]; a.x += b.x; a.y += b.y; a.z += b.z; a.w += b.w; }
        float4 g = ((float4*)PG)[i];
        g.x *= gelu_tanh(a.x); g.y *= gelu_tanh(a.y); g.z *= gelu_tanh(a.z); g.w *= gelu_tanh(a.w);
        ((float4*)PG)[i] = g;
    }
}
__device__ __forceinline__ void phase_peer_w4(const P& p, int l) {
    const bf16_t* UP = (const bf16_t*)(p.ws + WS_PROJ); const float* PG = (const float*)(p.ws + WS_PG); unsigned char* PW4 = p.ws + WS_PW4;
    const int ntok = (l == DEPTH - 1) ? NLAT : NTOK;
    const int lane = otid() & 63, gw = blockIdx.x * NWAVE + owave(), nw = gridDim.x * NWAVE;
    const int k0 = 2 * lane, p0 = 16 * (k0 & 7) + (k0 >> 3), p1 = 16 * ((k0 + 1) & 7) + ((k0 + 1) >> 3);
    for (int tb = gw; tb < ntok; tb += 4 * nw) {
        float u0[4][4], u1[4][4], g0[4], g1[4];
#pragma unroll
        for (int q = 0; q < 4; ++q) { const int t = min(tb + q * nw, ntok - 1);
#pragma unroll
            for (int sl = 0; sl < 4; ++sl) { const bf16_t* u = UP + ((size_t)sl * NTOK + t) * 128; u0[q][sl] = bf1(u[p0]); u1[q][sl] = bf1(u[p1]); }
            g0[q] = PG[(size_t)t * 128 + p0]; g1[q] = PG[(size_t)t * 128 + p1]; }
#pragma unroll
        for (int q = 0; q < 4; ++q) { const int t = tb + q * nw;
            const float a0 = (u0[q][0] + u0[q][1]) + (u0[q][2] + u0[q][3]), a1 = (u1[q][0] + u1[q][1]) + (u1[q][2] + u1[q][3]);
            const float w0 = g0[q] * gelu_tanh(a0), w1 = g1[q] * gelu_tanh(a1);
            const float am = fmaxf(wave_max(fmaxf(fabsf(w0), fabsf(w1))), 1e-30f), inv = 6.0f / am;
            const float b0 = w0 * inv, b1 = w1 * inv;
            const unsigned t0 = __builtin_amdgcn_cvt_scalef32_pk_fp4_f32(0u, b0, b1, 1.0f, 0);
            const auto q0 = __builtin_amdgcn_cvt_scalef32_pk_f32_fp4(t0, 1.0f, 0);
            const unsigned t1 = __builtin_amdgcn_cvt_scalef32_pk_fp4_f32(0u, (b0 - q0[0]) * 4.0f, (b1 - q0[1]) * 4.0f, 1.0f, 0);
            if (t < ntok) { PW4[(size_t)t * 144 + lane] = (unsigned char)(t0 & 0xffu); PW4[(size_t)t * 144 + 64 + lane] = (unsigned char)(t1 & 0xffu);
                if (lane == 0) *(float*)(PW4 + (size_t)t * 144 + 128) = am * (1.0f / 6.0f); } }
    }
}
template <int OFF> __device__ __forceinline__ u32x2_t tr4_read(unsigned ad) { u32x2_t r; asm volatile("ds_read_b64_tr_b4 %0, %1 offset:%2" : "=&v"(r) : "v"(ad), "i"(OFF) : "memory"); return r; }
__device__ __forceinline__ void ld4_nowait(unsigned& d, const void* q) { asm volatile("global_load_dword %0, %1, off" : "=v"(d) : "v"(q) : "memory"); }
__device__ __forceinline__ void ld2_nowait(unsigned& d, const void* q) { asm volatile("global_load_ushort %0, %1, off" : "=v"(d) : "v"(q) : "memory"); }
template <int HH, int A2, int Q> __device__ __forceinline__ void pv_read(u32x2_t (&lo)[2][4], u32x2_t (&hi)[2][4], unsigned rb, const unsigned (&po)[2][2]) {
    lo[A2][Q] = tr4_read<8192 * HH + 8 * (Q & 1)>(rb + po[A2][Q >> 1]); hi[A2][Q] = tr4_read<8192 * HH + 2048 + 8 * (Q & 1)>(rb + po[A2][Q >> 1]); }
__device__ __forceinline__ void phase_peer_v(const P& p, int l, LAS unsigned char* lds) {
    const int tid = otid(), wave = __builtin_amdgcn_readfirstlane(tid >> 6), lane = tid & 63, n16 = lane & 15, kg = lane >> 4, dm = lane >> 3, di = lane & 7;
    const bool last = (l == DEPTH - 1); const int ntok = last ? NLAT : NTOK;
    const unsigned char* T4 = p.ws + WS_VT + (size_t)l * 16384 * 512;
    const unsigned char* PIDXb = p.ws + WS_YCAT; const unsigned char* PW4 = p.ws + WS_PW4;
    bf16_t* X = (bf16_t*)(p.ws + WS_XRES); const float* MOD = (const float*)(p.ws + WS_MOD); float* SSP = (float*)(p.ws + WS_SSP) + (size_t)((l + 1) & 3) * 4 * NTOK;
    LAS unsigned char* meta = lds + PEER_STAGE_OFF + wave * 2560;
    LAS unsigned char* ring = lds + wave * 16384;
    const PeerGeom G = peer_geom(lds, wave);
    const int pc0 = (di - (dm >> 1)) & 7, pc1 = (di - (dm >> 1) - 4) & 7;
    const int tm = n16 & 7, trot = (tm >> 1) + 4 * (n16 >> 3), ub = kg >> 1;
    const unsigned rb = (unsigned)(uintptr_t)ring + (unsigned)((4 * (kg & 1) + (n16 >> 3)) * 1024 + 128 * tm);
    unsigned po[2][2];
#pragma unroll
    for (int a = 0; a < 2; ++a)
#pragma unroll
        for (int qh = 0; qh < 2; ++qh) po[a][qh] = (unsigned)(((4 * ub + 2 * a + qh + trot) & 7) * 16);
    const bool rowok = (((n16 >> 1) & 1) == ub);
    const int scA = (n16 & 1) ? 125 : 127;
    const int aoff = 256 + 64 * (n16 & 1) + 16 * (kg & 1);
    for (int si = 0; si < G.nslice; ++si) {
        const int s = G.slice_lo + si;
        if (G.wid >= ntok) continue;
        const int ntk = (ntok - 1 - G.wid) / G.nworkers + 1;
        const unsigned char* T4a = T4 + 128 * s + 16 * pc0; const unsigned char* T4b = T4 + 128 * s + 16 * pc1;
        float gt[3][4];
#pragma unroll
        for (int sel = 0; sel < 3; ++sel)
#pragma unroll
            for (int c4 = 0; c4 < 4; ++c4) gt[sel][c4] = MOD[(size_t)(l * 3 + sel) * MODW + 5 * D + 256 * s + 64 * c4 + lane];
        asm volatile("s_waitcnt vmcnt(0)" : "+v"(gt[0][0]), "+v"(gt[0][1]), "+v"(gt[0][2]), "+v"(gt[0][3]), "+v"(gt[1][0]), "+v"(gt[1][1]), "+v"(gt[1][2]), "+v"(gt[1][3]), "+v"(gt[2][0]), "+v"(gt[2][1]), "+v"(gt[2][2]), "+v"(gt[2][3]) :: "memory");
#define PV_META(K) do { const int tk_ = G.wid + ((K) < ntk ? (K) : ntk - 1) * G.nworkers; LAS unsigned char* ms_ = meta + ((K) & 1) * 1280; \
            if (lane < 57) __builtin_amdgcn_global_load_lds((const unsigned*)(lane < 16 ? PIDXb + (size_t)tk_ * 256 + 16 * lane : (lane < 25 ? PW4 + (size_t)tk_ * 144 + 16 * (lane - 16) \
                : (const unsigned char*)(X + (size_t)tk_ * D + 256 * s) + 16 * (lane - 25))), (LAS unsigned*)ms_, 16, 0, 0); } while (0)
#define PV_IDS(K, E) do { const LAS unsigned char* ms_ = meta + ((K) & 1) * 1280 + 32 * dm; _Pragma("unroll") for (int q2 = 0; q2 < 2; ++q2) { const u32x4_t ev = *(const LAS u32x4_t*)(ms_ + 16 * q2); \
            _Pragma("unroll") for (int k = 0; k < 4; ++k) { E[8 * q2 + 2 * k] = (int)(ev[k] & 0xffffu); E[8 * q2 + 2 * k + 1] = (int)(ev[k] >> 16); } } } while (0)
#define PV_REGS(K, A_, X_, S_) do { const LAS unsigned char* ms_ = meta + ((K) & 1) * 1280; A_[0] = *(const LAS u32x4_t*)(ms_ + aoff); A_[1] = *(const LAS u32x4_t*)(ms_ + aoff + 32); \
            S_ = *(const LAS float*)(ms_ + 384); _Pragma("unroll") for (int c4 = 0; c4 < 4; ++c4) X_[c4] = (unsigned)*(const LAS unsigned short*)(ms_ + 400 + 2 * (64 * c4 + lane)); } while (0)
        int En[16]; u32x4_t Ac[2]; unsigned xc[4]; float sgc;
        PV_META(0); PV_META(1);
        asm volatile("s_waitcnt vmcnt(0)" ::: "memory");
        __builtin_amdgcn_sched_barrier(0);
        PV_IDS(0, En); PV_REGS(0, Ac, xc, sgc);
        asm volatile("s_waitcnt lgkmcnt(0)" : "+v"(Ac[0]), "+v"(Ac[1]), "+v"(xc[0]), "+v"(xc[1]), "+v"(xc[2]), "+v"(xc[3]), "+v"(sgc) :: "memory");
        __builtin_amdgcn_sched_barrier(0);
#pragma unroll
        for (int sl = 0; sl < 16; ++sl) __builtin_amdgcn_global_load_lds((const unsigned*)(((sl & 1) ? T4b : T4a) + ((unsigned)En[sl] << 9)), (LAS unsigned*)(ring + sl * 1024), 16, 0, 0);
        __builtin_amdgcn_sched_barrier(0);
        for (int j = 0; j < ntk; ++j) {
            const int t = G.wid + j * G.nworkers;
            PV_META(j + 2);
            __builtin_amdgcn_sched_barrier(0);
            f32x4_t acc[2] = {(f32x4_t){0.f, 0.f, 0.f, 0.f}, (f32x4_t){0.f, 0.f, 0.f, 0.f}};
            u32x4_t An[2]; unsigned xn[4]; float sgn;
#pragma unroll
            for (int hh = 0; hh < 2; ++hh) {
                __builtin_amdgcn_sched_barrier(0);
                asm volatile("s_waitcnt vmcnt(9)" ::: "memory");
                __builtin_amdgcn_sched_barrier(0);
                if (hh == 0) { PV_IDS(j + 1, En); PV_REGS(j + 1, An, xn, sgn); }
                u32x2_t lo[2][4], hi[2][4];
                if (hh == 0) { pv_read<0, 0, 0>(lo, hi, rb, po); pv_read<0, 1, 0>(lo, hi, rb, po); pv_read<0, 0, 1>(lo, hi, rb, po); pv_read<0, 1, 1>(lo, hi, rb, po);
                               pv_read<0, 0, 2>(lo, hi, rb, po); pv_read<0, 1, 2>(lo, hi, rb, po); pv_read<0, 0, 3>(lo, hi, rb, po); pv_read<0, 1, 3>(lo, hi, rb, po); }
                else         { pv_read<1, 0, 0>(lo, hi, rb, po); pv_read<1, 1, 0>(lo, hi, rb, po); pv_read<1, 0, 1>(lo, hi, rb, po); pv_read<1, 1, 1>(lo, hi, rb, po);
                               pv_read<1, 0, 2>(lo, hi, rb, po); pv_read<1, 1, 2>(lo, hi, rb, po); pv_read<1, 0, 3>(lo, hi, rb, po); pv_read<1, 1, 3>(lo, hi, rb, po); }
                asm volatile("s_waitcnt lgkmcnt(0)" : "+v"(lo[0][0]), "+v"(lo[0][1]), "+v"(lo[0][2]), "+v"(lo[0][3]), "+v"(lo[1][0]), "+v"(lo[1][1]), "+v"(lo[1][2]), "+v"(lo[1][3]),
                                                      "+v"(hi[0][0]), "+v"(hi[0][1]), "+v"(hi[0][2]), "+v"(hi[0][3]), "+v"(hi[1][0]), "+v"(hi[1][1]), "+v"(hi[1][2]), "+v"(hi[1][3]) :: "memory");
                __builtin_amdgcn_sched_barrier(0);
#pragma unroll
                for (int sl = 0; sl < 8; ++sl) __builtin_amdgcn_global_load_lds((const unsigned*)((((8 * hh + sl) & 1) ? T4b : T4a) + ((unsigned)En[8 * hh + sl] << 9)), (LAS unsigned*)(ring + (8 * hh + sl) * 1024), 16, 0, 0);
                __builtin_amdgcn_sched_barrier(0);
#pragma unroll
                for (int q = 0; q < 4; ++q) {
                    const bool ok = rowok && ((n16 >> 2) == q);
                    const i32x8_t Aq = {ok ? (int)Ac[hh][0] : 0, ok ? (int)Ac[hh][1] : 0, ok ? (int)Ac[hh][2] : 0, ok ? (int)Ac[hh][3] : 0, 0, 0, 0, 0};
#pragma unroll
                    for (int a = 0; a < 2; ++a) {
                        const i32x8_t B = {(int)lo[a][q][0], (int)lo[a][q][1], (int)hi[a][q][0], (int)hi[a][q][1], 0, 0, 0, 0};
                        acc[a] = __builtin_amdgcn_mfma_scale_f32_16x16x128_f8f6f4(Aq, B, acc[a], 4, 4, 0, scA, 0, 127); }
                }
            }
            __builtin_amdgcn_sched_barrier(0);
            { const int sel = row_sel(t); float ssq = 0.f;
#pragma unroll
              for (int c4 = 0; c4 < 4; ++c4) { const int a = c4 & 1, u = c4 >> 1; const float r = acc[a][2 * u] + acc[a][2 * u + 1];
                  const float gate = sel == 0 ? gt[0][c4] : (sel == 1 ? gt[1][c4] : gt[2][c4]);
                  const float xv = fmaf(gate * sgc, r, __uint_as_float(xc[c4] << 16));
                  const unsigned xb = pk_bf16(xv, 0.f) & 0xffffu; const float xr = __uint_as_float(xb << 16); ssq = fmaf(xr, xr, ssq);
                  X[(size_t)t * D + 256 * s + 64 * c4 + lane] = (bf16_t)xb; }
              if (!last) {
                  ssq += dppf<0xB1>(ssq); ssq += dppf<0x4E>(ssq); ssq += dppf<0x141>(ssq); ssq += dppf<0x140>(ssq); ssq = x4_sum(ssq);
                  if (lane == 0) SSP[(size_t)t * 4 + s] = ssq; } }
            Ac[0] = An[0]; Ac[1] = An[1]; sgc = sgn;
#pragma unroll
            for (int c4 = 0; c4 < 4; ++c4) xc[c4] = xn[c4];
        }
        asm volatile("s_waitcnt vmcnt(0)" ::: "memory");
#undef PV_META
#undef PV_IDS
#undef PV_REGS
    }
}
__device__ __forceinline__ void phase_final(const P& p) {
    const bf16_t* X = (const bf16_t*)(p.ws + WS_XRES);
    const int lane = otid() & 63, gw = blockIdx.x * NWAVE + owave(), nw = gridDim.x * NWAVE;
    for (int r = gw; r < NLAT; r += nw) {
        const bf16_t* xr = X + (size_t)r * D; float4 v[4]; float ss = 0.f;
#pragma unroll
        for (int i = 0; i < 4; ++i) { const uint2 w = *(const uint2*)(xr + i * 256 + lane * 4); v[i] = make_float4(bf_lo(w.x), bf_hi(w.x), bf_lo(w.y), bf_hi(w.y)); ss += v[i].x * v[i].x + v[i].y * v[i].y + v[i].z * v[i].z + v[i].w * v[i].w; }
        ss = wave_sum(ss); const float rs = rsqrtf(ss * (1.0f / D) + EPS);
#pragma unroll
        for (int i = 0; i < 4; ++i) { const int col = i * 256 + lane * 4; const float4 gv = *(const float4*)(p.final_norm_g + col);
            float4 o; o.x = v[i].x * rs * gv.x; o.y = v[i].y * rs * gv.y; o.z = v[i].z * rs * gv.z; o.w = v[i].w * rs * gv.w;
            *(float4*)(p.out + (size_t)r * D + col) = o; }
    }
}
__device__ __forceinline__ bool gemm_has_slack(int ntiles) {
    const int G = (int)gridDim.x, c = (int)blockIdx.x; const int mine = c < ntiles ? (ntiles - c + G - 1) / G : 0, most = (ntiles + G - 1) / G;
    return mine < most;
}
__device__ __forceinline__ void gemm_slack_work(const P& p, int l, LAS unsigned char* lds, bool before) {
    if (((blockIdx.x & 1) != 0) != before) return;
    if (l + 1 < DEPTH) deferred_drain(p, l + 1, lds, 1);
    else if (before) { for (int i = 0; i < 3; ++i) __builtin_amdgcn_s_sleep(127); }
}
__device__ __forceinline__ void phase_gemm_in(const P& p, int l, LAS unsigned char* lds) {
    pg8::Gemm g{(const bf16_t*)(p.ws + WS_H), (const bf16_t*)(p.ws + WS_WIN) + (size_t)l * IN_W * D, NTOK, IN_W, D};
    pg8::StaticOrder S; S.init(NTOK, IN_W, (int)gridDim.x, (int)blockIdx.x);
    pg8::EpiStoreBf16 E{(bf16_t*)(p.ws + WS_PROJ), IN_W};
    const bool slack = gemm_has_slack((NTOK / 256) * (IN_W / 256));
    if (slack) gemm_slack_work(p, l, lds, true);
    if (l == 0) pg8::gemm_phase<pg8::EpiStoreBf16, pg8::StaticOrder, false>(lds, g, S, E, nullptr);
    else {
        pg8::Gemm g3{(const bf16_t*)(p.ws + WS_XRES), (const bf16_t*)(p.ws + WS_WIN3) + (size_t)(l - 1) * 3 * IN_W * D, NTOK, IN_W, D, (size_t)IN_W * D * 2};
        pg8::EpiScaleBias<4> E3{(bf16_t*)(p.ws + WS_PROJ), IN_W, (const float*)(p.ws + WS_SSP) + (size_t)l * 4 * NTOK, (const float*)(p.ws + WS_BIASP) + (size_t)l * 3 * 2 * IN_W};
        pg8::gemm_phase<pg8::EpiScaleBias<4>, pg8::StaticOrder, false>(lds, g3, S, E3, nullptr); }
    if (slack) gemm_slack_work(p, l, lds, false);
}
__device__ __forceinline__ void phase_gemm_out(const P& p, int l, LAS unsigned char* lds) {
    const int M = (l == DEPTH - 1) ? NLAT : NTOK;
    pg8::Gemm g{(const bf16_t*)(p.ws + WS_YCAT), (const bf16_t*)(p.ws + WS_WOUT) + (size_t)l * D * D, M, D, D};
    pg8::StaticOrder S; S.init(M, D, (int)gridDim.x, (int)blockIdx.x);
    pg8::EpiResid E{(bf16_t*)(p.ws + WS_XRES), l == 0 ? p.x : (const float*)nullptr, l == 0 ? p.ctx : (const float*)nullptr, D, (const float*)(p.ws + WS_MOD) + (size_t)l * 3 * MODW + 2 * D, MODW, (float*)(p.ws + WS_SSP2)};
    const bool slack = gemm_has_slack((M / 256) * (D / 256));
    if (slack) gemm_slack_work(p, l, lds, true);
    pg8::gemm_phase<pg8::EpiResid, pg8::StaticOrder, false>(lds, g, S, E, nullptr);
    if (slack) gemm_slack_work(p, l, lds, false);
}
__device__ __forceinline__ void phase_gemm_q(const P& p, int l, LAS unsigned char* lds) {
    const int M = (l == DEPTH - 1) ? NLAT : NTOK;
    pg8::Gemm g{(const bf16_t*)(p.ws + WS_XRES), (const bf16_t*)(p.ws + WS_WQ3) + (size_t)l * 3 * QW * D, M, QW, D, (size_t)QW * D * 2};
    pg8::StaticOrder S; S.init(M, QW, (int)gridDim.x, (int)blockIdx.x);
    pg8::EpiScaleBias<16> E{(bf16_t*)(p.ws + WS_Q), QW, (const float*)(p.ws + WS_SSP2), (const float*)(p.ws + WS_BIASP2) + (size_t)l * 3 * 2 * QW};
    const bool slack = gemm_has_slack((M / 256) * (QW / 256));
    if (slack) gemm_slack_work(p, l, lds, true);
    pg8::gemm_phase<pg8::EpiScaleBias<16>, pg8::StaticOrder, false>(lds, g, S, E, nullptr);
    if (slack) gemm_slack_work(p, l, lds, false);
}


#define XB_TMO      128
#define XB_XCNT(j)  (256  + 64 * (j))
#define XB_XSUB(j)  (1280 + 64 * (j))
#define XB_XGEN(j)  (2304 + 64 * (j))
#define XB_TOP      3328
#define XB_TOPGEN   3392
#define XCD_BAR_WORDS 3456
#define XB_SPIN_CAP (1u << 18)

__device__ __forceinline__ unsigned xb_ld(unsigned* p)              { return __hip_atomic_load(p, __ATOMIC_RELAXED, __HIP_MEMORY_SCOPE_AGENT); }
__device__ __forceinline__ unsigned xb_add(unsigned* p, unsigned v) { return __hip_atomic_fetch_add(p, v, __ATOMIC_RELAXED, __HIP_MEMORY_SCOPE_AGENT); }
__device__ __forceinline__ unsigned xb_xcc_id() { return (unsigned)__builtin_amdgcn_s_getreg((3 << 11) | 20) & 0xFu; }
#define XB_SPIN(cond, bar) do { unsigned _sp = 0; while (cond) { __builtin_amdgcn_s_sleep(1); \
    if ((++_sp & 255u) == 0u) { if (xb_ld(&(bar)[XB_TMO])) break; if (_sp > XB_SPIN_CAP) { atomicAdd(&(bar)[XB_TMO], 1u); break; } } } } while (0)
struct XcdBarrier {
    unsigned* bar; unsigned x;
    volatile LAS unsigned* st;
};

__device__ __forceinline__ XcdBarrier xcd_barrier_post(unsigned* bar, volatile LAS unsigned* st) {
    XcdBarrier b; b.bar = bar; b.x = xb_xcc_id(); b.st = st;
    if (threadIdx.x == 0) (void)xb_add(&bar[XB_XCNT(b.x)], 1u);
    return b;
}
__device__ __forceinline__ void xcd_barrier_complete(unsigned* bar, unsigned x, unsigned& nloc, unsigned& nx) {
    const unsigned G = gridDim.x * gridDim.y * gridDim.z;
    unsigned sum, cnt, mine, sp = 0u;
    for (;;) {
        sum = 0u; cnt = 0u; mine = 0u;
#pragma unroll
        for (unsigned j = 0; j < 16; ++j) { const unsigned c = xb_ld(&bar[XB_XCNT(j)]); sum += c; cnt += (c > 0u) ? 1u : 0u; mine = (j == x) ? c : mine; }
        if (sum == G) break;
        __builtin_amdgcn_s_sleep(1);
        if ((++sp & 255u) == 0u) { if (xb_ld(&bar[XB_TMO])) break; if (sp > XB_SPIN_CAP) { atomicAdd(&bar[XB_TMO], 1u); break; } }
    }
    nloc = mine > 0u ? mine : 1u; nx = cnt > 0u ? cnt : 1u;
}

__device__ __forceinline__ void xcd_barrier(const XcdBarrier& b) {
    asm volatile("s_waitcnt vmcnt(0)" ::: "memory");
    __syncthreads();
    if (threadIdx.x == 0) {
        unsigned* bar = b.bar;
        __builtin_amdgcn_s_waitcnt(0);
        unsigned nloc = b.st[0], nx = b.st[1];
        if (nloc == 0u) { xcd_barrier_complete(bar, b.x, nloc, nx); b.st[0] = nloc; b.st[1] = nx; }
        const unsigned old = xb_add(&bar[XB_XSUB(b.x)], 1u);
        const unsigned gen = old / nloc;
        if (old + 1u == (gen + 1u) * nloc) {
            __builtin_amdgcn_fence(__ATOMIC_RELEASE, "agent");
            asm volatile("s_waitcnt vmcnt(0)" ::: "memory");
            const unsigned og = xb_add(&bar[XB_TOP], 1u);
            const unsigned tg = og / nx;
            if (og + 1u == (tg + 1u) * nx) xb_add(&bar[XB_TOPGEN], 1u);
            else XB_SPIN(xb_ld(&bar[XB_TOPGEN]) == tg, bar);
            __builtin_amdgcn_fence(__ATOMIC_ACQUIRE, "agent");
            xb_add(&bar[XB_XGEN(b.x)], 1u);
            asm volatile("s_waitcnt vmcnt(0)" ::: "memory");
        } else {
            XB_SPIN(xb_ld(&bar[XB_XGEN(b.x)]) == gen, bar);
            __builtin_amdgcn_fence(__ATOMIC_ACQUIRE, "agent");
            asm volatile("s_waitcnt vmcnt(0)" ::: "memory");
        }
    }
    __syncthreads();
}

__global__ void __launch_bounds__(NTHR, 2) k_mega(P p) {
    extern __shared__ __attribute__((aligned(16))) unsigned char shm[];
    LAS unsigned char* lds = (LAS unsigned char*)shm;
    volatile LAS unsigned* st = (volatile LAS unsigned*)(lds + ST_OFF);
    if (threadIdx.x < 16) st[threadIdx.x] = 0u;
    __syncthreads();
    (void)xcd_barrier_post((unsigned*)(p.ws + WS_CTL), st);
    if (threadIdx.x == 0) st[4] = xb_add((unsigned*)(p.ws + WS_CTL) + 4096 + 64 * xb_xcc_id(), 1u);
#define GRID_BAR() do { XcdBarrier b_; { size_t z_ = 0; asm volatile("" : "+s"(z_)); b_.bar = (unsigned*)(p.ws + z_ + WS_CTL); } b_.x = xb_xcc_id(); \
        b_.st = (volatile LAS unsigned*)((LAS unsigned char*)shm + ST_OFF); xcd_barrier(b_); } while (0)
    { P q = p; { size_t z_ = 0; asm volatile("" : "+s"(z_)); q.ws = p.ws + z_; } phase_prologue(q, lds); }
    { P q = p; { size_t z_ = 0; asm volatile("" : "+s"(z_)); q.ws = p.ws + z_; } phase_adaln(q, lds); }
    GRID_BAR();
    if (threadIdx.x == 0) {
        unsigned cnt[16], dense = 0u, npop = 0u; const unsigned x = xb_xcc_id();
        for (unsigned j = 0; j < 16u; ++j) { cnt[j] = xb_ld((unsigned*)(p.ws + WS_CTL) + XB_XCNT(j)); if (cnt[j] > 0u) { if (j < x) ++dense; ++npop; } }
        unsigned base = 0u, total = 0u, k = 0u;
        for (unsigned j = 0; j < 16u; ++j) if (cnt[j] > 0u) { if ((k & 3u) == (dense & 3u)) { if (k < dense) base += cnt[j]; total += cnt[j]; } ++k; }
        st[6] = dense; st[7] = base; st[8] = (npop == 8u) ? total : 0u; }
    __syncthreads();
    { P q = p; { size_t z_ = 0; asm volatile("" : "+s"(z_)); q.ws = p.ws + z_; } phase_norm(q, 0, 0);
      for (int c = 256 + 120 + (int)blockIdx.x; c < DEF_NCHUNK; c += (int)gridDim.x) { __syncthreads(); deferred_chunk(q, 0, c, lds); } }
    GRID_BAR();
    for (int l = 0; l < DEPTH; ++l) {
        { P q = p; { size_t z_ = 0; asm volatile("" : "+s"(z_)); q.ws = p.ws + z_; } phase_gemm_in(q, l, lds); }
        GRID_BAR();
        { P q = p; { size_t z_ = 0; asm volatile("" : "+s"(z_)); q.ws = p.ws + z_; } phase_conv(q, l); }
        { P q = p; { size_t z_ = 0; asm volatile("" : "+s"(z_)); q.ws = p.ws + z_; } phase_sgu(q, l, lds); }
        { P q = p; { size_t z_ = 0; asm volatile("" : "+s"(z_)); q.ws = p.ws + z_; } phase_na(q, l, lds); }
        GRID_BAR();
        { P q = p; { size_t z_ = 0; asm volatile("" : "+s"(z_)); q.ws = p.ws + z_; } phase_gemm_out(q, l, lds); }
        GRID_BAR();
        { P q = p; { size_t z_ = 0; asm volatile("" : "+s"(z_)); q.ws = p.ws + z_; } phase_gemm_q(q, l, lds); }
        GRID_BAR();
        { P q = p; { size_t z_ = 0; asm volatile("" : "+s"(z_)); q.ws = p.ws + z_; } phase_topk(q, l, lds); }
        GRID_BAR();
        { P q = p; { size_t z_ = 0; asm volatile("" : "+s"(z_)); q.ws = p.ws + z_; } phase_peer_u(q, l, lds); }
        GRID_BAR();
        { P q = p; { size_t z_ = 0; asm volatile("" : "+s"(z_)); q.ws = p.ws + z_; } phase_peer_w4(q, l); }
        GRID_BAR();
        { P q = p; { size_t z_ = 0; asm volatile("" : "+s"(z_)); q.ws = p.ws + z_; } phase_peer_v(q, l, lds); if (l + 1 < DEPTH) deferred_drain(q, l + 1, lds, 1 << 30); }
        GRID_BAR();
        if (l + 1 == DEPTH) { P q = p; { size_t z_ = 0; asm volatile("" : "+s"(z_)); q.ws = p.ws + z_; } phase_final(q); }
    }
}

extern "C" void kernel_launch(void* const* d_in, const int* in_sizes, int n_in, void* d_out, int out_size, void* d_ws, size_t ws_size, hipStream_t stream) {
    static int grid = 0;
    if (grid == 0) {
        if (n_in != 21 || ws_size < WS_END) { fprintf(stderr, "kernel_launch: expected 21 inputs and >= %zu bytes of workspace, got %d and %zu\n", (size_t)WS_END, n_in, ws_size); grid = -1; return; }
        int dev = 0, cus = 0, per_cu = 0;
        if (hipGetDevice(&dev) != hipSuccess || hipDeviceGetAttribute(&cus, hipDeviceAttributeMultiprocessorCount, dev) != hipSuccess || cus <= 0) cus = 256;
        if (hipFuncSetAttribute((const void*)k_mega, hipFuncAttributeMaxDynamicSharedMemorySize, LDS_BYTES) != hipSuccess) { fprintf(stderr, "kernel_launch: hipFuncSetAttribute failed\n"); grid = -1; return; }
        if (hipOccupancyMaxActiveBlocksPerMultiprocessor(&per_cu, (const void*)k_mega, NTHR, LDS_BYTES) != hipSuccess || per_cu < 1) { fprintf(stderr, "kernel_launch: occupancy query reports %d workgroups per CU\n", per_cu); per_cu = 1; }
        (void)hipGetLastError();
        grid = cus;
    }
    if (grid < 0) return;
    (void)hipMemsetAsync((unsigned char*)d_ws + WS_CTL, 0, 65536, stream);
    P p{};
    const float** pf = (const float**)&p;
    for (int i = 0; i < 21; ++i) pf[i] = (const float*)d_in[i];
    p.out = (float*)d_out; p.ws = (unsigned char*)d_ws;
    hipLaunchKernelGGL(k_mega, dim3(grid), dim3(NTHR), LDS_BYTES, stream, p);
}
```

```cpp
#include <hip/hip_runtime.h>
#include <cstdio>
#include <cstdint>
#include <utility>

#ifndef ONE_LAUNCH
#define ONE_LAUNCH 0
#endif

namespace pg8 {
#define PG8_LAS __attribute__((address_space(3)))
typedef unsigned short bf16_t;
typedef short bf16x8 __attribute__((ext_vector_type(8)));
typedef float f32x4 __attribute__((ext_vector_type(4)));
typedef unsigned u32x4 __attribute__((ext_vector_type(4)));
constexpr int BM = 256, BK = 64, HALF = 128, HTB = HALF * BK * 2  , STAGE_BYTES = 8 * HTB, NXCD = 8, WGM = 8;

__host__ __device__ __forceinline__ int lds_byte(int r, int c) { const int st = (r >> 4) * 2 + (c >> 5), rr = r & 15, cc = c & 31, ob = rr * 64 + cc * 2; return st * 1024 + (ob ^ (((ob >> 9) & 1) << 5)); }
__host__ __device__ __forceinline__ void stage_rc(int b, int& R, int& C) { const int st = b / 1024, sb = b % 1024, swz = sb ^ (((sb >> 9) & 1) << 5); R = (st >> 1) * 16 + swz / 64; C = (st & 1) * 32 + (swz % 64) / 2; }
__host__ __device__ __forceinline__ int perm32(int rho) { const int n = rho >> 4, i = rho & 15; return 8 * (i >> 2) + 4 * n + (i & 3); }

struct Unit { int pm, pn; };
struct Gemm { const bf16_t* A; const bf16_t* Bt; int M, N, K; size_t vbytes; };
__host__ __device__ __forceinline__ int panel_sel(int pm) { return pm < 64 ? 0 : (pm < 128 ? 1 : 2); }

struct StaticOrder {
    int nM, nN, nwg, G, c;
    __host__ __device__ void init(int M, int N, int G_, int c_) { nM = M / BM; nN = N / BM; nwg = nM * nN; G = G_; c = c_; }
    __host__ __device__ bool next(int i, Unit& u) const {
        const long L = (long)i * G + c; if (L >= nwg) return false;
        int wgid = (int)L; { const int q = nwg / NXCD, r = nwg % NXCD, xcd = wgid % NXCD, off = wgid / NXCD; wgid = (xcd < r ? xcd * (q + 1) : r * (q + 1) + (xcd - r) * q) + off; }
        const int nig = WGM * nN, gid = wgid / nig, fm = gid * WGM, gsz = (nM - fm) < WGM ? (nM - fm) : WGM;
        u.pm = fm + ((wgid % nig) % gsz); u.pn = (wgid % nig) / gsz; return true;
    }
    __device__ __forceinline__ void a_ready(const Unit&) const {}
    __device__ __forceinline__ void done(const Unit&) const {}
};

__device__ __forceinline__ unsigned cvt_pk_bf16(float lo, float hi) { unsigned r; asm volatile("v_cvt_pk_bf16_f32 %0, %1, %2" : "=v"(r) : "v"(lo), "v"(hi)); return r; }

struct EpiStoreBf16 {
    static constexpr bool PERM = true, AFTER_DRAIN = false;
    bf16_t* O; int ldc;
    __device__ __forceinline__ void operator()(const f32x4 (&acc)[2][2][4][2], const Unit& u, int wr, int wc, int fr, int fq) const {
        const int row0 = u.pm * BM + wr * 64 + fr, col0 = u.pn * BM + wc * 32 + 8 * fq;
#pragma unroll
        for (int ai = 0; ai < 2; ++ai)
#pragma unroll
            for (int m = 0; m < 4; ++m) { bf16_t* rowp = O + (size_t)(row0 + ai * HALF + m * 16) * ldc + col0;
#pragma unroll
                for (int bj = 0; bj < 2; ++bj) { const f32x4 v0 = acc[ai][bj][m][0], v1 = acc[ai][bj][m][1];
                    u32x4 w; w.x = cvt_pk_bf16(v0[0], v0[1]); w.y = cvt_pk_bf16(v0[2], v0[3]); w.z = cvt_pk_bf16(v1[0], v1[1]); w.w = cvt_pk_bf16(v1[2], v1[3]);
                    *(u32x4*)(rowp + bj * HALF) = w; } }
    }
};
__device__ __forceinline__ float sq8_bf16(const u32x4 w) {
    float s = 0.f;
#pragma unroll
    for (int i = 0; i < 4; ++i) { const float lo = __uint_as_float(w[i] << 16), hi = __uint_as_float(w[i] & 0xffff0000u); s = __builtin_fmaf(lo, lo, s); s = __builtin_fmaf(hi, hi, s); }
    return s; }
__device__ __forceinline__ float x4sum(float x) {
    auto s = __builtin_amdgcn_permlane16_swap(__float_as_uint(x), __float_as_uint(x), false, false); x = __uint_as_float(s[0]) + __uint_as_float(s[1]);
    auto t = __builtin_amdgcn_permlane32_swap(__float_as_uint(x), __float_as_uint(x), false, false); return __uint_as_float(t[0]) + __uint_as_float(t[1]); }
template <int NSS> struct EpiScaleBias {
    static constexpr bool PERM = true, AFTER_DRAIN = false;
    bf16_t* O; int ldc; const float* ssp; const float* bias;
    __device__ __forceinline__ void operator()(const f32x4 (&acc)[2][2][4][2], const Unit& u, int wr, int wc, int fr, int fq) const {
        const int row0 = u.pm * BM + wr * 64 + fr, col0 = u.pn * BM + wc * 32 + 8 * fq;
        const float* bp = bias + (size_t)panel_sel(u.pm) * 2 * ldc + col0;
        f32x4 bv[2][2];
#pragma unroll
        for (int bj = 0; bj < 2; ++bj)
#pragma unroll
            for (int n = 0; n < 2; ++n) bv[bj][n] = *(const f32x4*)(bp + bj * HALF + 4 * n) + *(const f32x4*)(bp + ldc + bj * HALF + 4 * n);
#pragma unroll
        for (int ai = 0; ai < 2; ++ai) {
            float rs[4];
#pragma unroll
            for (int m = 0; m < 4; ++m) { const float* sp = ssp + (size_t)(row0 + ai * HALF + m * 16) * NSS + (NSS / 4) * fq; float sq;
                if constexpr (NSS == 16) { const f32x4 pv = *(const f32x4*)sp; sq = (pv[0] + pv[1]) + (pv[2] + pv[3]); } else sq = sp[0];
                sq = x4sum(sq);
                rs[m] = __builtin_amdgcn_rsqf(sq * (1.0f / 1024.0f) + 1e-6f); }
#pragma unroll
            for (int m = 0; m < 4; ++m) { bf16_t* rowp = O + (size_t)(row0 + ai * HALF + m * 16) * ldc + col0;
#pragma unroll
                for (int bj = 0; bj < 2; ++bj) { const f32x4 v0 = rs[m] * acc[ai][bj][m][0] + bv[bj][0], v1 = rs[m] * acc[ai][bj][m][1] + bv[bj][1];
                    u32x4 w; w.x = cvt_pk_bf16(v0[0], v0[1]); w.y = cvt_pk_bf16(v0[2], v0[3]); w.z = cvt_pk_bf16(v1[0], v1[1]); w.w = cvt_pk_bf16(v1[2], v1[3]);
                    *(u32x4*)(rowp + bj * HALF) = w; } }
        }
    }
};
struct EpiResid {
    static constexpr bool PERM = true, AFTER_DRAIN = false;
    bf16_t* X; const float* Xlat; const float* Xctx; int ldc; const float* gate; int gate_stride; float* ssp;
    __device__ __forceinline__ void operator()(const f32x4 (&acc)[2][2][4][2], const Unit& u, int wr, int wc, int fr, int fq) const {
        const int row0 = u.pm * BM + wr * 64 + fr, col0 = u.pn * BM + wc * 32 + 8 * fq;
        const float* gp = gate + (size_t)(u.pm < 64 ? 0 : (u.pm < 128 ? 1 : 2)) * gate_stride + col0;
        f32x4 gv[2][2];
#pragma unroll
        for (int bj = 0; bj < 2; ++bj)
#pragma unroll
            for (int n = 0; n < 2; ++n) gv[bj][n] = *(const f32x4*)(gp + bj * HALF + 4 * n);
        float sq[2][4] = {{0.f, 0.f, 0.f, 0.f}, {0.f, 0.f, 0.f, 0.f}};
        if (Xlat != nullptr) {
#pragma unroll
            for (int am = 0; am < 2; ++am)
#pragma unroll
                for (int mh = 0; mh < 2; ++mh) {
                    f32x4 xv[2][2][2];
#pragma unroll
                    for (int m2 = 0; m2 < 2; ++m2) { const int row = row0 + am * HALF + (2 * mh + m2) * 16; const float* rowp = (u.pm < 128 ? Xlat + (size_t)row * ldc : Xctx + (size_t)(row - 32768) * ldc) + col0;
#pragma unroll
                        for (int bj = 0; bj < 2; ++bj)
#pragma unroll
                            for (int n = 0; n < 2; ++n) xv[m2][bj][n] = *(const f32x4*)(rowp + bj * HALF + 4 * n); }
#pragma unroll
                    for (int m2 = 0; m2 < 2; ++m2) { const int m = 2 * mh + m2; bf16_t* rowp = X + (size_t)(row0 + am * HALF + m * 16) * ldc + col0;
#pragma unroll
                        for (int bj = 0; bj < 2; ++bj) { const f32x4 v0 = xv[m2][bj][0] + gv[bj][0] * acc[am][bj][m][0], v1 = xv[m2][bj][1] + gv[bj][1] * acc[am][bj][m][1];
                            u32x4 w; w.x = cvt_pk_bf16(v0[0], v0[1]); w.y = cvt_pk_bf16(v0[2], v0[3]); w.z = cvt_pk_bf16(v1[0], v1[1]); w.w = cvt_pk_bf16(v1[2], v1[3]);
                            sq[am][m] += sq8_bf16(w);
                            *(u32x4*)(rowp + bj * HALF) = w; } }
                }
        } else {
#pragma unroll
            for (int am = 0; am < 2; ++am) {
                u32x4 xb[4][2];
#pragma unroll
                for (int m = 0; m < 4; ++m) { const bf16_t* rowp = X + (size_t)(row0 + am * HALF + m * 16) * ldc + col0;
#pragma unroll
                    for (int bj = 0; bj < 2; ++bj) xb[m][bj] = *(const u32x4*)(rowp + bj * HALF); }
#pragma unroll
                for (int m = 0; m < 4; ++m) { bf16_t* rowp = X + (size_t)(row0 + am * HALF + m * 16) * ldc + col0;
#pragma unroll
                    for (int bj = 0; bj < 2; ++bj) { const u32x4 b = xb[m][bj]; const f32x4 g0 = gv[bj][0], g1 = gv[bj][1], a0 = acc[am][bj][m][0], a1 = acc[am][bj][m][1];
                        u32x4 w;
                        w.x = cvt_pk_bf16(__uint_as_float(b.x << 16) + g0[0] * a0[0], __uint_as_float(b.x & 0xffff0000u) + g0[1] * a0[1]);
                        w.y = cvt_pk_bf16(__uint_as_float(b.y << 16) + g0[2] * a0[2], __uint_as_float(b.y & 0xffff0000u) + g0[3] * a0[3]);
                        w.z = cvt_pk_bf16(__uint_as_float(b.z << 16) + g1[0] * a1[0], __uint_as_float(b.z & 0xffff0000u) + g1[1] * a1[1]);
                        w.w = cvt_pk_bf16(__uint_as_float(b.w << 16) + g1[2] * a1[2], __uint_as_float(b.w & 0xffff0000u) + g1[3] * a1[3]);
                        sq[am][m] += sq8_bf16(w);
                        *(u32x4*)(rowp + bj * HALF) = w; } }
            }
        }
#pragma unroll
        for (int am = 0; am < 2; ++am)
#pragma unroll
            for (int m = 0; m < 4; ++m) { const float t = x4sum(sq[am][m]); if (fq == 0) ssp[(size_t)(row0 + am * HALF + m * 16) * 16 + 4 * u.pn + wc] = t; }
    }
};

template <class Epi, class Sched, bool STAMP = false>
__device__ __forceinline__ void gemm_phase(PG8_LAS unsigned char* lds, const Gemm g, const Sched& S, const Epi& E, unsigned long long* stamps) {
    int tid_ = threadIdx.x; asm volatile("" : "+v"(tid_));
    const int tid = tid_, wid = __builtin_amdgcn_readfirstlane(tid >> 6), lane = tid & 63, wr = wid >> 2, wc = wid & 3, fr = lane & 15, fq = lane >> 4;
    const int K = g.K, nt = K / BK;
    int ts_lo = 0, ts_hi = 0, nts = 0; const unsigned long long rt_entry = STAMP ? (unsigned long long)wall_clock64() : 0ull;
#define PG8_STAMP() do { if (STAMP && wid == 0 && nts < 64) { const unsigned long long _c = (unsigned long long)clock64(); \
        ts_lo = (lane == nts) ? (int)(unsigned)_c : ts_lo; ts_hi = (lane == nts) ? (int)(unsigned)(_c >> 32) : ts_hi; ++nts; } } while (0)
    PG8_STAMP();
    unsigned voffA[2], voffB[2];
#pragma unroll
    for (int i = 0; i < 2; ++i) { int R, C; stage_rc(tid * 16 + i * 8192, R, C); const int Rb = Epi::PERM ? ((R & ~31) + perm32(R & 31)) : R;
        voffA[i] = (unsigned)(R * K + C) * 2u; voffB[i] = (unsigned)(Rb * K + C) * 2u; }
    const size_t kstep = (size_t)(BK * 2);
    const size_t hstep = (size_t)HALF * K * 2;
    const size_t tstep = 2 * hstep;
    const unsigned ldsw = (unsigned)wid * 1024u;
    const int aoff = lds_byte(wr * 64 + fr, fq * 8), boff = lds_byte(wc * 32 + fr, fq * 8);
#define PG8_SA(b, h) (((b) * 2 + (h)) * HTB)
#define PG8_SB(b, h) ((4 + (b) * 2 + (h)) * HTB)
#define PG8_STAGE(bufoff, gbase, voff) do { _Pragma("unroll") for (int _i = 0; _i < 2; ++_i) \
        __builtin_amdgcn_global_load_lds((const unsigned*)((const char*)(gbase) + (voff)[_i]), (PG8_LAS unsigned*)(lds + (bufoff) + ldsw + _i * 8192), 16, 0, 0); } while (0)
#define PG8_LDA(dst, b, h) do { _Pragma("unroll") for (int m = 0; m < 4; ++m) _Pragma("unroll") for (int k = 0; k < 2; ++k) dst[m][k] = *(const PG8_LAS bf16x8*)(lds + PG8_SA(b, h) + aoff + m * 2048 + k * 1024); } while (0)
#define PG8_LDB(dst, b, h) do { _Pragma("unroll") for (int n = 0; n < 2; ++n) _Pragma("unroll") for (int k = 0; k < 2; ++k) dst[n][k] = *(const PG8_LAS bf16x8*)(lds + PG8_SB(b, h) + boff + n * 2048 + k * 1024); } while (0)
#define PG8_MMA(ai, bj, At, Bt) do { __builtin_amdgcn_s_setprio(1); _Pragma("unroll") for (int m = 0; m < 4; ++m) _Pragma("unroll") for (int n = 0; n < 2; ++n) _Pragma("unroll") for (int k = 0; k < 2; ++k) \
        acc[ai][bj][m][n] = __builtin_amdgcn_mfma_f32_16x16x32_bf16(Bt[n][k], At[m][k], acc[ai][bj][m][n], 0, 0, 0); __builtin_amdgcn_s_setprio(0); } while (0)
#define PG8_WAIT_V(n) asm volatile("s_waitcnt vmcnt(" #n ")" ::: "memory")
#define PG8_WAIT_L(n) asm volatile("s_waitcnt lgkmcnt(" #n ")" ::: "memory")
#define PG8_BAR __builtin_amdgcn_s_barrier()
#define PG8_SCHED __builtin_amdgcn_sched_barrier(0)
    Unit cur, nxt; int ui = 0;
    if (!S.next(0, cur)) return;
    f32x4 acc[2][2][4][2];
#pragma unroll
    for (int a = 0; a < 2; ++a)
#pragma unroll
        for (int b = 0; b < 2; ++b)
#pragma unroll
            for (int m = 0; m < 4; ++m)
#pragma unroll
                for (int n = 0; n < 2; ++n) acc[a][b][m][n] = (f32x4){0.f, 0.f, 0.f, 0.f};
    bf16x8 At[4][2], B0[2][2], B1[2][2];
    const char* cA = (const char*)g.A + (size_t)cur.pm * tstep; const char* cB = (const char*)g.Bt + (size_t)cur.pn * tstep + (size_t)panel_sel(cur.pm) * g.vbytes;
    S.a_ready(cur);
    PG8_STAGE(PG8_SB(0, 0), cB, voffB); PG8_STAGE(PG8_SA(0, 0), cA, voffA); PG8_STAGE(PG8_SB(0, 1), cB + hstep, voffB); PG8_STAGE(PG8_SA(0, 1), cA + hstep, voffA);
    if (wr == 1) PG8_BAR;
    PG8_WAIT_V(4); PG8_BAR;
    PG8_STAGE(PG8_SB(1, 0), cB + kstep, voffB); PG8_STAGE(PG8_SA(1, 0), cA + kstep, voffA); PG8_STAGE(PG8_SB(1, 1), cB + hstep + kstep, voffB);
    PG8_WAIT_V(6); PG8_BAR;
    PG8_STAMP();
    for (;;) {
        const bool has_next = S.next(ui + 1, nxt);
        const char* nA = has_next ? (const char*)g.A + (size_t)nxt.pm * tstep : cA; const char* nB = has_next ? (const char*)g.Bt + (size_t)nxt.pn * tstep + (size_t)panel_sel(nxt.pm) * g.vbytes : cB;
        for (int t = 0; t < nt; t += 2) {
            const bool last = (t == nt - 2);
            const char* a1 = cA + (size_t)(t + 1) * kstep;
            const char* a2 = last ? nA : cA + (size_t)(t + 2) * kstep; const char* b2 = last ? nB : cB + (size_t)(t + 2) * kstep;
            const char* a3 = a2 + kstep; const char* b3 = b2 + kstep;
            if (last && has_next) S.a_ready(nxt);
            PG8_LDB(B0, 0, 0); PG8_SCHED; PG8_LDA(At, 0, 0); PG8_STAGE(PG8_SA(1, 1), a1 + hstep, voffA);
            PG8_WAIT_L(8); PG8_BAR; PG8_WAIT_L(0); PG8_MMA(0, 0, At, B0); PG8_BAR; PG8_SCHED;
            PG8_LDB(B1, 0, 1); PG8_STAGE(PG8_SB(0, 0), b2, voffB);
            PG8_BAR; PG8_WAIT_L(0); PG8_MMA(0, 1, At, B1); PG8_BAR;
            PG8_LDA(At, 0, 1); PG8_STAGE(PG8_SA(0, 0), a2, voffA);
            PG8_BAR; PG8_WAIT_L(0); PG8_MMA(1, 0, At, B0); PG8_BAR; PG8_SCHED;
            PG8_STAGE(PG8_SB(0, 1), b2 + hstep, voffB);
            PG8_WAIT_V(6); PG8_BAR; PG8_MMA(1, 1, At, B1); PG8_BAR;
            PG8_LDB(B0, 1, 0); PG8_SCHED; PG8_LDA(At, 1, 0); PG8_STAGE(PG8_SA(0, 1), a2 + hstep, voffA);
            PG8_WAIT_L(8); PG8_BAR; PG8_WAIT_L(0); PG8_MMA(0, 0, At, B0); PG8_BAR; PG8_SCHED;
            PG8_LDB(B1, 1, 1); PG8_STAGE(PG8_SB(1, 0), b3, voffB);
            PG8_BAR; PG8_WAIT_L(0); PG8_MMA(0, 1, At, B1); PG8_BAR;
            PG8_LDA(At, 1, 1); PG8_STAGE(PG8_SA(1, 0), a3, voffA);
            PG8_BAR; PG8_WAIT_L(0); PG8_MMA(1, 0, At, B0); PG8_BAR; PG8_SCHED;
            PG8_STAGE(PG8_SB(1, 1), b3 + hstep, voffB);
            PG8_WAIT_V(6); PG8_BAR; PG8_MMA(1, 1, At, B1); PG8_BAR;
        }
        PG8_STAMP();
        if constexpr (!Epi::AFTER_DRAIN) { E(acc, cur, wr, wc, fr, fq); S.done(cur); }
        PG8_STAMP();
        if (!has_next) break;
#pragma unroll
        for (int a = 0; a < 2; ++a)
#pragma unroll
            for (int b = 0; b < 2; ++b)
#pragma unroll
                for (int m = 0; m < 4; ++m)
#pragma unroll
                    for (int n = 0; n < 2; ++n) acc[a][b][m][n] = (f32x4){0.f, 0.f, 0.f, 0.f};
        cur = nxt; cA = nA; cB = nB; ++ui;
    }
    PG8_WAIT_V(0);
    if (wr == 0) PG8_BAR;
    PG8_BAR;
    if constexpr (Epi::AFTER_DRAIN) { E.fused(acc, cur, wr, wc, fr, fq, lds, wid, lane); S.done(cur); }
    PG8_STAMP();
    if (STAMP && wid == 0) { stamps[lane] = lane < nts ? (((unsigned long long)(unsigned)ts_hi << 32) | (unsigned)ts_lo) : 0ull;
        if (lane == 62) stamps[62] = rt_entry; if (lane == 63) stamps[63] = (unsigned long long)wall_clock64(); }
#undef PG8_STAMP
#undef PG8_SA
#undef PG8_SB
#undef PG8_STAGE
#undef PG8_LDA
#undef PG8_LDB
#undef PG8_MMA
#undef PG8_WAIT_V
#undef PG8_WAIT_L
#undef PG8_BAR
#undef PG8_SCHED
}
}

#define LAS __attribute__((address_space(3)))
typedef unsigned short bf16_t;
constexpr int D = 1024, T = 16384, NLAT = 32768, CTXL = 256, NTOK = 33280, DEPTH = 4;
constexpr int IN_W = 2816, QW = 2048;
constexpr int C_GB = 0, C_GC = 256, C_XI = 512, C_SU = 768, C_SV = 1024, C_Q = 1280, C_K = 1792, C_V = 2304;
constexpr int MODW = 6144;
constexpr float EPS = 1e-6f;
constexpr int NTHR = 512, NWAVE = 8;
constexpr int ST_OFF = 131072 + 1024 + 20480 + 2048;
constexpr int LDS_BYTES = ST_OFF + 1024;

constexpr size_t MiB = 1u << 20;
constexpr size_t WS_CTL = 0;
constexpr size_t WS_MOD = 1 * MiB;
constexpr size_t WS_US = 1 * MiB + 512 * 1024;
constexpr size_t WS_VS = 1 * MiB + 768 * 1024;
constexpr size_t WS_WIN = 2 * MiB;
constexpr size_t WS_WOUT = WS_WIN + 22 * MiB;
constexpr size_t WS_WQ = WS_WOUT + 8 * MiB;
constexpr size_t WS_SUBK = WS_WQ + 16 * MiB;
constexpr size_t WS_UT = WS_SUBK + 2 * MiB;
constexpr size_t WS_VT = WS_UT + 128 * MiB;
constexpr size_t WS_XRES = WS_VT + 128 * MiB;
constexpr size_t WS_H = WS_XRES + 130 * MiB;
constexpr size_t WS_PROJ = WS_H + 65 * MiB;
constexpr size_t WS_H4 = WS_PROJ + 96 * MiB;
constexpr size_t WS_PW4 = WS_PROJ + 150 * MiB;
constexpr size_t WS_YCAT = WS_PROJ + 179 * MiB;
constexpr size_t WS_Q = WS_YCAT + 65 * MiB;
constexpr size_t WS_PIDX = WS_Q + 130 * MiB;
constexpr size_t WS_PG = WS_PIDX + 17 * MiB;
constexpr size_t WS_SGUW = WS_PG + 16 * MiB + 512 * 1024;
constexpr size_t WS_END = WS_PG + 17 * MiB;
constexpr size_t WS_WIN3 = WS_UT + 32 * MiB;
constexpr size_t WS_BIASP = WS_XRES + 65 * MiB;
constexpr size_t WS_WQ3 = WS_VT + 32 * MiB;
constexpr size_t WS_BIASP2 = WS_XRES + 65 * MiB + 512 * 1024;
constexpr size_t WS_SSP2 = WS_XRES + 70 * MiB;
constexpr size_t WS_SSP = WS_XRES + 66 * MiB;

struct P {
    const float *x, *c, *ctx, *c_ctx, *ada_w, *ada_b, *norm1_g, *w_in, *conv_w, *sgu_w, *sgu_b, *sgu_norm_g, *na_rpb, *out_norm_g, *w_out, *norm2_g,
                *peer_wq, *peer_subkeys, *peer_u, *peer_v, *final_norm_g;
    float* out; unsigned char* ws;
};

__device__ __forceinline__ float bf_lo(unsigned u) { return __uint_as_float(u << 16); }
__device__ __forceinline__ float bf_hi(unsigned u) { return __uint_as_float(u & 0xffff0000u); }
__device__ __forceinline__ float bf1(bf16_t b) { return __uint_as_float(((unsigned)b) << 16); }
__device__ __forceinline__ unsigned pk_bf16(float lo, float hi) { return pg8::cvt_pk_bf16(lo, hi); }
__device__ __forceinline__ float wave_sum(float v) {
#pragma unroll
    for (int o = 32; o >= 1; o >>= 1) v += __shfl_xor(v, o);
    return v; }
__device__ __forceinline__ float wave_max(float v) {
#pragma unroll
    for (int o = 32; o >= 1; o >>= 1) v = fmaxf(v, __shfl_xor(v, o));
    return v; }
__device__ __forceinline__ float gelu_tanh(float x) {
    const float y = 0.7978845608f * (x + 0.044715f * x * x * x);
    const float e = __expf(2.0f * y);
    const float th = 1.0f - 2.0f * __builtin_amdgcn_rcpf(1.0f + e);
    return 0.5f * x * (1.0f + th); }
__device__ __forceinline__ void unpack8(const uint4 v, float (&f)[8]) {
    f[0] = bf_lo(v.x); f[1] = bf_hi(v.x); f[2] = bf_lo(v.y); f[3] = bf_hi(v.y); f[4] = bf_lo(v.z); f[5] = bf_hi(v.z); f[6] = bf_lo(v.w); f[7] = bf_hi(v.w); }
__device__ __forceinline__ float dot8(const uint4 a, const uint4 b, float acc) {
    acc = fmaf(bf_lo(a.x), bf_lo(b.x), acc); acc = fmaf(bf_hi(a.x), bf_hi(b.x), acc);
    acc = fmaf(bf_lo(a.y), bf_lo(b.y), acc); acc = fmaf(bf_hi(a.y), bf_hi(b.y), acc);
    acc = fmaf(bf_lo(a.z), bf_lo(b.z), acc); acc = fmaf(bf_hi(a.z), bf_hi(b.z), acc);
    acc = fmaf(bf_lo(a.w), bf_lo(b.w), acc); acc = fmaf(bf_hi(a.w), bf_hi(b.w), acc);
    return acc; }
__device__ __forceinline__ int row_sel(int r) { return r < T ? 0 : (r < NLAT ? 1 : 2); }

__device__ __forceinline__ int otid() { int t = threadIdx.x; asm volatile("" : "+v"(t)); return t; }

__device__ __forceinline__ int owave() { return __builtin_amdgcn_readfirstlane(otid() >> 6); }

__device__ __forceinline__ void transpose_cvt(const float* src, int K, int N, bf16_t* dst, LAS float* tile) {
    const int tid = otid(), tn = N / 64, ntile = (K / 64) * tn;
    const int kk = tid >> 4, nn = (tid & 15) * 4;
    float4 v[2];
    if ((int)blockIdx.x < ntile) { const int k0 = ((int)blockIdx.x / tn) * 64, n0 = ((int)blockIdx.x % tn) * 64;
#pragma unroll
        for (int i = 0; i < 2; ++i) v[i] = *(const float4*)(src + (size_t)(k0 + kk + 32 * i) * N + n0 + nn); }
    for (int t = blockIdx.x; t < ntile; t += gridDim.x) {
        const int k0 = (t / tn) * 64, n0 = (t % tn) * 64;
#pragma unroll
        for (int i = 0; i < 2; ++i) { const int k = kk + 32 * i;
            tile[k * 65 + nn + 0] = v[i].x; tile[k * 65 + nn + 1] = v[i].y; tile[k * 65 + nn + 2] = v[i].z; tile[k * 65 + nn + 3] = v[i].w; }
        __syncthreads();
        { const int t2 = t + (int)gridDim.x;
          if (t2 < ntile) { const int k2 = (t2 / tn) * 64, n2 = (t2 % tn) * 64;
#pragma unroll
              for (int i = 0; i < 2; ++i) v[i] = *(const float4*)(src + (size_t)(k2 + kk + 32 * i) * N + n2 + nn); } }
        const int n = tid >> 3, kc = (tid & 7) * 8;
        uint4 w;
        w.x = pk_bf16(tile[(kc + 0) * 65 + n], tile[(kc + 1) * 65 + n]); w.y = pk_bf16(tile[(kc + 2) * 65 + n], tile[(kc + 3) * 65 + n]);
        w.z = pk_bf16(tile[(kc + 4) * 65 + n], tile[(kc + 5) * 65 + n]); w.w = pk_bf16(tile[(kc + 6) * 65 + n], tile[(kc + 7) * 65 + n]);
        *(uint4*)(dst + (size_t)(n0 + n) * K + k0 + kc) = w;
        __syncthreads();
    }
}
__device__ __forceinline__ void cvt_copy(const float* src, bf16_t* dst, size_t n) {
    const size_t stride = (size_t)gridDim.x * NTHR;
    for (size_t i = (size_t)blockIdx.x * NTHR + otid(); i < n / 8; i += stride) {
        const float4 a = ((const float4*)src)[2 * i], b = ((const float4*)src)[2 * i + 1];
        uint4 w; w.x = pk_bf16(a.x, a.y); w.y = pk_bf16(a.z, a.w); w.z = pk_bf16(b.x, b.y); w.w = pk_bf16(b.z, b.w);
        ((uint4*)dst)[i] = w; }
}
typedef float f32x2_t __attribute__((ext_vector_type(2)));
__device__ __forceinline__ void quant_rows_fp4(const float* src, unsigned char* dst, float* scale, int nrows) {
    const int lane = otid() & 63, gw = blockIdx.x * NWAVE + owave(), nw = gridDim.x * NWAVE;
    float4 nx[4];
    { const float4* sp = (const float4*)(src + (size_t)(gw < nrows ? gw : 0) * 1024 + lane * 16); nx[0] = sp[0]; nx[1] = sp[1]; nx[2] = sp[2]; nx[3] = sp[3]; }
    for (int r = gw; r < nrows; r += nw) {
        const float4 a = nx[0], b = nx[1], c = nx[2], d = nx[3];
        { const int r2 = (r + nw < nrows) ? r + nw : r; const float4* sp = (const float4*)(src + (size_t)r2 * 1024 + lane * 16); nx[0] = sp[0]; nx[1] = sp[1]; nx[2] = sp[2]; nx[3] = sp[3]; }
        float m = fmaxf(fmaxf(fmaxf(fabsf(a.x), fabsf(a.y)), fmaxf(fabsf(a.z), fabsf(a.w))), fmaxf(fmaxf(fabsf(b.x), fabsf(b.y)), fmaxf(fabsf(b.z), fabsf(b.w))));
        m = fmaxf(m, fmaxf(fmaxf(fmaxf(fabsf(c.x), fabsf(c.y)), fmaxf(fabsf(c.z), fabsf(c.w))), fmaxf(fmaxf(fabsf(d.x), fabsf(d.y)), fmaxf(fabsf(d.z), fabsf(d.w)))));
        m = wave_max(m); m = fmaxf(m, 1e-30f);
        const float inv = 6.0f / m;
        unsigned w0 = 0u, w1 = 0u;
        w0 = __builtin_amdgcn_cvt_scalef32_pk_fp4_f32(w0, a.x * inv, a.y * inv, 1.0f, 0); w0 = __builtin_amdgcn_cvt_scalef32_pk_fp4_f32(w0, a.z * inv, a.w * inv, 1.0f, 1);
        w0 = __builtin_amdgcn_cvt_scalef32_pk_fp4_f32(w0, b.x * inv, b.y * inv, 1.0f, 2); w0 = __builtin_amdgcn_cvt_scalef32_pk_fp4_f32(w0, b.z * inv, b.w * inv, 1.0f, 3);
        w1 = __builtin_amdgcn_cvt_scalef32_pk_fp4_f32(w1, c.x * inv, c.y * inv, 1.0f, 0); w1 = __builtin_amdgcn_cvt_scalef32_pk_fp4_f32(w1, c.z * inv, c.w * inv, 1.0f, 1);
        w1 = __builtin_amdgcn_cvt_scalef32_pk_fp4_f32(w1, d.x * inv, d.y * inv, 1.0f, 2); w1 = __builtin_amdgcn_cvt_scalef32_pk_fp4_f32(w1, d.z * inv, d.w * inv, 1.0f, 3);
        *(uint2*)(dst + (size_t)r * 512 + lane * 8) = make_uint2(w0, w1);
        if (lane == 0) scale[r] = m * (1.0f / 6.0f);
    }
}
__device__ __forceinline__ void phase_prologue(const P& p, LAS unsigned char* lds) {
    unsigned char* ws = p.ws;
    transpose_cvt(p.w_in, D, IN_W, (bf16_t*)(ws + WS_WIN), (LAS float*)lds);
    transpose_cvt(p.w_out, D, D, (bf16_t*)(ws + WS_WOUT), (LAS float*)lds);
    cvt_copy(p.peer_subkeys, (bf16_t*)(ws + WS_SUBK), (size_t)DEPTH * 8 * 2 * 128 * 128);
    cvt_copy(p.sgu_w, (bf16_t*)(ws + WS_SGUW), (size_t)DEPTH * 4 * 128 * 128);
    quant_rows_fp4(p.peer_u, ws + WS_UT, (float*)(ws + WS_US), 16384);
    quant_rows_fp4(p.peer_v, ws + WS_VT, (float*)(ws + WS_VS), 16384);
}
constexpr int DEF_NCHUNK = 256 + 184;
__device__ __forceinline__ void deferred_chunk(const P& p, int L, int c, LAS unsigned char* lds) {
    unsigned char* ws = p.ws;
    const int tid = otid(), wave = __builtin_amdgcn_readfirstlane(tid >> 6), lane = tid & 63;
    if (c < 256) {
        const bool isv = c >= 128; const int row0 = (c & 127) * 128 + wave * 16;
        const float* src = (isv ? p.peer_v : p.peer_u) + ((size_t)L * 16384 + row0) * 1024 + lane * 16;
        unsigned char* dst = ws + (isv ? WS_VT : WS_UT) + ((size_t)L * 16384 + row0) * 512 + lane * 8;
        float* scale = (float*)(ws + (isv ? WS_VS : WS_US)) + (size_t)L * 16384 + row0;
        for (int r4 = 0; r4 < 16; r4 += 4) {
            float4 x[4][4];
#pragma unroll
            for (int q = 0; q < 4; ++q) { const float4* sp = (const float4*)(src + (size_t)(r4 + q) * 1024); x[q][0] = sp[0]; x[q][1] = sp[1]; x[q][2] = sp[2]; x[q][3] = sp[3]; }
#pragma unroll
            for (int q = 0; q < 4; ++q) {
                const float4 a = x[q][0], b = x[q][1], cc = x[q][2], d = x[q][3];
                float m = fmaxf(fmaxf(fmaxf(fabsf(a.x), fabsf(a.y)), fmaxf(fabsf(a.z), fabsf(a.w))), fmaxf(fmaxf(fabsf(b.x), fabsf(b.y)), fmaxf(fabsf(b.z), fabsf(b.w))));
                m = fmaxf(m, fmaxf(fmaxf(fmaxf(fabsf(cc.x), fabsf(cc.y)), fmaxf(fabsf(cc.z), fabsf(cc.w))), fmaxf(fmaxf(fabsf(d.x), fabsf(d.y)), fmaxf(fabsf(d.z), fabsf(d.w)))));
                m = wave_max(m); m = fmaxf(m, 1e-30f);
                const float inv = 6.0f / m;
                unsigned w0 = 0u, w1 = 0u;
                w0 = __builtin_amdgcn_cvt_scalef32_pk_fp4_f32(w0, a.x * inv, a.y * inv, 1.0f, 0); w0 = __builtin_amdgcn_cvt_scalef32_pk_fp4_f32(w0, a.z * inv, a.w * inv, 1.0f, 1);
                w0 = __builtin_amdgcn_cvt_scalef32_pk_fp4_f32(w0, b.x * inv, b.y * inv, 1.0f, 2); w0 = __builtin_amdgcn_cvt_scalef32_pk_fp4_f32(w0, b.z * inv, b.w * inv, 1.0f, 3);
                w1 = __builtin_amdgcn_cvt_scalef32_pk_fp4_f32(w1, cc.x * inv, cc.y * inv, 1.0f, 0); w1 = __builtin_amdgcn_cvt_scalef32_pk_fp4_f32(w1, cc.z * inv, cc.w * inv, 1.0f, 1);
                w1 = __builtin_amdgcn_cvt_scalef32_pk_fp4_f32(w1, d.x * inv, d.y * inv, 1.0f, 2); w1 = __builtin_amdgcn_cvt_scalef32_pk_fp4_f32(w1, d.z * inv, d.w * inv, 1.0f, 3);
                *(uint2*)(dst + (size_t)(r4 + q) * 512) = make_uint2(w0, w1);
                if (lane == 0) scale[r4 + q] = m * (1.0f / 6.0f);
            }
        }
    } else {
        LAS float* tile = (LAS float*)lds;
        const int kk = tid >> 4, nn = (tid & 15) * 4, n = tid >> 3, kc = (tid & 7) * 8;
        auto tile_of = [&](int q, const float*& src, bf16_t*& dst, int& N, int& k0, int& n0) { int t = (c - 256) * 8 + q;
            if (t < 704) { src = p.w_in + (size_t)L * D * IN_W; dst = (bf16_t*)(ws + WS_WIN3) + (size_t)(L - 1) * 3 * IN_W * D; N = IN_W; k0 = (t & 15) * 64; n0 = (t >> 4) * 64; return; }
            else if (t < 960) { t -= 704; src = p.w_out + (size_t)L * D * D; dst = (bf16_t*)(ws + WS_WOUT) + (size_t)L * D * D; N = D; }
            else { t -= 960; src = p.peer_wq + (size_t)L * D * QW; dst = (bf16_t*)(ws + WS_WQ3) + (size_t)L * 3 * QW * D; N = QW; k0 = (t & 15) * 64; n0 = (t >> 4) * 64; return; }
            const int tn = N / 64; k0 = (t / tn) * 64; n0 = (t % tn) * 64; };
        const int t0_ = (c - 256) * 8;
        const bool isq = t0_ >= 960, win = t0_ < 704 || isq;
        const float* gvec = (isq ? p.norm2_g : p.norm1_g) + (size_t)L * D; const int modoff = isq ? 3 * D : 0, Nw = isq ? QW : IN_W;
        float bacc[3] = {0.f, 0.f, 0.f};
        float4 v[2];
        { const float* src; bf16_t* dst; int N, k0, n0; tile_of(0, src, dst, N, k0, n0);
#pragma unroll
          for (int i = 0; i < 2; ++i) v[i] = *(const float4*)(src + (size_t)(k0 + kk + 32 * i) * N + n0 + nn); }
        for (int q = 0; q < 8; ++q) {
            const float* src; bf16_t* dst; int N, k0, n0; tile_of(q, src, dst, N, k0, n0);
#pragma unroll
            for (int i = 0; i < 2; ++i) { const int k = kk + 32 * i; tile[k * 65 + nn + 0] = v[i].x; tile[k * 65 + nn + 1] = v[i].y; tile[k * 65 + nn + 2] = v[i].z; tile[k * 65 + nn + 3] = v[i].w; }
            __syncthreads();
            if (q + 1 < 8) { const float* s2; bf16_t* d2; int N2, k2, n2; tile_of(q + 1, s2, d2, N2, k2, n2);
#pragma unroll
                for (int i = 0; i < 2; ++i) v[i] = *(const float4*)(s2 + (size_t)(k2 + kk + 32 * i) * N2 + n2 + nn); }
            float tv[8];
#pragma unroll
            for (int i = 0; i < 8; ++i) tv[i] = tile[(kc + i) * 65 + n];
            if (win) {
                const float4 g0 = *(const float4*)(gvec + k0 + kc), g1 = *(const float4*)(gvec + k0 + kc + 4);
#pragma unroll
                for (int m = 0; m < 3; ++m) { const float* mr = (const float*)(ws + WS_MOD) + (size_t)(L * 3 + m) * MODW + modoff + k0 + kc;
                    const float4 h0 = *(const float4*)mr, h1 = *(const float4*)(mr + 4), c0 = *(const float4*)(mr + D), c1 = *(const float4*)(mr + D + 4);
                    uint4 w;
                    w.x = pk_bf16(tv[0] * (g0.x * (1.0f + c0.x)), tv[1] * (g0.y * (1.0f + c0.y))); w.y = pk_bf16(tv[2] * (g0.z * (1.0f + c0.z)), tv[3] * (g0.w * (1.0f + c0.w)));
                    w.z = pk_bf16(tv[4] * (g1.x * (1.0f + c1.x)), tv[5] * (g1.y * (1.0f + c1.y))); w.w = pk_bf16(tv[6] * (g1.z * (1.0f + c1.z)), tv[7] * (g1.w * (1.0f + c1.w)));
                    *(uint4*)(dst + ((size_t)m * Nw + n0 + n) * D + k0 + kc) = w;
                    bacc[m] += ((tv[0] * h0.x + tv[1] * h0.y) + (tv[2] * h0.z + tv[3] * h0.w)) + ((tv[4] * h1.x + tv[5] * h1.y) + (tv[6] * h1.z + tv[7] * h1.w)); }
            } else {
                uint4 w;
                w.x = pk_bf16(tv[0], tv[1]); w.y = pk_bf16(tv[2], tv[3]); w.z = pk_bf16(tv[4], tv[5]); w.w = pk_bf16(tv[6], tv[7]);
                *(uint4*)(dst + (size_t)(n0 + n) * D + k0 + kc) = w; }
            __syncthreads();
        }
        if (win) {
            const int t0 = t0_ - (isq ? 960 : 0), n0 = (t0 >> 4) * 64, half = (t0 >> 3) & 1; float* bp_ = (float*)(ws + (isq ? WS_BIASP2 : WS_BIASP));
#pragma unroll
            for (int m = 0; m < 3; ++m) { float b = bacc[m]; b += __shfl_xor(b, 1); b += __shfl_xor(b, 2); b += __shfl_xor(b, 4);
                if ((tid & 7) == 0) bp_[((size_t)(L * 3 + m) * 2 + half) * Nw + n0 + n] = b; }
        }
    }
}
__device__ __forceinline__ void deferred_drain(const P& p, int L, LAS unsigned char* lds, int quota) {
    if (L >= DEPTH) return;
    volatile LAS unsigned* st = (volatile LAS unsigned*)(lds + ST_OFF);
    unsigned* ctr = (unsigned*)(p.ws + WS_CTL) + 6144 + 64 * L;
    for (int n = 0; n < quota; ++n) {
        __syncthreads();
        if (threadIdx.x == 0) st[12] = __hip_atomic_fetch_add(ctr, 1u, __ATOMIC_RELAXED, __HIP_MEMORY_SCOPE_AGENT);
        __syncthreads();
        const int c = (int)st[12];
        if (c >= DEF_NCHUNK) break;
        deferred_chunk(p, L, c, lds);
    }
    __syncthreads();
}
__device__ __forceinline__ void phase_adaln(const P& p, LAS unsigned char* lds) {
    LAS float* sl = (LAS float*)lds; LAS float* part = sl + 3072;
    const int tid = otid(), wave = __builtin_amdgcn_readfirstlane(tid >> 6), lane = tid & 63;
    for (int i = tid; i < 3072; i += NTHR) { const int m = i >> 10, j = i & 1023; const float cv = (m < 2) ? p.c[m * 1024 + j] : p.c_ctx[j]; sl[i] = cv / (1.0f + __expf(-cv)); }
    __syncthreads();
    float* MOD = (float*)(p.ws + WS_MOD);
    const int rs = lane < 24 ? 0 : 1, c4 = lane < 24 ? lane : (lane < 48 ? lane - 24 : lane - 48);
    for (int item = blockIdx.x; item < DEPTH * 64; item += gridDim.x) {
        const int l = item >> 6, j0 = (item & 63) * 96;
        const float* W = p.ada_w + (size_t)l * D * MODW + j0 + 4 * c4 + (size_t)(wave * 128 + rs) * MODW;
        LAS const float* s0 = sl + wave * 128 + rs;
        float4 a0 = make_float4(0.f, 0.f, 0.f, 0.f), a1 = a0, a2 = a0;
#pragma unroll 16
        for (int i = 0; i < 64; ++i) { const float4 w = *(const float4*)(W + (size_t)(2 * i) * MODW); const float x0 = s0[2 * i], x1 = s0[1024 + 2 * i], x2 = s0[2048 + 2 * i];
            a0.x = fmaf(x0, w.x, a0.x); a0.y = fmaf(x0, w.y, a0.y); a0.z = fmaf(x0, w.z, a0.z); a0.w = fmaf(x0, w.w, a0.w);
            a1.x = fmaf(x1, w.x, a1.x); a1.y = fmaf(x1, w.y, a1.y); a1.z = fmaf(x1, w.z, a1.z); a1.w = fmaf(x1, w.w, a1.w);
            a2.x = fmaf(x2, w.x, a2.x); a2.y = fmaf(x2, w.y, a2.y); a2.z = fmaf(x2, w.z, a2.z); a2.w = fmaf(x2, w.w, a2.w); }
        if (lane < 48) { LAS float* pp = part + (size_t)((wave * 2 + rs) * 3) * 96 + 4 * c4;
            pp[0] = a0.x; pp[1] = a0.y; pp[2] = a0.z; pp[3] = a0.w; pp[96] = a1.x; pp[97] = a1.y; pp[98] = a1.z; pp[99] = a1.w; pp[192] = a2.x; pp[193] = a2.y; pp[194] = a2.z; pp[195] = a2.w; }
        __syncthreads();
        if (tid < 288) { const int m = tid / 96, c = tid - 96 * m; float sum = 0.f;
#pragma unroll
            for (int g = 0; g < 16; ++g) sum += part[(g * 3 + m) * 96 + c];
            MOD[(size_t)(l * 3 + m) * MODW + j0 + c] = sum + p.ada_b[l * MODW + j0 + c]; }
        __syncthreads();
    }
}
__device__ __forceinline__ void phase_norm(const P& p, int l, int which) {
    const float* g = (which ? p.norm2_g : p.norm1_g) + l * D;
    const float* mod = (const float*)(p.ws + WS_MOD) + (size_t)l * 3 * MODW + (which ? 3 * D : 0);
    const bf16_t* X = (const bf16_t*)(p.ws + WS_XRES); bf16_t* H = (bf16_t*)(p.ws + WS_H);
    const int lane = otid() & 63, gw = blockIdx.x * NWAVE + owave(), nw = gridDim.x * NWAVE;
    const int nrow = (which == 1 && l == DEPTH - 1) ? NLAT : NTOK;
    const bool first = (l == 0 && which == 0);
    for (int r = gw; r < nrow; r += nw) {
        const float* xr = r < NLAT ? p.x + (size_t)r * D : p.ctx + (size_t)(r - NLAT) * D; const bf16_t* xb = X + (size_t)r * D; const float* mr = mod + (size_t)row_sel(r) * MODW;
        float4 v[4]; float ss = 0.f;
#pragma unroll
        for (int i = 0; i < 4; ++i) { if (first) v[i] = *(const float4*)(xr + i * 256 + lane * 4); else { const uint2 w = *(const uint2*)(xb + i * 256 + lane * 4); v[i] = make_float4(bf_lo(w.x), bf_hi(w.x), bf_lo(w.y), bf_hi(w.y)); }
            ss += v[i].x * v[i].x + v[i].y * v[i].y + v[i].z * v[i].z + v[i].w * v[i].w; }
        ss = wave_sum(ss); const float rs = rsqrtf(ss * (1.0f / D) + EPS);
#pragma unroll
        for (int i = 0; i < 4; ++i) { const int col = i * 256 + lane * 4;
            const float4 gv = *(const float4*)(g + col), sh = *(const float4*)(mr + col), sc = *(const float4*)(mr + D + col);
            uint2 w; w.x = pk_bf16(v[i].x * rs * gv.x * (1.0f + sc.x) + sh.x, v[i].y * rs * gv.y * (1.0f + sc.y) + sh.y);
                     w.y = pk_bf16(v[i].z * rs * gv.z * (1.0f + sc.z) + sh.z, v[i].w * rs * gv.w * (1.0f + sc.w) + sh.w);
            *(uint2*)(H + (size_t)r * D + col) = w; }
    }
}
template <int C> __device__ __forceinline__ void fp4x3_pair_f(float x0, float x1, unsigned& a0, unsigned& a1, unsigned& a2) {
    a0 = __builtin_amdgcn_cvt_scalef32_pk_fp4_f32(a0, x0 * 0.5f, x1 * 0.5f, 1.0f, C);
    const auto q0 = __builtin_amdgcn_cvt_scalef32_pk_f32_fp4(a0, 1.0f, C);
    const float r0 = x0 - 2.0f * q0[0], r1 = x1 - 2.0f * q0[1];
    a1 = __builtin_amdgcn_cvt_scalef32_pk_fp4_f32(a1, r0 * 4.0f, r1 * 4.0f, 1.0f, C);
}
__device__ __forceinline__ void phase_norm2(const P& p, int l) {
    const float* g = p.norm2_g + l * D;
    const float* mod = (const float*)(p.ws + WS_MOD) + (size_t)l * 3 * MODW + 3 * D;
    const bf16_t* X = (const bf16_t*)(p.ws + WS_XRES); bf16_t* H = (bf16_t*)(p.ws + WS_H); unsigned char* H4 = p.ws + WS_H4;
    const int lane = otid() & 63, gw = blockIdx.x * NWAVE + owave(), nw = gridDim.x * NWAVE;
    const int nrow = (l == DEPTH - 1) ? NLAT : NTOK;
    for (int r = gw; r < nrow; r += nw) {
        const bf16_t* xr = X + (size_t)r * D + lane * 16; const float* mr = mod + (size_t)row_sel(r) * MODW + lane * 16; const float* gr = g + lane * 16;
        float v[16]; float ss = 0.f;
#pragma unroll
        for (int i = 0; i < 4; ++i) { const uint2 w = ((const uint2*)xr)[i]; const float4 t = make_float4(bf_lo(w.x), bf_hi(w.x), bf_lo(w.y), bf_hi(w.y)); v[4 * i] = t.x; v[4 * i + 1] = t.y; v[4 * i + 2] = t.z; v[4 * i + 3] = t.w; ss += t.x * t.x + t.y * t.y + t.z * t.z + t.w * t.w; }
        ss = wave_sum(ss); const float rs = rsqrtf(ss * (1.0f / D) + EPS);
        unsigned hb[8], a0[2] = {0u, 0u}, a1[2] = {0u, 0u}, a2[2] = {0u, 0u};
#pragma unroll
        for (int i = 0; i < 4; ++i) { const float4 gv = ((const float4*)gr)[i], sh = ((const float4*)mr)[i], sc = ((const float4*)(mr + D))[i];
            v[4 * i] = v[4 * i] * rs * gv.x * (1.0f + sc.x) + sh.x; v[4 * i + 1] = v[4 * i + 1] * rs * gv.y * (1.0f + sc.y) + sh.y;
            v[4 * i + 2] = v[4 * i + 2] * rs * gv.z * (1.0f + sc.z) + sh.z; v[4 * i + 3] = v[4 * i + 3] * rs * gv.w * (1.0f + sc.w) + sh.w; }
#pragma unroll
        for (int i = 0; i < 8; ++i) hb[i] = pk_bf16(v[2 * i], v[2 * i + 1]);
        uint4* hw = (uint4*)(H + (size_t)r * D + lane * 16); hw[0] = make_uint4(hb[0], hb[1], hb[2], hb[3]); hw[1] = make_uint4(hb[4], hb[5], hb[6], hb[7]);
#pragma unroll
        for (int d = 0; d < 2; ++d) {
            fp4x3_pair_f<0>(bf_lo(hb[4 * d]), bf_hi(hb[4 * d]), a0[d], a1[d], a2[d]); fp4x3_pair_f<1>(bf_lo(hb[4 * d + 1]), bf_hi(hb[4 * d + 1]), a0[d], a1[d], a2[d]);
            fp4x3_pair_f<2>(bf_lo(hb[4 * d + 2]), bf_hi(hb[4 * d + 2]), a0[d], a1[d], a2[d]); fp4x3_pair_f<3>(bf_lo(hb[4 * d + 3]), bf_hi(hb[4 * d + 3]), a0[d], a1[d], a2[d]); }
        unsigned char* h4 = H4 + (size_t)r * 1536 + lane * 8;
        *(uint2*)(h4) = make_uint2(a0[0], a0[1]); *(uint2*)(h4 + 512) = make_uint2(a1[0], a1[1]);
    }
}
__device__ __forceinline__ void h4_rows(const P& p, int l, int first, int step, int nrow) {
    const float* g = p.norm2_g + l * D;
    const float* mod = (const float*)(p.ws + WS_MOD) + (size_t)l * 3 * MODW + 3 * D;
    const bf16_t* X = (const bf16_t*)(p.ws + WS_XRES); unsigned char* H4 = p.ws + WS_H4; const float* SS = (const float*)(p.ws + WS_SSP2);
    const int lane = otid() & 63;
    if (first >= nrow) return;
    float gm[16], sh[16]; int cur_sel = -1;
    uint4 xn[2]; float4 sn[4];
    { const uint4* xp = (const uint4*)(X + (size_t)first * D + lane * 16); xn[0] = xp[0]; xn[1] = xp[1]; const float4* sp = (const float4*)(SS + (size_t)first * 16); sn[0] = sp[0]; sn[1] = sp[1]; sn[2] = sp[2]; sn[3] = sp[3]; }
    for (int r = first; r < nrow; r += step) {
        const uint4 x0 = xn[0], x1 = xn[1]; const float4 p0 = sn[0], p1 = sn[1], p2 = sn[2], p3 = sn[3];
        { const int r2 = (r + step < nrow) ? r + step : r; const uint4* xp = (const uint4*)(X + (size_t)r2 * D + lane * 16); xn[0] = xp[0]; xn[1] = xp[1];
          const float4* sp = (const float4*)(SS + (size_t)r2 * 16); sn[0] = sp[0]; sn[1] = sp[1]; sn[2] = sp[2]; sn[3] = sp[3]; }
        const int sel = row_sel(r);
        if (sel != cur_sel) {
            cur_sel = sel; const float* mr = mod + (size_t)sel * MODW + lane * 16; const float* gr = g + lane * 16;
#pragma unroll
            for (int i = 0; i < 4; ++i) { const float4 gv = ((const float4*)gr)[i], s4 = ((const float4*)mr)[i], c4 = ((const float4*)(mr + D))[i];
                gm[4 * i] = gv.x * (1.0f + c4.x); gm[4 * i + 1] = gv.y * (1.0f + c4.y); gm[4 * i + 2] = gv.z * (1.0f + c4.z); gm[4 * i + 3] = gv.w * (1.0f + c4.w);
                sh[4 * i] = s4.x; sh[4 * i + 1] = s4.y; sh[4 * i + 2] = s4.z; sh[4 * i + 3] = s4.w; }
        }
        const float sq = (((p0.x + p0.y) + (p0.z + p0.w)) + ((p1.x + p1.y) + (p1.z + p1.w))) + (((p2.x + p2.y) + (p2.z + p2.w)) + ((p3.x + p3.y) + (p3.z + p3.w)));
        const float rs = __builtin_amdgcn_rsqf(sq * (1.0f / 1024.0f) + 1e-6f);
        float v[16]; { float a[8], b[8]; unpack8(x0, a); unpack8(x1, b);
#pragma unroll
            for (int j = 0; j < 8; ++j) { v[j] = a[j]; v[8 + j] = b[j]; } }
#pragma unroll
        for (int i = 0; i < 16; ++i) v[i] = fmaf(v[i] * rs, gm[i], sh[i]);
        unsigned hb[8], a0[2] = {0u, 0u}, a1[2] = {0u, 0u}, a2[2] = {0u, 0u};
#pragma unroll
        for (int i = 0; i < 8; ++i) hb[i] = pk_bf16(v[2 * i], v[2 * i + 1]);
#pragma unroll
        for (int d = 0; d < 2; ++d) {
            fp4x3_pair_f<0>(bf_lo(hb[4 * d]), bf_hi(hb[4 * d]), a0[d], a1[d], a2[d]); fp4x3_pair_f<1>(bf_lo(hb[4 * d + 1]), bf_hi(hb[4 * d + 1]), a0[d], a1[d], a2[d]);
            fp4x3_pair_f<2>(bf_lo(hb[4 * d + 2]), bf_hi(hb[4 * d + 2]), a0[d], a1[d], a2[d]); fp4x3_pair_f<3>(bf_lo(hb[4 * d + 3]), bf_hi(hb[4 * d + 3]), a0[d], a1[d], a2[d]); }
        unsigned char* h4 = H4 + (size_t)r * 1536 + lane * 8;
        *(uint2*)(h4) = make_uint2(a0[0], a0[1]); *(uint2*)(h4 + 512) = make_uint2(a1[0], a1[1]);
    }
}
__device__ __forceinline__ void phase_conv(const P& p, int l) {
    const bf16_t* PR = (const bf16_t*)(p.ws + WS_PROJ); bf16_t* Y = (bf16_t*)(p.ws + WS_YCAT);
    const int lane = otid() & 63, gw = blockIdx.x * NWAVE + owave(), nw = gridDim.x * NWAVE, ch = lane * 4;
    const float4 cw0 = *(const float4*)(p.conv_w + (size_t)(l * 3 + 0) * 256 + ch), cw1 = *(const float4*)(p.conv_w + (size_t)(l * 3 + 1) * 256 + ch), cw2 = *(const float4*)(p.conv_w + (size_t)(l * 3 + 2) * 256 + ch);
    const float4 og = *(const float4*)(p.out_norm_g + (size_t)l * D + ch);
    const int nblk = ((l == DEPTH - 1) ? NLAT : NTOK) / 4;
    for (int bk = gw; bk < nblk; bk += nw) {
        const int r0 = 4 * bk;
        int pos, len; if (r0 < NLAT) { pos = r0 & (T - 1); len = T; } else { pos = (r0 - NLAT) & (CTXL - 1); len = CTXL; }
        const bf16_t* pr = PR + (size_t)r0 * IN_W + ch;
        uint2 gb[4], gc[6], xi[6];
#pragma unroll
        for (int q = 0; q < 4; ++q) gb[q] = *(const uint2*)(pr + (size_t)q * IN_W + C_GB);
#pragma unroll
        for (int q = 0; q < 6; ++q) { const bool ok = (q == 0) ? (pos > 0) : ((q == 5) ? (pos + 4 < len) : true); const bf16_t* pq = pr + (ptrdiff_t)((ok ? q : 1) - 1) * IN_W;
            gc[q] = *(const uint2*)(pq + C_GC); xi[q] = *(const uint2*)(pq + C_XI);
            if (!ok) { gc[q] = make_uint2(0u, 0u); xi[q] = make_uint2(0u, 0u); } }
#pragma unroll
        for (int q = 0; q < 4; ++q) {
            const uint2 gcm = gc[q], xim = xi[q], gcc = gc[q + 1], xic = xi[q + 1], gcp = gc[q + 2], xip = xi[q + 2], gbq = gb[q];
            float y[4];
            y[0] = bf_lo(gbq.x) * (bf_lo(gcm.x) * bf_lo(xim.x) * cw0.x + bf_lo(gcc.x) * bf_lo(xic.x) * cw1.x + bf_lo(gcp.x) * bf_lo(xip.x) * cw2.x);
            y[1] = bf_hi(gbq.x) * (bf_hi(gcm.x) * bf_hi(xim.x) * cw0.y + bf_hi(gcc.x) * bf_hi(xic.x) * cw1.y + bf_hi(gcp.x) * bf_hi(xip.x) * cw2.y);
            y[2] = bf_lo(gbq.y) * (bf_lo(gcm.y) * bf_lo(xim.y) * cw0.z + bf_lo(gcc.y) * bf_lo(xic.y) * cw1.z + bf_lo(gcp.y) * bf_lo(xip.y) * cw2.z);
            y[3] = bf_hi(gbq.y) * (bf_hi(gcm.y) * bf_hi(xim.y) * cw0.w + bf_hi(gcc.y) * bf_hi(xic.y) * cw1.w + bf_hi(gcp.y) * bf_hi(xip.y) * cw2.w);
            float ss = y[0] * y[0] + y[1] * y[1] + y[2] * y[2] + y[3] * y[3];
            ss += __shfl_xor(ss, 1); ss += __shfl_xor(ss, 2); ss += __shfl_xor(ss, 4); ss += __shfl_xor(ss, 8);
            const float rs = rsqrtf(ss * (1.0f / 64.0f) + EPS);
            uint2 w; w.x = pk_bf16(y[0] * rs * og.x, y[1] * rs * og.y); w.y = pk_bf16(y[2] * rs * og.z, y[3] * rs * og.w);
            *(uint2*)(Y + (size_t)(r0 + q) * D + ch) = w;
        }
    }
}
typedef short s16x8_t __attribute__((ext_vector_type(8)));
typedef short s16x4_t __attribute__((ext_vector_type(4)));
typedef float f32x4_t __attribute__((ext_vector_type(4)));
typedef unsigned u32x4_t __attribute__((ext_vector_type(4)));
__device__ __forceinline__ float x4_max(float x) {
    auto s = __builtin_amdgcn_permlane16_swap(__float_as_uint(x), __float_as_uint(x), false, false); x = fmaxf(__uint_as_float(s[0]), __uint_as_float(s[1]));
    auto t = __builtin_amdgcn_permlane32_swap(__float_as_uint(x), __float_as_uint(x), false, false); return fmaxf(__uint_as_float(t[0]), __uint_as_float(t[1])); }
__device__ __forceinline__ float x4_sum(float x) {
    auto s = __builtin_amdgcn_permlane16_swap(__float_as_uint(x), __float_as_uint(x), false, false); x = __uint_as_float(s[0]) + __uint_as_float(s[1]);
    auto t = __builtin_amdgcn_permlane32_swap(__float_as_uint(x), __float_as_uint(x), false, false); return __uint_as_float(t[0]) + __uint_as_float(t[1]); }
template <int OFF> __device__ __forceinline__ s16x4_t tr_read(unsigned vb) { s16x4_t r; asm volatile("ds_read_b64_tr_b16 %0, %1 offset:%2" : "=&v"(r) : "v"(vb), "i"(OFF) : "memory"); return r; }
constexpr int NA_VSTRIDE = 144;
constexpr int NA_NSLOT = 9;
constexpr int NA_CTX_ROW = NA_NSLOT * 64;
constexpr int NA_CK_OFF = (NA_CTX_ROW + 256) * NA_VSTRIDE;
constexpr int NA_RPB_OFF = NA_CK_OFF + 256 * 128;
static_assert(NA_RPB_OFF + 465 * 4 + 64 <= ST_OFF, "attention LDS image overlaps the control words");
__device__ __forceinline__ void phase_na(const P& p, int l, LAS unsigned char* lds) {
    const bf16_t* PR = (const bf16_t*)(p.ws + WS_PROJ); bf16_t* Y = (bf16_t*)(p.ws + WS_YCAT);
    const int tid = otid(), wave = __builtin_amdgcn_readfirstlane(tid >> 6), lane = tid & 63, g = lane >> 4, lq = lane & 15;
    LAS float* rpbl = (LAS float*)(lds + NA_RPB_OFF);
    const unsigned vbase = (unsigned)(uintptr_t)lds;
    const int G = (int)gridDim.x, per = (2048 + G - 1) / G, nctx_it = (l == DEPTH - 1) ? 0 : (32 + G - 1) / G;
    const int qt = wave & 3, rsel = wave >> 2;
    f32x4_t mk[2];
    { const int gc_ = qt * 16 + lq, cs_ = min(max(gc_ - 8, 0), 48), cw_ = min(max(qt * 16 - 8, 0), 32);
#pragma unroll
      for (int pq = 0; pq < 2; ++pq)
#pragma unroll
          for (int r = 0; r < 4; ++r) { const int col = cw_ + 16 * pq + 4 * g + r; mk[pq][r] = ((col >= cs_) && (col < cs_ + 16)) ? 0.f : -3.0e38f; } }
    int cur_b = -1, cur_h = -1, lo_row = 0, hi_row = 0;
    for (int it = 0; it < per + nctx_it; ++it) {
        bool isctx, valid; int b, h, gr0 = 0, hb = 0;
        if (it < per) { const int ul = (int)blockIdx.x * per + it; valid = ul < 2048; isctx = false; b = ul >> 10; h = (ul >> 7) & 7; gr0 = (ul & 127) * 2; }
        else { const int uc = (G - 1 - (int)blockIdx.x) + (it - per) * G;        valid = uc < 32; isctx = true; b = uc >> 4; h = (uc >> 1) & 7; hb = uc & 1; }
        if (!valid) continue;
        const int tokb = b * T, tokc = NLAT + b * CTXL;
        const int need_lo = min(max(gr0 - 4, 0), 248), need_hi = min(max(gr0 + 1 - 4, 0), 248) + 8;
        if (b != cur_b || h != cur_h) {
#pragma unroll
            for (int c = tid; c < 256 * 8; c += NTHR) { const int R = c >> 3, ch = c & 7;
                const u32x4_t v = *(const u32x4_t*)(PR + (size_t)(tokc + R) * IN_W + C_V + h * 64 + ch * 8), k = *(const u32x4_t*)(PR + (size_t)(tokc + R) * IN_W + C_K + h * 64 + ch * 8);
                *(LAS u32x4_t*)(lds + (NA_CTX_ROW + R) * NA_VSTRIDE + ch * 16) = v; *(LAS u32x4_t*)(lds + NA_CK_OFF + R * 128 + 16 * (ch ^ ((R >> 1) & 7))) = k; }
            if (tid < 465) rpbl[tid] = p.na_rpb[(size_t)(l * 8 + h) * 465 + tid] * 1.44269504f;
            cur_b = b; cur_h = h; lo_row = 0; hi_row = 0;
        }
        if (!isctx) {
            for (int R = need_lo; R < need_hi; ++R)
                if (R < lo_row || R >= hi_row) { const u32x4_t v = *(const u32x4_t*)(PR + (size_t)(tokb + R * 64 + (tid >> 3)) * IN_W + C_V + h * 64 + (tid & 7) * 8);
                    *(LAS u32x4_t*)(lds + ((R % NA_NSLOT) * 64 + (tid >> 3)) * NA_VSTRIDE + (tid & 7) * 16) = v; }
            lo_row = need_lo; hi_row = need_hi;
        }
        asm volatile("s_waitcnt lgkmcnt(0)" ::: "memory"); __builtin_amdgcn_s_barrier(); asm volatile("" ::: "memory");
        int nx_lo = 0, nx_n = 0; u32x4_t vn0 = (u32x4_t){0u, 0u, 0u, 0u}, vn1 = vn0;
        if (!isctx && it + 1 < per) { const int ul1 = (int)blockIdx.x * per + it + 1;
            if (ul1 < 2048 && (ul1 >> 7) == (((int)blockIdx.x * per + it) >> 7)) { const int g1 = (ul1 & 127) * 2; const int nhi = min(max(g1 + 1 - 4, 0), 248) + 8;
                nx_lo = hi_row; nx_n = nhi - hi_row;
                if (nx_n > 0) vn0 = *(const u32x4_t*)(PR + (size_t)(tokb + nx_lo * 64 + (tid >> 3)) * IN_W + C_V + h * 64 + (tid & 7) * 8);
                if (nx_n > 1) vn1 = *(const u32x4_t*)(PR + (size_t)(tokb + (nx_lo + 1) * 64 + (tid >> 3)) * IN_W + C_V + h * 64 + (tid & 7) * 8); } }
        const int gr = gr0 + rsel, rs_ = min(max(gr - 4, 0), 248);
        const int tq = isctx ? (tokc + hb * 128 + wave * 16 + lq) : (tokb + gr * 64 + qt * 16 + lq);
        const int cw0 = min(max(qt * 16 - 8, 0), 32);
        const int tokl = tokb + rs_ * 64;
        const int qq = lq >> 2, pp4 = lq & 3;
        f32x4_t O[4]; float mrow = -3.0e38f, lrow = 0.f;
#pragma unroll
        for (int c = 0; c < 4; ++c) O[c] = (f32x4_t){0.f, 0.f, 0.f, 0.f};
        const bf16_t* qp = PR + (size_t)tq * IN_W + C_Q + h * 64 + g * 8;
        const s16x8_t qf0 = *(const s16x8_t*)qp, qf1 = *(const s16x8_t*)(qp + 32);
        s16x8_t kfa[8], kfb[8];
#pragma unroll
        for (int k8 = 0; k8 < 8; ++k8) asm volatile("" : "=v"(kfa[k8]), "=v"(kfb[k8]));
        if (!isctx) {
#pragma unroll
            for (int k8 = 0; k8 < 8; ++k8) { const int tk = tokl + (k8 >> 1) * 64 + cw0 + 16 * (k8 & 1) + lq; const bf16_t* kp = PR + (size_t)tk * IN_W + C_K + h * 64 + g * 8;
                kfa[k8] = *(const s16x8_t*)kp; kfb[k8] = *(const s16x8_t*)(kp + 32); } }
        __builtin_amdgcn_sched_barrier(0);
#define NA_TRRD(BUF, KB_) do { const int kb = (KB_); const int R0 = (ROW0_OF_KB_EXPR); \
                const unsigned a0 = vbase + (unsigned)((R0 + qq) * NA_VSTRIDE + pp4 * 8), a1 = a0 + 16 * NA_VSTRIDE; \
                vl[BUF][0] = tr_read<0>(a0); vl[BUF][1] = tr_read<32>(a0); vl[BUF][2] = tr_read<64>(a0); vl[BUF][3] = tr_read<96>(a0); \
                vh[BUF][0] = tr_read<0>(a1); vh[BUF][1] = tr_read<32>(a1); vh[BUF][2] = tr_read<64>(a1); vh[BUF][3] = tr_read<96>(a1); } while (0)
#define NA_MERGE_PV() do { \
            mx = x4_max(mx); \
            const float mnew = fmaxf(mrow, mx), resc = __builtin_amdgcn_exp2f(mrow - mnew); f32x4_t lsv = (f32x4_t){0.f, 0.f, 0.f, 0.f}; \
            f32x2_t nm2 = (f32x2_t){-mnew, -mnew}; asm volatile("" : "+v"(nm2)); const f32x4_t nm4 = (f32x4_t){nm2[0], nm2[1], nm2[0], nm2[1]}; \
            _Pragma("unroll") for (int kt = 0; kt < 16; ++kt) { f32x4_t d = sc[kt] + nm4; d[0] = __builtin_amdgcn_exp2f(d[0]); d[1] = __builtin_amdgcn_exp2f(d[1]); d[2] = __builtin_amdgcn_exp2f(d[2]); d[3] = __builtin_amdgcn_exp2f(d[3]); sc[kt] = d; lsv += d; } \
            float ls = (lsv[0] + lsv[1]) + (lsv[2] + lsv[3]); \
            ls = x4_sum(ls); lrow = lrow * resc + ls; mrow = mnew; \
            _Pragma("unroll") for (int c = 0; c < 4; ++c) O[c] = O[c] * resc; \
            s16x4_t vl[2][4], vh[2][4]; \
            NA_TRRD(0, 0); \
            _Pragma("unroll") for (int kb_ = 0; kb_ < 8; ++kb_) { \
                asm volatile("s_waitcnt lgkmcnt(0)" ::: "memory"); __builtin_amdgcn_sched_barrier(0); \
                if (kb_ < 7) NA_TRRD((kb_ + 1) & 1, kb_ + 1);                \
                s16x8_t pf; \
                { const unsigned u0 = pk_bf16(sc[2 * kb_][0], sc[2 * kb_][1]), u1 = pk_bf16(sc[2 * kb_][2], sc[2 * kb_][3]), u2 = pk_bf16(sc[2 * kb_ + 1][0], sc[2 * kb_ + 1][1]), u3 = pk_bf16(sc[2 * kb_ + 1][2], sc[2 * kb_ + 1][3]); \
                  pf = __builtin_bit_cast(s16x8_t, make_uint4(u0, u1, u2, u3)); } \
                O[0] = __builtin_amdgcn_mfma_f32_16x16x32_bf16(NA_PK(vl[kb_ & 1][0], vh[kb_ & 1][0]), pf, O[0], 0, 0, 0); \
                O[1] = __builtin_amdgcn_mfma_f32_16x16x32_bf16(NA_PK(vl[kb_ & 1][1], vh[kb_ & 1][1]), pf, O[1], 0, 0, 0); \
                O[2] = __builtin_amdgcn_mfma_f32_16x16x32_bf16(NA_PK(vl[kb_ & 1][2], vh[kb_ & 1][2]), pf, O[2], 0, 0, 0); \
                O[3] = __builtin_amdgcn_mfma_f32_16x16x32_bf16(NA_PK(vl[kb_ & 1][3], vh[kb_ & 1][3]), pf, O[3], 0, 0, 0); \
                __builtin_amdgcn_sched_barrier(0); } } while (0)
#define NA_PK(L, H) (s16x8_t){L[0], L[1], L[2], L[3], H[0], H[1], H[2], H[3]}
        {
            f32x4_t sc[16];
            const unsigned sw = (unsigned)((lq >> 1) & 7);
            const LAS unsigned char* ka = lds + NA_CK_OFF + lq * 128 + 16 * ((unsigned)g ^ sw); const LAS unsigned char* kb2 = lds + NA_CK_OFF + lq * 128 + 16 * ((unsigned)(4 + g) ^ sw);
#pragma unroll
            for (int q4 = 0; q4 < 4; ++q4) {
                s16x8_t c0[4], c1[4];
#pragma unroll
                for (int k4 = 0; k4 < 4; ++k4) { const int kt = q4 * 4 + k4; c0[k4] = *(const LAS s16x8_t*)(ka + 2048 * kt); c1[k4] = *(const LAS s16x8_t*)(kb2 + 2048 * kt); }
#pragma unroll
                for (int k4 = 0; k4 < 4; ++k4) { f32x4_t acc = (f32x4_t){0.f, 0.f, 0.f, 0.f};
                    acc = __builtin_amdgcn_mfma_f32_16x16x32_bf16(c0[k4], qf0, acc, 0, 0, 0);
                    acc = __builtin_amdgcn_mfma_f32_16x16x32_bf16(c1[k4], qf1, acc, 0, 0, 0);
                    sc[q4 * 4 + k4] = acc; }
            }
            float mx = -3.0e38f;
#pragma unroll
            for (int kt = 0; kt < 16; ++kt)
#pragma unroll
                for (int r = 0; r < 4; ++r) mx = fmaxf(mx, sc[kt][r]);
            mx *= 0.125f * 1.44269504f;
#pragma unroll
            for (int kt = 0; kt < 16; ++kt) sc[kt] = sc[kt] * (0.125f * 1.44269504f);
#define ROW0_OF_KB_EXPR (NA_CTX_ROW + 32 * kb + 4 * g)
            NA_MERGE_PV();
#undef ROW0_OF_KB_EXPR
        }
        if (!isctx) {
            f32x4_t sc[16];
#pragma unroll
            for (int k8 = 0; k8 < 8; ++k8) { f32x4_t acc = (f32x4_t){0.f, 0.f, 0.f, 0.f};
                acc = __builtin_amdgcn_mfma_f32_16x16x32_bf16(kfa[k8], qf0, acc, 0, 0, 0);
                acc = __builtin_amdgcn_mfma_f32_16x16x32_bf16(kfb[k8], qf1, acc, 0, 0, 0);
                sc[k8] = acc; }
            __builtin_amdgcn_sched_barrier(0);
#pragma unroll
            for (int k8 = 0; k8 < 8; ++k8) { const int kt = 8 + k8;
                const int tk = tokl + (kt >> 1) * 64 + cw0 + 16 * (kt & 1) + lq; const bf16_t* kp = PR + (size_t)tk * IN_W + C_K + h * 64 + g * 8;
                kfa[k8] = *(const s16x8_t*)kp; kfb[k8] = *(const s16x8_t*)(kp + 32); }
            __builtin_amdgcn_sched_barrier(0);
#pragma unroll
            for (int k8 = 0; k8 < 8; ++k8) { f32x4_t acc = (f32x4_t){0.f, 0.f, 0.f, 0.f};
                acc = __builtin_amdgcn_mfma_f32_16x16x32_bf16(kfa[k8], qf0, acc, 0, 0, 0);
                acc = __builtin_amdgcn_mfma_f32_16x16x32_bf16(kfb[k8], qf1, acc, 0, 0, 0);
                sc[8 + k8] = acc; }
            __builtin_amdgcn_sched_barrier(0);
            float mx = -3.0e38f;
            const int gc = qt * 16 + lq;
            const LAS float* rb_ = rpbl + ((rs_ - gr + 7) * 31 + (cw0 + 4 * g - gc + 15));
#pragma unroll
            for (int kq = 0; kq < 4; ++kq) {
                float bq[16];
#pragma unroll
                for (int e = 0; e < 16; ++e) { const int kt = 4 * kq + (e >> 2), r = e & 3; bq[e] = rb_[31 * (kt >> 1) + 16 * (kt & 1) + r]; }
                asm volatile("" : "+v"(bq[0]), "+v"(bq[1]), "+v"(bq[2]), "+v"(bq[3]), "+v"(bq[4]), "+v"(bq[5]), "+v"(bq[6]), "+v"(bq[7]),
                                  "+v"(bq[8]), "+v"(bq[9]), "+v"(bq[10]), "+v"(bq[11]), "+v"(bq[12]), "+v"(bq[13]), "+v"(bq[14]), "+v"(bq[15]));
#pragma unroll
                for (int e4 = 0; e4 < 4; ++e4) { const int kt = 4 * kq + e4;
                    const f32x4_t b4 = (f32x4_t){bq[4 * e4], bq[4 * e4 + 1], bq[4 * e4 + 2], bq[4 * e4 + 3]} + mk[kt & 1];
                    const f32x4_t sv = sc[kt] * (0.125f * 1.44269504f) + b4; sc[kt] = sv;
                    mx = fmaxf(fmaxf(mx, sv[0]), sv[1]); mx = fmaxf(fmaxf(mx, sv[2]), sv[3]); }
            }
#define ROW0_OF_KB_EXPR (((rs_ + kb) % NA_NSLOT) * 64 + cw0 + 4 * g)
            NA_MERGE_PV();
#undef ROW0_OF_KB_EXPR
        }
#undef NA_PK
#undef NA_MERGE_PV
#undef NA_TRRD
        { const float inv = 1.0f / lrow; float ss = 0.f;
#pragma unroll
          for (int c = 0; c < 4; ++c) { O[c] = O[c] * inv; ss += O[c][0] * O[c][0] + O[c][1] * O[c][1] + O[c][2] * O[c][2] + O[c][3] * O[c][3]; }
          ss = x4_sum(ss); const float rn = rsqrtf(ss * (1.0f / 64.0f) + EPS);
          const float* og = p.out_norm_g + (size_t)l * D + 512 + h * 64 + 4 * g; bf16_t* yp = Y + (size_t)tq * D + 512 + h * 64 + 4 * g;
#pragma unroll
          for (int c = 0; c < 4; ++c) { const float4 gv = *(const float4*)(og + 16 * c);
              uint2 w; w.x = pk_bf16(O[c][0] * rn * gv.x, O[c][1] * rn * gv.y); w.y = pk_bf16(O[c][2] * rn * gv.z, O[c][3] * rn * gv.w);
              *(uint2*)(yp + 16 * c) = w; } }
        asm volatile("s_waitcnt lgkmcnt(0)" ::: "memory"); __builtin_amdgcn_s_barrier(); asm volatile("" ::: "memory");
        if (nx_n > 0) *(LAS u32x4_t*)(lds + (((nx_lo) % NA_NSLOT) * 64 + (tid >> 3)) * NA_VSTRIDE + (tid & 7) * 16) = vn0;
        if (nx_n > 1) *(LAS u32x4_t*)(lds + (((nx_lo + 1) % NA_NSLOT) * 64 + (tid >> 3)) * NA_VSTRIDE + (tid & 7) * 16) = vn1;
        if (nx_n > 0) hi_row = nx_lo + nx_n;
    }
    __syncthreads();
}
__device__ __forceinline__ void phase_sgu(const P& p, int l, LAS unsigned char* lds) {
    const bf16_t* PR = (const bf16_t*)(p.ws + WS_PROJ); bf16_t* Y = (bf16_t*)(p.ws + WS_YCAT);
    const bf16_t* WB = (const bf16_t*)(p.ws + WS_SGUW) + (size_t)l * 4 * 128 * 128;
    const int tid = otid(), wave = __builtin_amdgcn_readfirstlane(tid >> 6), lane = tid & 63, g = lane >> 4, lq = lane & 15;
    const unsigned vbase = (unsigned)(uintptr_t)lds;
    const int nitem = (((l == DEPTH - 1) ? NLAT : NTOK) / 128) * 4;
    for (int item = blockIdx.x; item < nitem; item += gridDim.x) {
        const int chunk = item >> 2, grp = item & 3, row0 = chunk * 128;
        { const int tok = tid >> 2, cg = (tid & 3) * 16;
          const bf16_t* src = PR + (size_t)(row0 + tok) * IN_W + C_SV + grp * 64 + cg;
          float f[16]; { float a[8], b[8]; unpack8(((const uint4*)src)[0], a); unpack8(((const uint4*)src)[1], b);
#pragma unroll
              for (int j = 0; j < 8; ++j) { f[j] = gelu_tanh(a[j]); f[8 + j] = gelu_tanh(b[j]); } }
          float ss = 0.f;
#pragma unroll
          for (int j = 0; j < 16; ++j) ss += f[j] * f[j];
          ss += __shfl_xor(ss, 1); ss += __shfl_xor(ss, 2);
          const float rs = rsqrtf(ss * (1.0f / 64.0f) + EPS);
          const float* gn = p.sgu_norm_g + (size_t)l * 256 + grp * 64 + cg;
          unsigned o[8];
#pragma unroll
          for (int j = 0; j < 8; ++j) o[j] = pk_bf16(f[2 * j] * rs * gn[2 * j], f[2 * j + 1] * rs * gn[2 * j + 1]);
          LAS u32x4_t* dst = (LAS u32x4_t*)(lds + tok * NA_VSTRIDE + cg * 2);
          dst[0] = (u32x4_t){o[0], o[1], o[2], o[3]}; dst[1] = (u32x4_t){o[4], o[5], o[6], o[7]}; }
        __syncthreads();
        const int tokp = row0 + wave * 16 + lq;
        f32x4_t O[4];
#pragma unroll
        for (int c = 0; c < 4; ++c) O[c] = (f32x4_t){0.f, 0.f, 0.f, 0.f};
        const bf16_t* wp = WB + ((size_t)grp * 128 + wave * 16 + lq) * 128 + g * 8;
        const int qq = lq >> 2, pp4 = lq & 3;
#pragma unroll
        for (int ks = 0; ks < 4; ++ks) {
            const s16x8_t wf = *(const s16x8_t*)(wp + 32 * ks);
            const unsigned a0 = vbase + (unsigned)((32 * ks + 8 * g + qq) * NA_VSTRIDE + pp4 * 8), a1 = a0 + 4 * NA_VSTRIDE;
            const s16x4_t l0 = tr_read<0>(a0), l1 = tr_read<32>(a0), l2 = tr_read<64>(a0), l3 = tr_read<96>(a0);
            const s16x4_t h0 = tr_read<0>(a1), h1 = tr_read<32>(a1), h2 = tr_read<64>(a1), h3 = tr_read<96>(a1);
            asm volatile("s_waitcnt lgkmcnt(0)" ::: "memory"); __builtin_amdgcn_sched_barrier(0);
#define SG_PK(L, H) (s16x8_t){L[0], L[1], L[2], L[3], H[0], H[1], H[2], H[3]}
            O[0] = __builtin_amdgcn_mfma_f32_16x16x32_bf16(SG_PK(l0, h0), wf, O[0], 0, 0, 0);
            O[1] = __builtin_amdgcn_mfma_f32_16x16x32_bf16(SG_PK(l1, h1), wf, O[1], 0, 0, 0);
            O[2] = __builtin_amdgcn_mfma_f32_16x16x32_bf16(SG_PK(l2, h2), wf, O[2], 0, 0, 0);
            O[3] = __builtin_amdgcn_mfma_f32_16x16x32_bf16(SG_PK(l3, h3), wf, O[3], 0, 0, 0);
#undef SG_PK
        }
        const float bias = p.sgu_b[(size_t)(l * 4 + grp) * 128 + wave * 16 + lq];
        const bf16_t* up = PR + (size_t)tokp * IN_W + C_SU + grp * 64 + 4 * g;
        float ss = 0.f;
#pragma unroll
        for (int c = 0; c < 4; ++c) { const uint2 uu = *(const uint2*)(up + 16 * c);
            O[c][0] = gelu_tanh(bf_lo(uu.x)) * (O[c][0] + bias); O[c][1] = gelu_tanh(bf_hi(uu.x)) * (O[c][1] + bias);
            O[c][2] = gelu_tanh(bf_lo(uu.y)) * (O[c][2] + bias); O[c][3] = gelu_tanh(bf_hi(uu.y)) * (O[c][3] + bias);
            ss += O[c][0] * O[c][0] + O[c][1] * O[c][1] + O[c][2] * O[c][2] + O[c][3] * O[c][3]; }
        ss = x4_sum(ss); const float rn = rsqrtf(ss * (1.0f / 64.0f) + EPS);
        const float* og = p.out_norm_g + (size_t)l * D + 256 + grp * 64 + 4 * g; bf16_t* yp = Y + (size_t)tokp * D + 256 + grp * 64 + 4 * g;
#pragma unroll
        for (int c = 0; c < 4; ++c) { const float4 gv = *(const float4*)(og + 16 * c);
            uint2 w; w.x = pk_bf16(O[c][0] * rn * gv.x, O[c][1] * rn * gv.y); w.y = pk_bf16(O[c][2] * rn * gv.z, O[c][3] * rn * gv.w);
            *(uint2*)(yp + 16 * c) = w; }
        __syncthreads();
    }
}
__device__ __forceinline__ float vmaxf(float a, float b) { float r; asm("v_max_f32 %0, %1, %2" : "=v"(r) : "v"(a), "v"(b)); return r; }
__device__ __forceinline__ float vminf(float a, float b) { float r; asm("v_min_f32 %0, %1, %2" : "=v"(r) : "v"(a), "v"(b)); return r; }
__device__ __forceinline__ float vmed3f(float a, float b, float c) { float r; asm("v_med3_f32 %0, %1, %2, %3" : "=v"(r) : "v"(a), "v"(b), "v"(c)); return r; }
template <int A, int B> __device__ __forceinline__ void ce_desc(float (&v)[16]) { const float x = v[A], y = v[B]; v[A] = vmaxf(x, y); v[B] = vminf(x, y); }
__device__ __forceinline__ void sort16_desc(float (&v)[16]) {
    ce_desc<0, 13>(v); ce_desc<1, 12>(v); ce_desc<2, 15>(v); ce_desc<3, 14>(v); ce_desc<4, 8>(v); ce_desc<5, 6>(v); ce_desc<7, 11>(v); ce_desc<9, 10>(v);
    ce_desc<0, 5>(v); ce_desc<1, 7>(v); ce_desc<2, 9>(v); ce_desc<3, 4>(v); ce_desc<6, 13>(v); ce_desc<8, 14>(v); ce_desc<10, 15>(v); ce_desc<11, 12>(v);
    ce_desc<0, 1>(v); ce_desc<2, 3>(v); ce_desc<4, 5>(v); ce_desc<6, 8>(v); ce_desc<7, 9>(v); ce_desc<10, 11>(v); ce_desc<12, 13>(v); ce_desc<14, 15>(v);
    ce_desc<0, 2>(v); ce_desc<1, 3>(v); ce_desc<4, 10>(v); ce_desc<5, 11>(v); ce_desc<6, 7>(v); ce_desc<8, 9>(v); ce_desc<12, 14>(v); ce_desc<13, 15>(v);
    ce_desc<1, 2>(v); ce_desc<3, 12>(v); ce_desc<4, 6>(v); ce_desc<5, 7>(v); ce_desc<8, 10>(v); ce_desc<9, 11>(v); ce_desc<13, 14>(v);
    ce_desc<1, 4>(v); ce_desc<2, 6>(v); ce_desc<5, 8>(v); ce_desc<7, 10>(v); ce_desc<9, 13>(v); ce_desc<11, 14>(v);
    ce_desc<2, 4>(v); ce_desc<3, 6>(v); ce_desc<9, 12>(v); ce_desc<11, 13>(v);
    ce_desc<3, 5>(v); ce_desc<6, 8>(v); ce_desc<7, 9>(v); ce_desc<10, 12>(v);
    ce_desc<3, 4>(v); ce_desc<5, 6>(v); ce_desc<7, 8>(v); ce_desc<9, 10>(v); ce_desc<11, 12>(v);
    ce_desc<6, 7>(v); ce_desc<8, 9>(v);
}
template <int J, int I> __device__ __forceinline__ void bm_step(float (&v)[16]) { if constexpr ((I ^ J) > I) ce_desc<I, (I ^ J)>(v); }
template <int J, int... I> __device__ __forceinline__ void bm_layer(float (&v)[16], std::integer_sequence<int, I...>) { (bm_step<J, I>(v), ...); }
__device__ __forceinline__ void bmerge16_desc(float (&v)[16]) {
    using S = std::make_integer_sequence<int, 16>; bm_layer<8>(v, S{}); bm_layer<4>(v, S{}); bm_layer<2>(v, S{}); bm_layer<1>(v, S{}); }
template <int... I> __device__ __forceinline__ void mtop_(float (&A)[16], const float (&B)[16], std::integer_sequence<int, I...>) { ((A[I] = vmaxf(A[I], B[15 - I])), ...); }
__device__ __forceinline__ void merge_top16(float (&A)[16], const float (&B)[16]) {
    mtop_(A, B, std::make_integer_sequence<int, 16>{}); bmerge16_desc(A); }
constexpr int TK_ROW = 272;
__device__ __forceinline__ void phase_topk(const P& p, int l, LAS unsigned char* lds) {
    const bf16_t* Q = (const bf16_t*)(p.ws + WS_Q); const bf16_t* SK = (const bf16_t*)(p.ws + WS_SUBK) + (size_t)l * 8 * 2 * 128 * 128;
    int* PIDX = (int*)(p.ws + WS_PIDX); float* PG = (float*)(p.ws + WS_PG); float* PUS = (float*)(p.ws + WS_YCAT);
    const float* US = (const float*)(p.ws + WS_US) + (size_t)l * 16384; const float* VS = (const float*)(p.ws + WS_VS) + (size_t)l * 16384;
    const int tid = otid(), wave = __builtin_amdgcn_readfirstlane(tid >> 6), lane = tid & 63, g = lane >> 4, lq = lane & 15;
    const int h = (int)blockIdx.x & 7, ngrp = (int)gridDim.x >> 3, grp = (int)blockIdx.x >> 3;
    if (grp < ngrp) {
        const u32x4_t* src = (const u32x4_t*)(SK + (size_t)h * 2 * 128 * 128);
#pragma unroll
        for (int c = tid; c < 256 * 16; c += NTHR) { const int row = c >> 4, ch = c & 15; *(LAS u32x4_t*)(lds + row * TK_ROW + ch * 16) = src[c]; }
    }
    __syncthreads();
    const int wid = wave * ngrp + grp, nwid = ngrp * NWAVE;
    const int h4_nrow = (l == DEPTH - 1) ? NLAT : NTOK;
    if (wave < 4) h4_rows(p, l, (int)blockIdx.x * NWAVE + wave, (int)gridDim.x * NWAVE, h4_nrow);
    s16x8_t qn[2][4];
    { const int t0 = (grp < ngrp && wid < NTOK / 16) ? wid : 0; const bf16_t* qp = Q + (size_t)(t0 * 16 + lq) * QW + h * 256 + g * 8;
#pragma unroll
      for (int pp = 0; pp < 2; ++pp)
#pragma unroll
          for (int ks = 0; ks < 4; ++ks) qn[pp][ks] = *(const s16x8_t*)(qp + pp * 128 + 32 * ks); }
    const int ntile = ((l == DEPTH - 1) ? NLAT : NTOK) / 16;
    for (int tile0 = (grp < ngrp ? wid : NTOK); tile0 < ntile; tile0 += 4 * nwid) {
        float top0[16], top1[16];
#pragma unroll
        for (int i = 0; i < 16; ++i) { top0[i] = 0.f; top1[i] = 0.f; }
        for (int j = 0; j < 4; ++j) {
            const int tile = tile0 + j * nwid;
            if (tile >= ntile) break;
            s16x8_t qc[2][4];
#pragma unroll
            for (int pp = 0; pp < 2; ++pp)
#pragma unroll
                for (int ks = 0; ks < 4; ++ks) qc[pp][ks] = qn[pp][ks];
            { const int tn = (tile + nwid < ntile) ? tile + nwid : tile; const bf16_t* qp = Q + (size_t)(tn * 16 + lq) * QW + h * 256 + g * 8;
#pragma unroll
              for (int pp = 0; pp < 2; ++pp)
#pragma unroll
                  for (int ks = 0; ks < 4; ++ks) qn[pp][ks] = *(const s16x8_t*)(qp + pp * 128 + 32 * ks); }
            float own[2][16];
            s16x8_t fr[2][8];
#define TK_RD(STEP, F) do { _Pragma("unroll") for (int t_ = 0; t_ < 2; ++t_) { const LAS unsigned char* kp_ = lds + (((STEP) >> 2) * 128 + (2 * ((STEP) & 3) + t_) * 16 + lq) * TK_ROW + g * 16; \
                _Pragma("unroll") for (int ks = 0; ks < 4; ++ks) F[t_ * 4 + ks] = *(const LAS s16x8_t*)(kp_ + 64 * ks); } } while (0)
            TK_RD(0, fr[0]);
            __builtin_amdgcn_sched_barrier(0);
#pragma unroll
            for (int pp = 0; pp < 2; ++pp) {
                float sc[32];
#pragma unroll
                for (int s2 = 0; s2 < 4; ++s2) {
                    const int step = pp * 4 + s2;
                    if (step < 7) TK_RD(step + 1, fr[(step + 1) & 1]);
                    __builtin_amdgcn_sched_barrier(0);
                    f32x4_t acc0 = (f32x4_t){0.f, 0.f, 0.f, 0.f}, acc1 = (f32x4_t){0.f, 0.f, 0.f, 0.f};
#pragma unroll
                    for (int ks = 0; ks < 4; ++ks) { acc0 = __builtin_amdgcn_mfma_f32_16x16x32_bf16(fr[step & 1][ks], qc[pp][ks], acc0, 0, 0, 0);
                                                     acc1 = __builtin_amdgcn_mfma_f32_16x16x32_bf16(fr[step & 1][4 + ks], qc[pp][ks], acc1, 0, 0, 0); }
#pragma unroll
                    for (int r = 0; r < 4; ++r) { sc[s2 * 8 + r] = __uint_as_float((__float_as_uint(acc0[r]) & ~127u) | (unsigned)(s2 * 32 + 4 * g + r));
                                                  sc[s2 * 8 + 4 + r] = __uint_as_float((__float_as_uint(acc1[r]) & ~127u) | (unsigned)(s2 * 32 + 16 + 4 * g + r)); }
                    __builtin_amdgcn_sched_barrier(0);
                }
                float A[16], B[16];
#pragma unroll
                for (int i = 0; i < 16; ++i) { A[i] = sc[i]; B[i] = sc[16 + i]; }
                sort16_desc(A); sort16_desc(B);
                merge_top16(A, B);
#pragma unroll
                for (int i = 0; i < 16; ++i) own[pp][i] = A[i];
            }
#undef TK_RD
            float X[16], Y[16];
#pragma unroll
            for (int i = 0; i < 16; ++i) { auto r = __builtin_amdgcn_permlane16_swap(__float_as_uint(own[0][i]), __float_as_uint(own[1][i]), false, false); X[i] = __uint_as_float(r[0]); Y[i] = __uint_as_float(r[1]); }
            merge_top16(X, Y);
#pragma unroll
            for (int i = 0; i < 16; ++i) { auto r = __builtin_amdgcn_permlane32_swap(__float_as_uint(X[i]), __float_as_uint(X[i]), false, false); X[i] = __uint_as_float(r[0]); Y[i] = __uint_as_float(r[1]); }
            merge_top16(X, Y);
            const bool mine = (g == j);
#pragma unroll
            for (int i = 0; i < 16; ++i) { auto r = __builtin_amdgcn_permlane16_swap(__float_as_uint(X[i]), __float_as_uint(X[i]), false, false);
                top0[i] = mine ? __uint_as_float(r[0]) : top0[i]; top1[i] = mine ? __uint_as_float(r[1]) : top1[i]; }
        }
        const int mytile = tile0 + g * nwid, tok = mytile * 16 + lq;
        unsigned ia7[16], jb[16];
#pragma unroll
        for (int i = 0; i < 16; ++i) { ia7[i] = (__float_as_uint(top0[i]) & 127u) << 7; jb[i] = __float_as_uint(top1[i]) & 127u; }
#define CAND(a, b) __uint_as_float((__float_as_uint(top0[a] + top1[b]) & ~16383u) | (ia7[a] | jb[b]))
        float L0[16], L1[16], L2[16], L3[16];
#pragma unroll
        for (int i = 0; i < 16; ++i) L0[i] = CAND(0, i);
#pragma unroll
        for (int i = 0; i < 8; ++i) L1[i] = CAND(1, i);
#pragma unroll
        for (int i = 8; i < 16; ++i) L1[i] = -3.0e38f;
        L2[0] = CAND(2, 0); L2[1] = CAND(2, 1); L2[2] = CAND(2, 2); L2[3] = CAND(2, 3); L2[4] = CAND(2, 4); L2[5] = CAND(3, 0); L2[6] = CAND(3, 1); L2[7] = CAND(3, 2);
        L2[8] = CAND(3, 3); L2[9] = CAND(4, 0); L2[10] = CAND(4, 1); L2[11] = CAND(4, 2); L2[12] = CAND(5, 0); L2[13] = CAND(5, 1); L2[14] = CAND(6, 0); L2[15] = CAND(6, 1);
        {
          float S[9]; const float x71 = CAND(7, 1);
#pragma unroll
          for (int i = 0; i < 9; ++i) S[i] = CAND(7 + i, 0);
          L3[0] = S[0];
#pragma unroll
          for (int i = 1; i < 9; ++i) L3[i] = vmed3f(S[i - 1], S[i], x71);
          L3[9] = vminf(S[8], x71); }
#pragma unroll
        for (int i = 10; i < 16; ++i) L3[i] = -3.0e38f;
#undef CAND
        sort16_desc(L2);
        merge_top16(L0, L1); merge_top16(L2, L3); merge_top16(L0, L2);
        float e[16], sum = 0.f; const float mx = __uint_as_float(__float_as_uint(L0[0]) & ~16383u);
#pragma unroll
        for (int i = 0; i < 16; ++i) { e[i] = __expf(__uint_as_float(__float_as_uint(L0[i]) & ~16383u) - mx); sum += e[i]; }
        const float inv = 1.0f / sum;
        if (mytile < ntile) {
            int* ip = PIDX + (size_t)tok * 128 + h * 16; float* gp = PG + (size_t)tok * 128 + h * 16; float* up = PUS + (size_t)tok * 128 + h * 16;
#pragma unroll
            for (int i = 0; i < 4; ++i) {
                const int ea = (int)(__float_as_uint(L0[4 * i]) & 16383u), eb = (int)(__float_as_uint(L0[4 * i + 1]) & 16383u), ec = (int)(__float_as_uint(L0[4 * i + 2]) & 16383u), ed = (int)(__float_as_uint(L0[4 * i + 3]) & 16383u);
                *(int4*)(ip + 4 * i) = make_int4((int)((pk_bf16(0.f, US[ea]) & 0xffff0000u) | (unsigned)ea), (int)((pk_bf16(0.f, US[eb]) & 0xffff0000u) | (unsigned)eb),
                                                 (int)((pk_bf16(0.f, US[ec]) & 0xffff0000u) | (unsigned)ec), (int)((pk_bf16(0.f, US[ed]) & 0xffff0000u) | (unsigned)ed));
                *(float4*)(gp + 4 * i) = make_float4(e[4 * i] * inv * VS[ea], e[4 * i + 1] * inv * VS[eb], e[4 * i + 2] * inv * VS[ec], e[4 * i + 3] * inv * VS[ed]);
}
        }
    }
    if (wave >= 4) h4_rows(p, l, (int)blockIdx.x * NWAVE + wave, (int)gridDim.x * NWAVE, h4_nrow);
}
template <int CTRL> __device__ __forceinline__ float dppf(float x) { return __builtin_bit_cast(float, __builtin_amdgcn_mov_dpp(__builtin_bit_cast(int, x), CTRL, 0xf, 0xf, true)); }
struct PeerGeom { int slice_lo, nslice, wid, nworkers; };
__device__ __forceinline__ PeerGeom peer_geom(LAS unsigned char* lds, int wave) {
    volatile LAS unsigned* st = (volatile LAS unsigned*)(lds + ST_OFF);
    const unsigned nx = st[1], rank = st[4], dense = st[6], base = st[7], total = st[8];
    PeerGeom g;
    if (nx == 8u && total > 0u && base + rank < total) { g.slice_lo = (int)(dense & 3u); g.nslice = 1; g.wid = (int)(base + rank) * NWAVE + wave; g.nworkers = (int)total * NWAVE; }
    else { g.slice_lo = 0; g.nslice = 4; g.wid = (int)blockIdx.x * NWAVE + wave; g.nworkers = (int)gridDim.x * NWAVE; }
    return g;
}
template <bool VP> struct PeerRaw { int2 e2; float2 g2; uint4 h[4]; };
template <bool VP> __device__ __forceinline__ void peer_load_raw(PeerRaw<VP>& R, int t, int lane, int colbase, const int* PIDX, const float* PG, const float* UP, const bf16_t* H) {
    R.e2 = *(const int2*)(PIDX + (size_t)t * 128 + 2 * lane);
    if (VP) R.g2 = *(const float2*)(PG + (size_t)t * 128 + 2 * lane);
    if (!VP) { const uint4* hp = (const uint4*)(H + (size_t)t * D + colbase); R.h[0] = hp[0]; R.h[1] = hp[1]; R.h[2] = hp[2]; R.h[3] = hp[3]; }
}
template <bool VP> __device__ __forceinline__ void peer_stage(const PeerRaw<VP>& R, LAS float* lw, int lane, int rg, int (&E)[16], float (&W)[16]) {
    *(LAS f32x2_t*)(lw + 2 * lane) = (f32x2_t){__int_as_float(R.e2.x), __int_as_float(R.e2.y)};
    if (VP) *(LAS f32x2_t*)(lw + 128 + 2 * lane) = (f32x2_t){R.g2.x, R.g2.y};
    __builtin_amdgcn_wave_barrier();
#pragma unroll
    for (int i = 0; i < 4; ++i) { const f32x4_t v = *(LAS f32x4_t*)(lw + 16 * rg + 4 * i); E[4 * i] = __float_as_int(v[0]); E[4 * i + 1] = __float_as_int(v[1]); E[4 * i + 2] = __float_as_int(v[2]); E[4 * i + 3] = __float_as_int(v[3]); }
    if (VP) {
#pragma unroll
        for (int i = 0; i < 4; ++i) { const f32x4_t v = *(LAS f32x4_t*)(lw + 128 + 16 * rg + 4 * i); W[4 * i] = v[0]; W[4 * i + 1] = v[1]; W[4 * i + 2] = v[2]; W[4 * i + 3] = v[3]; } }
    __builtin_amdgcn_wave_barrier();
}
__device__ __forceinline__ void unpack32_bf16(const uint4 (&h)[4], float (&f)[32]) {
#pragma unroll
    for (int i = 0; i < 4; ++i) { float a[8]; unpack8(h[i], a);
#pragma unroll
        for (int j = 0; j < 8; ++j) f[8 * i + j] = a[j]; }
}
typedef _Float16 h2_t __attribute__((ext_vector_type(2)));
__device__ __forceinline__ void cvt32_fp4_h2(const u32x4_t w, h2_t (&f)[16]) {
#pragma unroll
    for (int d = 0; d < 4; ++d) {
        f[4 * d + 0] = __builtin_bit_cast(h2_t, __builtin_amdgcn_cvt_scalef32_pk_f16_fp4(w[d], 1.0f, 0)); f[4 * d + 1] = __builtin_bit_cast(h2_t, __builtin_amdgcn_cvt_scalef32_pk_f16_fp4(w[d], 1.0f, 1));
        f[4 * d + 2] = __builtin_bit_cast(h2_t, __builtin_amdgcn_cvt_scalef32_pk_f16_fp4(w[d], 1.0f, 2)); f[4 * d + 3] = __builtin_bit_cast(h2_t, __builtin_amdgcn_cvt_scalef32_pk_f16_fp4(w[d], 1.0f, 3)); }
}
__device__ __forceinline__ void pack32_h2(const float (&f)[32], h2_t (&h)[16]) {
#pragma unroll
    for (int i = 0; i < 16; ++i) h[i] = __builtin_bit_cast(h2_t, __builtin_amdgcn_cvt_pkrtz(f[2 * i], f[2 * i + 1]));
}
constexpr int PEER_STAGE_OFF = 131072 + 1024;
template <bool VP> __device__ __forceinline__ void peer_rows4(const u32x4_t (&r)[4], int i0, const h2_t (&hf)[16], const float (&W)[16], float (&acc)[16], h2_t (&acc2)[16]) {
#pragma unroll
    for (int k = 0; k < 4; ++k) { h2_t f[16]; cvt32_fp4_h2(r[k], f);
        if (VP) { const h2_t wk = __builtin_bit_cast(h2_t, __builtin_amdgcn_cvt_pkrtz(W[i0 + k], W[i0 + k]));
#pragma unroll
            for (int j = 0; j < 16; ++j) acc2[j] = f[j] * wk + acc2[j];
            asm volatile("" : "+v"(acc2[0]), "+v"(acc2[1]), "+v"(acc2[2]), "+v"(acc2[3]), "+v"(acc2[4]), "+v"(acc2[5]), "+v"(acc2[6]), "+v"(acc2[7]), "+v"(acc2[8]), "+v"(acc2[9]), "+v"(acc2[10]), "+v"(acc2[11]), "+v"(acc2[12]), "+v"(acc2[13]), "+v"(acc2[14]), "+v"(acc2[15]));
        } else { h2_t d0 = {0, 0}, d1 = d0, d2 = d0, d3 = d0;
#pragma unroll
            for (int j = 0; j < 4; ++j) { d0 = f[j] * hf[j] + d0; d1 = f[4 + j] * hf[4 + j] + d1; d2 = f[8 + j] * hf[8 + j] + d2; d3 = f[12 + j] * hf[12 + j] + d3; }
            const h2_t dd = (d0 + d1) + (d2 + d3);
            float d = (float)dd.x + (float)dd.y;
            asm volatile("" : "+v"(d)); acc[i0 + k] = d; } }
}
typedef unsigned u32x2_t __attribute__((ext_vector_type(2)));
__device__ __forceinline__ void ld8_nowait(u32x2_t& d, const void* q) { asm volatile("global_load_dwordx2 %0, %1, off" : "=v"(d) : "v"(q) : "memory"); }
__device__ __forceinline__ void ld16_nowait(u32x4_t& d, const void* q) { asm volatile("global_load_dwordx4 %0, %1, off" : "=v"(d) : "v"(q) : "memory"); }
template <bool VP> __device__ __forceinline__ void phase_peer(const P& p, int l, LAS unsigned char* lds) {
    const int tid = otid(), wave = __builtin_amdgcn_readfirstlane(tid >> 6), lane = tid & 63, rg = lane >> 3, pc = lane & 7;
    const bool last = (l == DEPTH - 1); const int ntok = last ? NLAT : NTOK;
    const unsigned char* T4 = p.ws + (VP ? WS_VT : WS_UT) + (size_t)l * 16384 * 512;
    const int* PIDX = (const int*)(p.ws + WS_PIDX); const float* PG = (const float*)(p.ws + (VP ? WS_PG : WS_YCAT)); const bf16_t* H = (const bf16_t*)(p.ws + WS_H);
    float* UP = (float*)(p.ws + WS_PROJ); bf16_t* X = (bf16_t*)(p.ws + WS_XRES); const float* MOD = (const float*)(p.ws + WS_MOD);
    LAS float* lwb = (LAS float*)(lds + PEER_STAGE_OFF + wave * 2048);
    LAS unsigned char* ring = lds + wave * 16384;
    const PeerGeom G = peer_geom(lds, wave);
    const bool b3 = (lane & 8) != 0, b2 = (lane & 4) != 0, b1 = (lane & 2) != 0, b0 = (lane & 1) != 0;
    for (int si = 0; si < G.nslice; ++si) {
        const int s = G.slice_lo + si, colbase = 256 * s + 32 * pc;
        if (G.wid >= ntok) continue;
        const int ntk = (ntok - 1 - G.wid) / G.nworkers + 1;
        const unsigned char* T4c = T4 + 128 * s + 16 * pc;
        PeerRaw<VP> R; int E0[16], En[16]; float W[16], Wn[16]; h2_t hf[16], hfn[16];
#pragma unroll
        for (int i = 0; i < 16; ++i) { W[i] = 0.f; Wn[i] = 0.f; hf[i] = (h2_t){0, 0}; hfn[i] = (h2_t){0, 0}; }
        peer_load_raw<VP>(R, G.wid, lane, colbase, PIDX, PG, UP, H);
        if (!VP) { float t32[32]; unpack32_bf16(R.h, t32); pack32_h2(t32, hf); }
        peer_stage<VP>(R, lwb, lane, rg, E0, W);
#pragma unroll
        for (int i = 0; i < 16; ++i) __builtin_amdgcn_global_load_lds((const unsigned*)(T4c + ((unsigned)E0[i] << 9)), (LAS unsigned*)(ring + i * 1024), 16, 0, 0);
        { const int t1 = G.wid + ((1 < ntk) ? 1 : 0) * G.nworkers; peer_load_raw<VP>(R, t1, lane, colbase, PIDX, PG, UP, H); }
        if (!VP) { float t32[32]; unpack32_bf16(R.h, t32); pack32_h2(t32, hfn); }
        peer_stage<VP>(R, lwb + 256, lane, rg, En, Wn);
        for (int j = 0; j < ntk; ++j) {
            const int t = G.wid + j * G.nworkers;
            const int j2 = (j + 2 < ntk) ? j + 2 : ntk - 1; const int t2 = G.wid + j2 * G.nworkers;
            u32x2_t e2r, g2r = (u32x2_t){0u, 0u}; u32x4_t z4 = (u32x4_t){0u, 0u, 0u, 0u}, hr[4] = {z4, z4, z4, z4}, gvr = z4; u32x2_t xvr = (u32x2_t){0u, 0u};
            ld8_nowait(e2r, PIDX + (size_t)t2 * 128 + 2 * lane);
            if (VP) ld8_nowait(g2r, PG + (size_t)t2 * 128 + 2 * lane);
            else { const bf16_t* hp = H + (size_t)t2 * D + colbase; ld16_nowait(hr[0], hp); ld16_nowait(hr[1], hp + 8); ld16_nowait(hr[2], hp + 16); ld16_nowait(hr[3], hp + 24); }
            if (VP) { const int col = colbase + 4 * rg; ld8_nowait(xvr, X + (size_t)t * D + col); ld16_nowait(gvr, MOD + (size_t)(l * 3 + row_sel(t)) * MODW + 5 * D + col); }
            else { u32x2_t g8; ld8_nowait(g8, PG + (size_t)t * 128 + 2 * lane); gvr[0] = g8[0]; gvr[1] = g8[1]; }
            float acc[16]; h2_t acc2[16];
#pragma unroll
            for (int i = 0; i < 16; ++i) { acc[i] = 0.f; acc2[i] = (h2_t){0, 0}; }
#pragma unroll
            for (int g4 = 0; g4 < 4; ++g4) {
                __builtin_amdgcn_sched_barrier(0);
                asm volatile("s_waitcnt vmcnt(12)" ::: "memory");
                u32x4_t r[4];
#pragma unroll
                for (int k = 0; k < 4; ++k) r[k] = *(LAS u32x4_t*)(ring + (4 * g4 + k) * 1024 + lane * 16);
                asm volatile("s_waitcnt lgkmcnt(0)" ::: "memory");
#pragma unroll
                for (int k = 0; k < 4; ++k) __builtin_amdgcn_global_load_lds((const unsigned*)(T4c + ((unsigned)En[4 * g4 + k] << 9)), (LAS unsigned*)(ring + (4 * g4 + k) * 1024), 16, 0, 0);
                __builtin_amdgcn_sched_barrier(0);
                peer_rows4<VP>(r, 4 * g4, hf, W, acc, acc2);
            }
            __builtin_amdgcn_sched_barrier(0);
            asm volatile("s_waitcnt vmcnt(16)" : "+v"(e2r), "+v"(g2r), "+v"(xvr), "+v"(gvr), "+v"(hr[0]), "+v"(hr[1]), "+v"(hr[2]), "+v"(hr[3]) :: "memory");
            if (!VP) {
#pragma unroll
                for (int k = 0; k < 8; ++k) { const float tt = b2 ? acc[k + 8] : acc[k], ss = b2 ? acc[k] : acc[k + 8]; acc[k] = tt + dppf<0x141>(ss); }
#pragma unroll
                for (int k = 0; k < 4; ++k) { const float tt = b1 ? acc[k + 4] : acc[k], ss = b1 ? acc[k] : acc[k + 4]; acc[k] = tt + dppf<0x4E>(ss); }
#pragma unroll
                for (int k = 0; k < 2; ++k) { const float tt = b0 ? acc[k + 2] : acc[k], ss = b0 ? acc[k] : acc[k + 2]; acc[k] = tt + dppf<0xB1>(ss); }
                *(float2*)(UP + ((size_t)s * NTOK + t) * 128 + 2 * lane) = make_float2(acc[0] * __uint_as_float(gvr[0]), acc[1] * __uint_as_float(gvr[1]));
            } else {
                float av[32];
#pragma unroll
                for (int k = 0; k < 16; ++k) { av[2 * k] = (float)acc2[k].x; av[2 * k + 1] = (float)acc2[k].y; }
#pragma unroll
                for (int k = 0; k < 16; ++k) { auto r = __builtin_amdgcn_permlane32_swap(__float_as_uint(av[k]), __float_as_uint(av[k + 16]), false, false); av[k] = __uint_as_float(r[0]) + __uint_as_float(r[1]); }
#pragma unroll
                for (int k = 0; k < 8; ++k) { auto r = __builtin_amdgcn_permlane16_swap(__float_as_uint(av[k]), __float_as_uint(av[k + 8]), false, false); av[k] = __uint_as_float(r[0]) + __uint_as_float(r[1]); }
#pragma unroll
                for (int k = 0; k < 4; ++k) { const float tt = b3 ? av[k + 4] : av[k], ss = b3 ? av[k] : av[k + 4]; acc[k] = tt + dppf<0x128>(ss); }
                const int col = colbase + 4 * rg; uint2* xp = (uint2*)(X + (size_t)t * D + col);
                float4 xv = make_float4(bf_lo(xvr[0]), bf_hi(xvr[0]), bf_lo(xvr[1]), bf_hi(xvr[1]));
                xv.x = fmaf(__uint_as_float(gvr[0]), acc[0], xv.x); xv.y = fmaf(__uint_as_float(gvr[1]), acc[1], xv.y); xv.z = fmaf(__uint_as_float(gvr[2]), acc[2], xv.z); xv.w = fmaf(__uint_as_float(gvr[3]), acc[3], xv.w);
                *xp = make_uint2(pk_bf16(xv.x, xv.y), pk_bf16(xv.z, xv.w));
            }
#pragma unroll
            for (int i = 0; i < 16; ++i) W[i] = Wn[i];
            if (!VP) {
#pragma unroll
                for (int i = 0; i < 16; ++i) hf[i] = hfn[i]; }
            R.e2 = make_int2((int)e2r[0], (int)e2r[1]); R.g2 = make_float2(__uint_as_float(g2r[0]), __uint_as_float(g2r[1]));
            if (!VP) { const uint4 hh[4] = {make_uint4(hr[0][0], hr[0][1], hr[0][2], hr[0][3]), make_uint4(hr[1][0], hr[1][1], hr[1][2], hr[1][3]), make_uint4(hr[2][0], hr[2][1], hr[2][2], hr[2][3]), make_uint4(hr[3][0], hr[3][1], hr[3][2], hr[3][3])};
                float t32[32]; unpack32_bf16(hh, t32); pack32_h2(t32, hfn); }
            peer_stage<VP>(R, lwb + 256 * (j & 1), lane, rg, En, Wn);
        }
        asm volatile("s_waitcnt vmcnt(0)" ::: "memory");
    }
}
typedef int i32x8_t __attribute__((ext_vector_type(8)));
template <int C> __device__ __forceinline__ void fp4x3_pair(unsigned w, unsigned& a0, unsigned& a1, unsigned& a2) {
    const float x0 = bf_lo(w), x1 = bf_hi(w);
    a0 = __builtin_amdgcn_cvt_scalef32_pk_fp4_f32(a0, x0 * 0.5f, x1 * 0.5f, 1.0f, C);
    const f32x2_t q0 = __builtin_amdgcn_cvt_scalef32_pk_f32_fp4(a0, 1.0f, C);
    const float r0 = x0 - 2.0f * q0.x, r1 = x1 - 2.0f * q0.y;
    a1 = __builtin_amdgcn_cvt_scalef32_pk_fp4_f32(a1, r0 * 4.0f, r1 * 4.0f, 1.0f, C);
    const f32x2_t q1 = __builtin_amdgcn_cvt_scalef32_pk_f32_fp4(a1, 1.0f, C);
    a2 = __builtin_amdgcn_cvt_scalef32_pk_fp4_f32(a2, (r0 - 0.25f * q1.x) * 32.0f, (r1 - 0.25f * q1.y) * 32.0f, 1.0f, C);
}
__device__ __forceinline__ void h2_to_fp4x3(const u32x4_t (&raw)[4], i32x8_t& t0, i32x8_t& t1, i32x8_t& t2) {
#pragma unroll
    for (int d = 0; d < 4; ++d) { unsigned a0 = 0u, a1 = 0u, a2 = 0u;
        fp4x3_pair<0>(raw[d][0], a0, a1, a2); fp4x3_pair<1>(raw[d][1], a0, a1, a2); fp4x3_pair<2>(raw[d][2], a0, a1, a2); fp4x3_pair<3>(raw[d][3], a0, a1, a2);
        t0[d] = (int)a0; t1[d] = (int)a1; t2[d] = (int)a2; t0[4 + d] = 0; t1[4 + d] = 0; t2[4 + d] = 0; }
}
__device__ __forceinline__ void phase_peer_u(const P& p, int l, LAS unsigned char* lds) {
    const int tid = otid(), wave = __builtin_amdgcn_readfirstlane(tid >> 6), lane = tid & 63, r16 = lane & 15, kq = lane >> 4;
    const bool last = (l == DEPTH - 1); const int ntok = last ? NLAT : NTOK;
    const unsigned char* T4 = p.ws + WS_UT + (size_t)l * 16384 * 512;
    const unsigned char* PIDXb = p.ws + WS_PIDX; const unsigned char* PUSb = p.ws + WS_YCAT; const unsigned char* H4 = p.ws + WS_H4;
    float* UP = (float*)(p.ws + WS_PROJ);
    LAS unsigned char* meta = lds + PEER_STAGE_OFF + wave * 2560;
    LAS unsigned char* ring = lds + wave * 16384;
    const PeerGeom G = peer_geom(lds, wave);
    const int isel = r16 & 3;
    const int dm = lane >> 3, di = lane & 7;
    const int pc0 = (di - (dm >> 1)) & 7, pc1 = (di - (dm >> 1) - 4) & 7;
    const int rm = r16 & 7, rsl = r16 >> 3;
    const int rd0 = (8 * rm + ((kq + (rm >> 1) + 4 * rsl) & 7)) * 16, rd1 = (8 * rm + ((kq + 4 + (rm >> 1) + 4 * rsl) & 7)) * 16;
    for (int si = 0; si < G.nslice; ++si) {
        const int s = G.slice_lo + si;
        if (G.wid >= ntok) continue;
        const int ntk = (ntok - 1 - G.wid) / G.nworkers + 1;
        const unsigned char* T4a = T4 + 128 * s + 16 * pc0; const unsigned char* T4b = T4 + 128 * s + 16 * pc1;
#define PU_META(K, SLOT) do { const int tk_ = G.wid + ((K) < ntk ? (K) : ntk - 1) * G.nworkers; LAS unsigned char* ms_ = meta + (SLOT) * 768; \
            if (lane < 48) __builtin_amdgcn_global_load_lds((const unsigned*)(lane < 32 ? PIDXb + (size_t)tk_ * 512 + 16 * lane : H4 + (size_t)tk_ * 1536 + 128 * s + (lane < 40 ? 16 * (lane - 32) : 512 + 16 * (lane - 40))), (LAS unsigned*)ms_, 16, 0, 0); \
            } while (0)
#define PU_IDS(SLOT, E) do { const LAS unsigned char* ms_ = meta + (SLOT) * 768 + 32 * dm; _Pragma("unroll") for (int q4 = 0; q4 < 4; ++q4) { const u32x4_t ev = *(const LAS u32x4_t*)(ms_ + 256 * (q4 >> 1) + 16 * (q4 & 1)); \
            E[4 * q4] = (int)(ev[0] & 16383u); E[4 * q4 + 1] = (int)(ev[1] & 16383u); E[4 * q4 + 2] = (int)(ev[2] & 16383u); E[4 * q4 + 3] = (int)(ev[3] & 16383u); } } while (0)
#define PU_REGS(SLOT, B0_, B1_, U0_, U1_) do { const LAS unsigned char* ms_ = meta + (SLOT) * 768; \
            B0_[0] = *(const LAS u32x4_t*)(ms_ + 512 + 16 * kq); B0_[1] = *(const LAS u32x4_t*)(ms_ + 512 + 64 + 16 * kq); B1_[0] = *(const LAS u32x4_t*)(ms_ + 640 + 16 * kq); B1_[1] = *(const LAS u32x4_t*)(ms_ + 640 + 64 + 16 * kq); \
            U0_ = *(const LAS u32x4_t*)(ms_ + 32 * (4 * kq + isel)) & 0xffff0000u; U1_ = *(const LAS u32x4_t*)(ms_ + 32 * (4 * kq + isel) + 16) & 0xffff0000u; } while (0)
        int En[16]; u32x4_t Bc0[2], Bc1[2], Uc0, Uc1;
        PU_META(0, 0); PU_META(1, 1); PU_META(2, 2);
        asm volatile("s_waitcnt vmcnt(0)" ::: "memory");
        __builtin_amdgcn_sched_barrier(0);
        PU_IDS(0, En); PU_REGS(0, Bc0, Bc1, Uc0, Uc1);
        int sj = 0;
        asm volatile("s_waitcnt lgkmcnt(0)" : "+v"(Bc0[0]), "+v"(Bc0[1]), "+v"(Bc1[0]), "+v"(Bc1[1]), "+v"(Uc0), "+v"(Uc1) :: "memory");
        __builtin_amdgcn_sched_barrier(0);
#pragma unroll
        for (int gI = 0; gI < 8; ++gI) {
            __builtin_amdgcn_global_load_lds((const unsigned*)(T4a + ((unsigned)En[gI] << 9)), (LAS unsigned*)(ring + (2 * gI) * 1024), 16, 0, 0);
            __builtin_amdgcn_global_load_lds((const unsigned*)(T4b + ((unsigned)En[8 + gI] << 9)), (LAS unsigned*)(ring + (2 * gI + 1) * 1024), 16, 0, 0); }
        __builtin_amdgcn_sched_barrier(0);
        for (int j = 0; j < ntk; ++j) {
            const int t = G.wid + j * G.nworkers;
            const int sj1 = sj == 2 ? 0 : sj + 1;
            PU_META(j + 3, sj);
            __builtin_amdgcn_sched_barrier(0);
            u32x4_t Bn0[2], Bn1[2], Un0, Un1;
            f32x4_t acc[8];
#pragma unroll
            for (int gI = 0; gI < 8; ++gI) acc[gI] = (f32x4_t){0.f, 0.f, 0.f, 0.f};
#pragma unroll
            for (int gI = 0; gI < 8; ++gI) {
                __builtin_amdgcn_sched_barrier(0);
                asm volatile("s_waitcnt vmcnt(15)" ::: "memory");
                __builtin_amdgcn_sched_barrier(0);
                if (gI == 0) { PU_IDS(sj1, En); PU_REGS(sj1, Bn0, Bn1, Un0, Un1); }
                const u32x4_t r0 = *(LAS u32x4_t*)(ring + (2 * gI + rsl) * 1024 + rd0), r1 = *(LAS u32x4_t*)(ring + (2 * gI + rsl) * 1024 + rd1);
                if (gI == 0) asm volatile("s_waitcnt lgkmcnt(0)" : "+v"(Bn0[0]), "+v"(Bn0[1]), "+v"(Bn1[0]), "+v"(Bn1[1]), "+v"(Un0), "+v"(Un1) :: "memory");
                else asm volatile("s_waitcnt lgkmcnt(0)" ::: "memory");
                __builtin_amdgcn_global_load_lds((const unsigned*)(T4a + ((unsigned)En[gI] << 9)), (LAS unsigned*)(ring + (2 * gI) * 1024), 16, 0, 0);
                __builtin_amdgcn_global_load_lds((const unsigned*)(T4b + ((unsigned)En[8 + gI] << 9)), (LAS unsigned*)(ring + (2 * gI + 1) * 1024), 16, 0, 0);
                __builtin_amdgcn_sched_barrier(0);
                const i32x8_t A0 = {(int)r0[0], (int)r0[1], (int)r0[2], (int)r0[3], 0, 0, 0, 0}, A1 = {(int)r1[0], (int)r1[1], (int)r1[2], (int)r1[3], 0, 0, 0, 0};
                const i32x8_t B00 = {(int)Bc0[0][0], (int)Bc0[0][1], (int)Bc0[0][2], (int)Bc0[0][3], 0, 0, 0, 0}, B10 = {(int)Bc1[0][0], (int)Bc1[0][1], (int)Bc1[0][2], (int)Bc1[0][3], 0, 0, 0, 0};
                const i32x8_t B01 = {(int)Bc0[1][0], (int)Bc0[1][1], (int)Bc0[1][2], (int)Bc0[1][3], 0, 0, 0, 0}, B11 = {(int)Bc1[1][0], (int)Bc1[1][1], (int)Bc1[1][2], (int)Bc1[1][3], 0, 0, 0, 0};
                acc[gI] = __builtin_amdgcn_mfma_scale_f32_16x16x128_f8f6f4(A0, B00, acc[gI], 4, 4, 0, 127, 0, 128);
                acc[gI] = __builtin_amdgcn_mfma_scale_f32_16x16x128_f8f6f4(A0, B10, acc[gI], 4, 4, 0, 127, 0, 125);
                acc[gI] = __builtin_amdgcn_mfma_scale_f32_16x16x128_f8f6f4(A1, B01, acc[gI], 4, 4, 0, 127, 0, 128);
                acc[gI] = __builtin_amdgcn_mfma_scale_f32_16x16x128_f8f6f4(A1, B11, acc[gI], 4, 4, 0, 127, 0, 125);
            }
            __builtin_amdgcn_sched_barrier(0);
            { float v[8];
#pragma unroll
              for (int gI = 0; gI < 8; ++gI) v[gI] = isel == 0 ? acc[gI][0] : (isel == 1 ? acc[gI][1] : (isel == 2 ? acc[gI][2] : acc[gI][3]));
              if (r16 < 4) { uint4* up = (uint4*)((bf16_t*)UP + ((size_t)s * NTOK + t) * 128 + 8 * (4 * kq + isel));
                  *up = make_uint4(pk_bf16(v[0] * __uint_as_float(Uc0[0]), v[1] * __uint_as_float(Uc0[1])), pk_bf16(v[2] * __uint_as_float(Uc0[2]), v[3] * __uint_as_float(Uc0[3])),
                                   pk_bf16(v[4] * __uint_as_float(Uc1[0]), v[5] * __uint_as_float(Uc1[1])), pk_bf16(v[6] * __uint_as_float(Uc1[2]), v[7] * __uint_as_float(Uc1[3]))); } }
            Bc0[0] = Bn0[0]; Bc0[1] = Bn0[1]; Bc1[0] = Bn1[0]; Bc1[1] = Bn1[1]; Uc0 = Un0; Uc1 = Un1; sj = sj1;
        }
        asm volatile("s_waitcnt vmcnt(0)" ::: "memory");
#undef PU_META
#undef PU_IDS
#undef PU_REGS
    }
}
__device__ __forceinline__ void phase_peer_w(const P& p, int l) {
    const float* UP = (const float*)(p.ws + WS_PROJ); float* PG = (float*)(p.ws + WS_PG);
    const int ntok = (l == DEPTH - 1) ? NLAT : NTOK;
    const size_t n4 = (size_t)ntok * 32, stride = (size_t)gridDim.x * NTHR;
    for (size_t i = (size_t)blockIdx.x * NTHR + otid(); i < n4; i += stride) {
        float4 a = ((const float4*)UP)[i];
#pragma unroll
        for (int s = 1; s < 4; ++s) { const float4 b = ((const float4*)UP)[(size_t)s * NTOK * 32 + i]; a.x += b.x; a.y += b.y; a.z += b.z; a.w += b.w; }
        float4 g = ((float4*)PG)[i];
        g.x *= gelu_tanh(a.x); g.y *= gelu_tanh(a.y); g.z *= gelu_tanh(a.z); g.w *= gelu_tanh(a.w);
        ((float4*)PG)[i] = g;
    }
}
__device__ __forceinline__ void phase_peer_w4(const P& p, int l) {
    const bf16_t* UP = (const bf16_t*)(p.ws + WS_PROJ); const float* PG = (const float*)(p.ws + WS_PG); unsigned char* PW4 = p.ws + WS_PW4;
    const int ntok = (l == DEPTH - 1) ? NLAT : NTOK;
    const int lane = otid() & 63, gw = blockIdx.x * NWAVE + owave(), nw = gridDim.x * NWAVE;
    const int k0 = 2 * lane, p0 = 16 * (k0 & 7) + (k0 >> 3), p1 = 16 * ((k0 + 1) & 7) + ((k0 + 1) >> 3);
    for (int tb = gw; tb < ntok; tb += 4 * nw) {
        float u0[4][4], u1[4][4], g0[4], g1[4];
#pragma unroll
        for (int q = 0; q < 4; ++q) { const int t = min(tb + q * nw, ntok - 1);
#pragma unroll
            for (int sl = 0; sl < 4; ++sl) { const bf16_t* u = UP + ((size_t)sl * NTOK + t) * 128; u0[q][sl] = bf1(u[p0]); u1[q][sl] = bf1(u[p1]); }
            g0[q] = PG[(size_t)t * 128 + p0]; g1[q] = PG[(size_t)t * 128 + p1]; }
#pragma unroll
        for (int q = 0; q < 4; ++q) { const int t = tb + q * nw;
            const float a0 = (u0[q][0] + u0[q][1]) + (u0[q][2] + u0[q][3]), a1 = (u1[q][0] + u1[q][1]) + (u1[q][2] + u1[q][3]);
            const float w0 = g0[q] * gelu_tanh(a0), w1 = g1[q] * gelu_tanh(a1);
            const float am = fmaxf(wave_max(fmaxf(fabsf(w0), fabsf(w1))), 1e-30f), inv = 6.0f / am;
            const float b0 = w0 * inv, b1 = w1 * inv;
            const unsigned t0 = __builtin_amdgcn_cvt_scalef32_pk_fp4_f32(0u, b0, b1, 1.0f, 0);
            const auto q0 = __builtin_amdgcn_cvt_scalef32_pk_f32_fp4(t0, 1.0f, 0);
            const unsigned t1 = __builtin_amdgcn_cvt_scalef32_pk_fp4_f32(0u, (b0 - q0[0]) * 4.0f, (b1 - q0[1]) * 4.0f, 1.0f, 0);
            if (t < ntok) { PW4[(size_t)t * 144 + lane] = (unsigned char)(t0 & 0xffu); PW4[(size_t)t * 144 + 64 + lane] = (unsigned char)(t1 & 0xffu);
                if (lane == 0) *(float*)(PW4 + (size_t)t * 144 + 128) = am * (1.0f / 6.0f); } }
    }
}
template <int OFF> __device__ __forceinline__ u32x2_t tr4_read(unsigned ad) { u32x2_t r; asm volatile("ds_read_b64_tr_b4 %0, %1 offset:%2" : "=&v"(r) : "v"(ad), "i"(OFF) : "memory"); return r; }
__device__ __forceinline__ void ld4_nowait(unsigned& d, const void* q) { asm volatile("global_load_dword %0, %1, off" : "=v"(d) : "v"(q) : "memory"); }
__device__ __forceinline__ void ld2_nowait(unsigned& d, const void* q) { asm volatile("global_load_ushort %0, %1, off" : "=v"(d) : "v"(q) : "memory"); }
template <int HH, int A2, int Q> __device__ __forceinline__ void pv_read(u32x2_t (&lo)[2][4], u32x2_t (&hi)[2][4], unsigned rb, const unsigned (&po)[2][2]) {
    lo[A2][Q] = tr4_read<8192 * HH + 8 * (Q & 1)>(rb + po[A2][Q >> 1]); hi[A2][Q] = tr4_read<8192 * HH + 2048 + 8 * (Q & 1)>(rb + po[A2][Q >> 1]); }
__device__ __forceinline__ void phase_peer_v(const P& p, int l, LAS unsigned char* lds) {
    const int tid = otid(), wave = __builtin_amdgcn_readfirstlane(tid >> 6), lane = tid & 63, n16 = lane & 15, kg = lane >> 4, dm = lane >> 3, di = lane & 7;
    const bool last = (l == DEPTH - 1); const int ntok = last ? NLAT : NTOK;
    const unsigned char* T4 = p.ws + WS_VT + (size_t)l * 16384 * 512;
    const unsigned char* PIDXb = p.ws + WS_PIDX; const unsigned char* PW4 = p.ws + WS_PW4;
    bf16_t* X = (bf16_t*)(p.ws + WS_XRES); const float* MOD = (const float*)(p.ws + WS_MOD); float* SSP = (float*)(p.ws + WS_SSP) + (size_t)((l + 1) & 3) * 4 * NTOK;
    LAS unsigned char* meta = lds + PEER_STAGE_OFF + wave * 2560;
    LAS unsigned char* ring = lds + wave * 16384;
    const PeerGeom G = peer_geom(lds, wave);
    const int pc0 = (di - (dm >> 1)) & 7, pc1 = (di - (dm >> 1) - 4) & 7;
    const int tm = n16 & 7, trot = (tm >> 1) + 4 * (n16 >> 3), ub = kg >> 1;
    const unsigned rb = (unsigned)(uintptr_t)ring + (unsigned)((4 * (kg & 1) + (n16 >> 3)) * 1024 + 128 * tm);
    unsigned po[2][2];
#pragma unroll
    for (int a = 0; a < 2; ++a)
#pragma unroll
        for (int qh = 0; qh < 2; ++qh) po[a][qh] = (unsigned)(((4 * ub + 2 * a + qh + trot) & 7) * 16);
    const bool rowok = (((n16 >> 1) & 1) == ub);
    const int scA = (n16 & 1) ? 125 : 127;
    const int aoff = 512 + 64 * (n16 & 1) + 16 * (kg & 1);
    for (int si = 0; si < G.nslice; ++si) {
        const int s = G.slice_lo + si;
        if (G.wid >= ntok) continue;
        const int ntk = (ntok - 1 - G.wid) / G.nworkers + 1;
        const unsigned char* T4a = T4 + 128 * s + 16 * pc0; const unsigned char* T4b = T4 + 128 * s + 16 * pc1;
        float gt[3][4];
#pragma unroll
        for (int sel = 0; sel < 3; ++sel)
#pragma unroll
            for (int c4 = 0; c4 < 4; ++c4) gt[sel][c4] = MOD[(size_t)(l * 3 + sel) * MODW + 5 * D + 256 * s + 64 * c4 + lane];
        asm volatile("s_waitcnt vmcnt(0)" : "+v"(gt[0][0]), "+v"(gt[0][1]), "+v"(gt[0][2]), "+v"(gt[0][3]), "+v"(gt[1][0]), "+v"(gt[1][1]), "+v"(gt[1][2]), "+v"(gt[1][3]), "+v"(gt[2][0]), "+v"(gt[2][1]), "+v"(gt[2][2]), "+v"(gt[2][3]) :: "memory");
#define PV_META(K) do { const int tk_ = G.wid + ((K) < ntk ? (K) : ntk - 1) * G.nworkers; LAS unsigned char* ms_ = meta + ((K) & 1) * 1280; \
            if (lane < 41) __builtin_amdgcn_global_load_lds((const unsigned*)(lane < 32 ? PIDXb + (size_t)tk_ * 512 + 16 * lane : PW4 + (size_t)tk_ * 144 + 16 * (lane - 32)), (LAS unsigned*)ms_, 16, 0, 0); \
            if (lane < 32) __builtin_amdgcn_global_load_lds((const unsigned*)((const unsigned char*)(X + (size_t)tk_ * D + 256 * s) + 16 * lane), (LAS unsigned*)(ms_ + 768), 16, 0, 0); } while (0)
#define PV_IDS(K, E) do { const LAS unsigned char* ms_ = meta + ((K) & 1) * 1280 + 64 * dm; _Pragma("unroll") for (int q4 = 0; q4 < 4; ++q4) { const u32x4_t ev = *(const LAS u32x4_t*)(ms_ + 16 * q4); \
            E[4 * q4] = (int)(ev[0] & 16383u); E[4 * q4 + 1] = (int)(ev[1] & 16383u); E[4 * q4 + 2] = (int)(ev[2] & 16383u); E[4 * q4 + 3] = (int)(ev[3] & 16383u); } } while (0)
#define PV_REGS(K, A_, X_, S_) do { const LAS unsigned char* ms_ = meta + ((K) & 1) * 1280; A_[0] = *(const LAS u32x4_t*)(ms_ + aoff); A_[1] = *(const LAS u32x4_t*)(ms_ + aoff + 32); \
            S_ = *(const LAS float*)(ms_ + 640); _Pragma("unroll") for (int c4 = 0; c4 < 4; ++c4) X_[c4] = (unsigned)*(const LAS unsigned short*)(ms_ + 768 + 2 * (64 * c4 + lane)); } while (0)
        int En[16]; u32x4_t Ac[2]; unsigned xc[4]; float sgc;
        PV_META(0); PV_META(1);
        asm volatile("s_waitcnt vmcnt(0)" ::: "memory");
        __builtin_amdgcn_sched_barrier(0);
        PV_IDS(0, En); PV_REGS(0, Ac, xc, sgc);
        asm volatile("s_waitcnt lgkmcnt(0)" : "+v"(Ac[0]), "+v"(Ac[1]), "+v"(xc[0]), "+v"(xc[1]), "+v"(xc[2]), "+v"(xc[3]), "+v"(sgc) :: "memory");
        __builtin_amdgcn_sched_barrier(0);
#pragma unroll
        for (int sl = 0; sl < 16; ++sl) __builtin_amdgcn_global_load_lds((const unsigned*)(((sl & 1) ? T4b : T4a) + ((unsigned)En[sl] << 9)), (LAS unsigned*)(ring + sl * 1024), 16, 0, 0);
        __builtin_amdgcn_sched_barrier(0);
        for (int j = 0; j < ntk; ++j) {
            const int t = G.wid + j * G.nworkers;
            PV_META(j + 2);
            __builtin_amdgcn_sched_barrier(0);
            f32x4_t acc[2] = {(f32x4_t){0.f, 0.f, 0.f, 0.f}, (f32x4_t){0.f, 0.f, 0.f, 0.f}};
            u32x4_t An[2]; unsigned xn[4]; float sgn;
#pragma unroll
            for (int hh = 0; hh < 2; ++hh) {
                __builtin_amdgcn_sched_barrier(0);
                asm volatile("s_waitcnt vmcnt(10)" ::: "memory");
                __builtin_amdgcn_sched_barrier(0);
                if (hh == 0) { PV_IDS(j + 1, En); PV_REGS(j + 1, An, xn, sgn); }
                u32x2_t lo[2][4], hi[2][4];
                if (hh == 0) { pv_read<0, 0, 0>(lo, hi, rb, po); pv_read<0, 1, 0>(lo, hi, rb, po); pv_read<0, 0, 1>(lo, hi, rb, po); pv_read<0, 1, 1>(lo, hi, rb, po);
                               pv_read<0, 0, 2>(lo, hi, rb, po); pv_read<0, 1, 2>(lo, hi, rb, po); pv_read<0, 0, 3>(lo, hi, rb, po); pv_read<0, 1, 3>(lo, hi, rb, po); }
                else         { pv_read<1, 0, 0>(lo, hi, rb, po); pv_read<1, 1, 0>(lo, hi, rb, po); pv_read<1, 0, 1>(lo, hi, rb, po); pv_read<1, 1, 1>(lo, hi, rb, po);
                               pv_read<1, 0, 2>(lo, hi, rb, po); pv_read<1, 1, 2>(lo, hi, rb, po); pv_read<1, 0, 3>(lo, hi, rb, po); pv_read<1, 1, 3>(lo, hi, rb, po); }
                asm volatile("s_waitcnt lgkmcnt(0)" : "+v"(lo[0][0]), "+v"(lo[0][1]), "+v"(lo[0][2]), "+v"(lo[0][3]), "+v"(lo[1][0]), "+v"(lo[1][1]), "+v"(lo[1][2]), "+v"(lo[1][3]),
                                                      "+v"(hi[0][0]), "+v"(hi[0][1]), "+v"(hi[0][2]), "+v"(hi[0][3]), "+v"(hi[1][0]), "+v"(hi[1][1]), "+v"(hi[1][2]), "+v"(hi[1][3]) :: "memory");
                __builtin_amdgcn_sched_barrier(0);
#pragma unroll
                for (int sl = 0; sl < 8; ++sl) __builtin_amdgcn_global_load_lds((const unsigned*)((((8 * hh + sl) & 1) ? T4b : T4a) + ((unsigned)En[8 * hh + sl] << 9)), (LAS unsigned*)(ring + (8 * hh + sl) * 1024), 16, 0, 0);
                __builtin_amdgcn_sched_barrier(0);
#pragma unroll
                for (int q = 0; q < 4; ++q) {
                    const bool ok = rowok && ((n16 >> 2) == q);
                    const i32x8_t Aq = {ok ? (int)Ac[hh][0] : 0, ok ? (int)Ac[hh][1] : 0, ok ? (int)Ac[hh][2] : 0, ok ? (int)Ac[hh][3] : 0, 0, 0, 0, 0};
#pragma unroll
                    for (int a = 0; a < 2; ++a) {
                        const i32x8_t B = {(int)lo[a][q][0], (int)lo[a][q][1], (int)hi[a][q][0], (int)hi[a][q][1], 0, 0, 0, 0};
                        acc[a] = __builtin_amdgcn_mfma_scale_f32_16x16x128_f8f6f4(Aq, B, acc[a], 4, 4, 0, scA, 0, 127); }
                }
            }
            __builtin_amdgcn_sched_barrier(0);
            { const int sel = row_sel(t); float ssq = 0.f;
#pragma unroll
              for (int c4 = 0; c4 < 4; ++c4) { const int a = c4 & 1, u = c4 >> 1; const float r = acc[a][2 * u] + acc[a][2 * u + 1];
                  const float gate = sel == 0 ? gt[0][c4] : (sel == 1 ? gt[1][c4] : gt[2][c4]);
                  const float xv = fmaf(gate * sgc, r, __uint_as_float(xc[c4] << 16));
                  const unsigned xb = pk_bf16(xv, 0.f) & 0xffffu; const float xr = __uint_as_float(xb << 16); ssq = fmaf(xr, xr, ssq);
                  X[(size_t)t * D + 256 * s + 64 * c4 + lane] = (bf16_t)xb; }
              if (!last) {
                  ssq += dppf<0xB1>(ssq); ssq += dppf<0x4E>(ssq); ssq += dppf<0x141>(ssq); ssq += dppf<0x140>(ssq); ssq = x4_sum(ssq);
                  if (lane == 0) SSP[(size_t)t * 4 + s] = ssq; } }
            Ac[0] = An[0]; Ac[1] = An[1]; sgc = sgn;
#pragma unroll
            for (int c4 = 0; c4 < 4; ++c4) xc[c4] = xn[c4];
        }
        asm volatile("s_waitcnt vmcnt(0)" ::: "memory");
#undef PV_META
#undef PV_IDS
#undef PV_REGS
    }
}
__device__ __forceinline__ void phase_final(const P& p) {
    const bf16_t* X = (const bf16_t*)(p.ws + WS_XRES);
    const int lane = otid() & 63, gw = blockIdx.x * NWAVE + owave(), nw = gridDim.x * NWAVE;
    for (int r = gw; r < NLAT; r += nw) {
        const bf16_t* xr = X + (size_t)r * D; float4 v[4]; float ss = 0.f;
#pragma unroll
        for (int i = 0; i < 4; ++i) { const uint2 w = *(const uint2*)(xr + i * 256 + lane * 4); v[i] = make_float4(bf_lo(w.x), bf_hi(w.x), bf_lo(w.y), bf_hi(w.y)); ss += v[i].x * v[i].x + v[i].y * v[i].y + v[i].z * v[i].z + v[i].w * v[i].w; }
        ss = wave_sum(ss); const float rs = rsqrtf(ss * (1.0f / D) + EPS);
#pragma unroll
        for (int i = 0; i < 4; ++i) { const int col = i * 256 + lane * 4; const float4 gv = *(const float4*)(p.final_norm_g + col);
            float4 o; o.x = v[i].x * rs * gv.x; o.y = v[i].y * rs * gv.y; o.z = v[i].z * rs * gv.z; o.w = v[i].w * rs * gv.w;
            *(float4*)(p.out + (size_t)r * D + col) = o; }
    }
}
__device__ __forceinline__ bool gemm_has_slack(int ntiles) {
    const int G = (int)gridDim.x, c = (int)blockIdx.x; const int mine = c < ntiles ? (ntiles - c + G - 1) / G : 0, most = (ntiles + G - 1) / G;
    return mine < most;
}
__device__ __forceinline__ void gemm_slack_work(const P& p, int l, LAS unsigned char* lds, bool before) {
    if (((blockIdx.x & 1) != 0) != before) return;
    if (l + 1 < DEPTH) deferred_drain(p, l + 1, lds, 1);
    else if (before) { for (int i = 0; i < 3; ++i) __builtin_amdgcn_s_sleep(127); }
}
__device__ __forceinline__ void phase_gemm_in(const P& p, int l, LAS unsigned char* lds) {
    pg8::Gemm g{(const bf16_t*)(p.ws + WS_H), (const bf16_t*)(p.ws + WS_WIN) + (size_t)l * IN_W * D, NTOK, IN_W, D};
    pg8::StaticOrder S; S.init(NTOK, IN_W, (int)gridDim.x, (int)blockIdx.x);
    pg8::EpiStoreBf16 E{(bf16_t*)(p.ws + WS_PROJ), IN_W};
    const bool slack = gemm_has_slack((NTOK / 256) * (IN_W / 256));
    if (slack) gemm_slack_work(p, l, lds, true);
    if (l == 0) pg8::gemm_phase<pg8::EpiStoreBf16, pg8::StaticOrder, false>(lds, g, S, E, nullptr);
    else {
        pg8::Gemm g3{(const bf16_t*)(p.ws + WS_XRES), (const bf16_t*)(p.ws + WS_WIN3) + (size_t)(l - 1) * 3 * IN_W * D, NTOK, IN_W, D, (size_t)IN_W * D * 2};
        pg8::EpiScaleBias<4> E3{(bf16_t*)(p.ws + WS_PROJ), IN_W, (const float*)(p.ws + WS_SSP) + (size_t)l * 4 * NTOK, (const float*)(p.ws + WS_BIASP) + (size_t)l * 3 * 2 * IN_W};
        pg8::gemm_phase<pg8::EpiScaleBias<4>, pg8::StaticOrder, false>(lds, g3, S, E3, nullptr); }
    if (slack) gemm_slack_work(p, l, lds, false);
}
__device__ __forceinline__ void phase_gemm_out(const P& p, int l, LAS unsigned char* lds) {
    const int M = (l == DEPTH - 1) ? NLAT : NTOK;
    pg8::Gemm g{(const bf16_t*)(p.ws + WS_YCAT), (const bf16_t*)(p.ws + WS_WOUT) + (size_t)l * D * D, M, D, D};
    pg8::StaticOrder S; S.init(M, D, (int)gridDim.x, (int)blockIdx.x);
    pg8::EpiResid E{(bf16_t*)(p.ws + WS_XRES), l == 0 ? p.x : (const float*)nullptr, l == 0 ? p.ctx : (const float*)nullptr, D, (const float*)(p.ws + WS_MOD) + (size_t)l * 3 * MODW + 2 * D, MODW, (float*)(p.ws + WS_SSP2)};
    const bool slack = gemm_has_slack((M / 256) * (D / 256));
    if (slack) gemm_slack_work(p, l, lds, true);
    pg8::gemm_phase<pg8::EpiResid, pg8::StaticOrder, false>(lds, g, S, E, nullptr);
    if (slack) gemm_slack_work(p, l, lds, false);
}
__device__ __forceinline__ void phase_gemm_q(const P& p, int l, LAS unsigned char* lds) {
    const int M = (l == DEPTH - 1) ? NLAT : NTOK;
    pg8::Gemm g{(const bf16_t*)(p.ws + WS_XRES), (const bf16_t*)(p.ws + WS_WQ3) + (size_t)l * 3 * QW * D, M, QW, D, (size_t)QW * D * 2};
    pg8::StaticOrder S; S.init(M, QW, (int)gridDim.x, (int)blockIdx.x);
    pg8::EpiScaleBias<16> E{(bf16_t*)(p.ws + WS_Q), QW, (const float*)(p.ws + WS_SSP2), (const float*)(p.ws + WS_BIASP2) + (size_t)l * 3 * 2 * QW};
    const bool slack = gemm_has_slack((M / 256) * (QW / 256));
    if (slack) gemm_slack_work(p, l, lds, true);
    pg8::gemm_phase<pg8::EpiScaleBias<16>, pg8::StaticOrder, false>(lds, g, S, E, nullptr);
    if (slack) gemm_slack_work(p, l, lds, false);
}


#define XB_TMO      128
#define XB_XCNT(j)  (256  + 64 * (j))
#define XB_XSUB(j)  (1280 + 64 * (j))
#define XB_XGEN(j)  (2304 + 64 * (j))
#define XB_TOP      3328
#define XB_TOPGEN   3392
#define XCD_BAR_WORDS 3456
#define XB_SPIN_CAP (1u << 18)

__device__ __forceinline__ unsigned xb_ld(unsigned* p)              { return __hip_atomic_load(p, __ATOMIC_RELAXED, __HIP_MEMORY_SCOPE_AGENT); }
__device__ __forceinline__ unsigned xb_add(unsigned* p, unsigned v) { return __hip_atomic_fetch_add(p, v, __ATOMIC_RELAXED, __HIP_MEMORY_SCOPE_AGENT); }
__device__ __forceinline__ unsigned xb_xcc_id() { return (unsigned)__builtin_amdgcn_s_getreg((3 << 11) | 20) & 0xFu; }
#define XB_SPIN(cond, bar) do { unsigned _sp = 0; while (cond) { __builtin_amdgcn_s_sleep(1); \
    if ((++_sp & 255u) == 0u) { if (xb_ld(&(bar)[XB_TMO])) break; if (_sp > XB_SPIN_CAP) { atomicAdd(&(bar)[XB_TMO], 1u); break; } } } } while (0)
struct XcdBarrier {
    unsigned* bar; unsigned x;
    volatile LAS unsigned* st;
};

__device__ __forceinline__ XcdBarrier xcd_barrier_post(unsigned* bar, volatile LAS unsigned* st) {
    XcdBarrier b; b.bar = bar; b.x = xb_xcc_id(); b.st = st;
    if (threadIdx.x == 0) (void)xb_add(&bar[XB_XCNT(b.x)], 1u);
    return b;
}
__device__ __forceinline__ void xcd_barrier_complete(unsigned* bar, unsigned x, unsigned& nloc, unsigned& nx) {
    const unsigned G = gridDim.x * gridDim.y * gridDim.z;
    unsigned sum, cnt, mine, sp = 0u;
    for (;;) {
        sum = 0u; cnt = 0u; mine = 0u;
#pragma unroll
        for (unsigned j = 0; j < 16; ++j) { const unsigned c = xb_ld(&bar[XB_XCNT(j)]); sum += c; cnt += (c > 0u) ? 1u : 0u; mine = (j == x) ? c : mine; }
        if (sum == G) break;
        __builtin_amdgcn_s_sleep(1);
        if ((++sp & 255u) == 0u) { if (xb_ld(&bar[XB_TMO])) break; if (sp > XB_SPIN_CAP) { atomicAdd(&bar[XB_TMO], 1u); break; } }
    }
    nloc = mine > 0u ? mine : 1u; nx = cnt > 0u ? cnt : 1u;
}

__device__ __forceinline__ void xcd_barrier(const XcdBarrier& b) {
    asm volatile("s_waitcnt vmcnt(0)" ::: "memory");
    __syncthreads();
    if (threadIdx.x == 0) {
        unsigned* bar = b.bar;
        __builtin_amdgcn_s_waitcnt(0);
        unsigned nloc = b.st[0], nx = b.st[1];
        if (nloc == 0u) { xcd_barrier_complete(bar, b.x, nloc, nx); b.st[0] = nloc; b.st[1] = nx; }
        const unsigned old = xb_add(&bar[XB_XSUB(b.x)], 1u);
        const unsigned gen = old / nloc;
        if (old + 1u == (gen + 1u) * nloc) {
            __builtin_amdgcn_fence(__ATOMIC_RELEASE, "agent");
            asm volatile("s_waitcnt vmcnt(0)" ::: "memory");
            const unsigned og = xb_add(&bar[XB_TOP], 1u);
            const unsigned tg = og / nx;
            if (og + 1u == (tg + 1u) * nx) xb_add(&bar[XB_TOPGEN], 1u);
            else XB_SPIN(xb_ld(&bar[XB_TOPGEN]) == tg, bar);
            __builtin_amdgcn_fence(__ATOMIC_ACQUIRE, "agent");
            xb_add(&bar[XB_XGEN(b.x)], 1u);
            asm volatile("s_waitcnt vmcnt(0)" ::: "memory");
        } else {
            XB_SPIN(xb_ld(&bar[XB_XGEN(b.x)]) == gen, bar);
            __builtin_amdgcn_fence(__ATOMIC_ACQUIRE, "agent");
            asm volatile("s_waitcnt vmcnt(0)" ::: "memory");
        }
    }
    __syncthreads();
}

__global__ void __launch_bounds__(NTHR, 2) k_mega(P p) {
    extern __shared__ __attribute__((aligned(16))) unsigned char shm[];
    LAS unsigned char* lds = (LAS unsigned char*)shm;
    volatile LAS unsigned* st = (volatile LAS unsigned*)(lds + ST_OFF);
    if (threadIdx.x < 16) st[threadIdx.x] = 0u;
    __syncthreads();
    (void)xcd_barrier_post((unsigned*)(p.ws + WS_CTL), st);
    if (threadIdx.x == 0) st[4] = xb_add((unsigned*)(p.ws + WS_CTL) + 4096 + 64 * xb_xcc_id(), 1u);
#define GRID_BAR() do { XcdBarrier b_; { size_t z_ = 0; asm volatile("" : "+s"(z_)); b_.bar = (unsigned*)(p.ws + z_ + WS_CTL); } b_.x = xb_xcc_id(); \
        b_.st = (volatile LAS unsigned*)((LAS unsigned char*)shm + ST_OFF); xcd_barrier(b_); } while (0)
    { P q = p; { size_t z_ = 0; asm volatile("" : "+s"(z_)); q.ws = p.ws + z_; } phase_prologue(q, lds); }
    { P q = p; { size_t z_ = 0; asm volatile("" : "+s"(z_)); q.ws = p.ws + z_; } phase_adaln(q, lds); }
    GRID_BAR();
    if (threadIdx.x == 0) {
        unsigned cnt[16], dense = 0u, npop = 0u; const unsigned x = xb_xcc_id();
        for (unsigned j = 0; j < 16u; ++j) { cnt[j] = xb_ld((unsigned*)(p.ws + WS_CTL) + XB_XCNT(j)); if (cnt[j] > 0u) { if (j < x) ++dense; ++npop; } }
        unsigned base = 0u, total = 0u, k = 0u;
        for (unsigned j = 0; j < 16u; ++j) if (cnt[j] > 0u) { if ((k & 3u) == (dense & 3u)) { if (k < dense) base += cnt[j]; total += cnt[j]; } ++k; }
        st[6] = dense; st[7] = base; st[8] = (npop == 8u) ? total : 0u; }
    __syncthreads();
    { P q = p; { size_t z_ = 0; asm volatile("" : "+s"(z_)); q.ws = p.ws + z_; } phase_norm(q, 0, 0);
      for (int c = 256 + 120 + (int)blockIdx.x; c < DEF_NCHUNK; c += (int)gridDim.x) { __syncthreads(); deferred_chunk(q, 0, c, lds); } }
    GRID_BAR();
    for (int l = 0; l < DEPTH; ++l) {
        { P q = p; { size_t z_ = 0; asm volatile("" : "+s"(z_)); q.ws = p.ws + z_; } phase_gemm_in(q, l, lds); }
        GRID_BAR();
        { P q = p; { size_t z_ = 0; asm volatile("" : "+s"(z_)); q.ws = p.ws + z_; } phase_conv(q, l); }
        { P q = p; { size_t z_ = 0; asm volatile("" : "+s"(z_)); q.ws = p.ws + z_; } phase_sgu(q, l, lds); }
        { P q = p; { size_t z_ = 0; asm volatile("" : "+s"(z_)); q.ws = p.ws + z_; } phase_na(q, l, lds); }
        GRID_BAR();
        { P q = p; { size_t z_ = 0; asm volatile("" : "+s"(z_)); q.ws = p.ws + z_; } phase_gemm_out(q, l, lds); }
        GRID_BAR();
        { P q = p; { size_t z_ = 0; asm volatile("" : "+s"(z_)); q.ws = p.ws + z_; } phase_gemm_q(q, l, lds); }
        GRID_BAR();
        { P q = p; { size_t z_ = 0; asm volatile("" : "+s"(z_)); q.ws = p.ws + z_; } phase_topk(q, l, lds); }
        GRID_BAR();
        { P q = p; { size_t z_ = 0; asm volatile("" : "+s"(z_)); q.ws = p.ws + z_; } phase_peer_u(q, l, lds); }
        GRID_BAR();
        { P q = p; { size_t z_ = 0; asm volatile("" : "+s"(z_)); q.ws = p.ws + z_; } phase_peer_w4(q, l); }
        GRID_BAR();
        { P q = p; { size_t z_ = 0; asm volatile("" : "+s"(z_)); q.ws = p.ws + z_; } phase_peer_v(q, l, lds); if (l + 1 < DEPTH) deferred_drain(q, l + 1, lds, 1 << 30); }
        GRID_BAR();
        if (l + 1 == DEPTH) { P q = p; { size_t z_ = 0; asm volatile("" : "+s"(z_)); q.ws = p.ws + z_; } phase_final(q); }
    }
}

extern "C" void kernel_launch(void* const* d_in, const int* in_sizes, int n_in, void* d_out, int out_size, void* d_ws, size_t ws_size, hipStream_t stream) {
    static int grid = 0;
    if (grid == 0) {
        if (n_in != 21 || ws_size < WS_END) { fprintf(stderr, "kernel_launch: expected 21 inputs and >= %zu bytes of workspace, got %d and %zu\n", (size_t)WS_END, n_in, ws_size); grid = -1; return; }
        int dev = 0, cus = 0, per_cu = 0;
        if (hipGetDevice(&dev) != hipSuccess || hipDeviceGetAttribute(&cus, hipDeviceAttributeMultiprocessorCount, dev) != hipSuccess || cus <= 0) cus = 256;
        if (hipFuncSetAttribute((const void*)k_mega, hipFuncAttributeMaxDynamicSharedMemorySize, LDS_BYTES) != hipSuccess) { fprintf(stderr, "kernel_launch: hipFuncSetAttribute failed\n"); grid = -1; return; }
        if (hipOccupancyMaxActiveBlocksPerMultiprocessor(&per_cu, (const void*)k_mega, NTHR, LDS_BYTES) != hipSuccess || per_cu < 1) { fprintf(stderr, "kernel_launch: occupancy query reports %d workgroups per CU\n", per_cu); per_cu = 1; }
        (void)hipGetLastError();
        grid = cus;
    }
    if (grid < 0) return;
    (void)hipMemsetAsync((unsigned char*)d_ws + WS_CTL, 0, 65536, stream);
    P p{};
    const float** pf = (const float**)&p;
    for (int i = 0; i < 21; ++i) pf[i] = (const float*)d_in[i];
    p.out = (float*)d_out; p.ws = (unsigned char*)d_ws;
    hipLaunchKernelGGL(k_mega, dim3(grid), dim3(NTHR), LDS_BYTES, stream, p);
}
```

```cpp
#include <hip/hip_runtime.h>
#include <cstdio>
#include <cstdint>
#include <utility>

#ifndef ONE_LAUNCH
#define ONE_LAUNCH 0
#endif

namespace pg8 {
#define PG8_LAS __attribute__((address_space(3)))
typedef unsigned short bf16_t;
typedef short bf16x8 __attribute__((ext_vector_type(8)));
typedef float f32x4 __attribute__((ext_vector_type(4)));
typedef unsigned u32x4 __attribute__((ext_vector_type(4)));
constexpr int BM = 256, BK = 64, HALF = 128, HTB = HALF * BK * 2  , STAGE_BYTES = 8 * HTB, NXCD = 8, WGM = 8;

__host__ __device__ __forceinline__ int lds_byte(int r, int c) { const int st = (r >> 4) * 2 + (c >> 5), rr = r & 15, cc = c & 31, ob = rr * 64 + cc * 2; return st * 1024 + (ob ^ (((ob >> 9) & 1) << 5)); }
__host__ __device__ __forceinline__ void stage_rc(int b, int& R, int& C) { const int st = b / 1024, sb = b % 1024, swz = sb ^ (((sb >> 9) & 1) << 5); R = (st >> 1) * 16 + swz / 64; C = (st & 1) * 32 + (swz % 64) / 2; }
__host__ __device__ __forceinline__ int perm32(int rho) { const int n = rho >> 4, i = rho & 15; return 8 * (i >> 2) + 4 * n + (i & 3); }

struct Unit { int pm, pn; };
struct Gemm { const bf16_t* A; const bf16_t* Bt; int M, N, K; size_t vbytes; };
__host__ __device__ __forceinline__ int panel_sel(int pm) { return pm < 64 ? 0 : (pm < 128 ? 1 : 2); }

struct StaticOrder {
    int nM, nN, nwg, G, c;
    __host__ __device__ void init(int M, int N, int G_, int c_) { nM = M / BM; nN = N / BM; nwg = nM * nN; G = G_; c = c_; }
    __host__ __device__ bool next(int i, Unit& u) const {
        const long L = (long)i * G + c; if (L >= nwg) return false;
        int wgid = (int)L; { const int q = nwg / NXCD, r = nwg % NXCD, xcd = wgid % NXCD, off = wgid / NXCD; wgid = (xcd < r ? xcd * (q + 1) : r * (q + 1) + (xcd - r) * q) + off; }
        const int nig = WGM * nN, gid = wgid / nig, fm = gid * WGM, gsz = (nM - fm) < WGM ? (nM - fm) : WGM;
        u.pm = fm + ((wgid % nig) % gsz); u.pn = (wgid % nig) / gsz; return true;
    }
    __device__ __forceinline__ void a_ready(const Unit&) const {}
    __device__ __forceinline__ void done(const Unit&) const {}
};

__device__ __forceinline__ unsigned cvt_pk_bf16(float lo, float hi) { unsigned r; asm volatile("v_cvt_pk_bf16_f32 %0, %1, %2" : "=v"(r) : "v"(lo), "v"(hi)); return r; }

struct EpiStoreBf16 {
    static constexpr bool PERM = true, AFTER_DRAIN = false;
    bf16_t* O; int ldc;
    __device__ __forceinline__ void operator()(const f32x4 (&acc)[2][2][4][2], const Unit& u, int wr, int wc, int fr, int fq) const {
        const int row0 = u.pm * BM + wr * 64 + fr, col0 = u.pn * BM + wc * 32 + 8 * fq;
#pragma unroll
        for (int ai = 0; ai < 2; ++ai)
#pragma unroll
            for (int m = 0; m < 4; ++m) { bf16_t* rowp = O + (size_t)(row0 + ai * HALF + m * 16) * ldc + col0;
#pragma unroll
                for (int bj = 0; bj < 2; ++bj) { const f32x4 v0 = acc[ai][bj][m][0], v1 = acc[ai][bj][m][1];
                    u32x4 w; w.x = cvt_pk_bf16(v0[0], v0[1]); w.y = cvt_pk_bf16(v0[2], v0[3]); w.z = cvt_pk_bf16(v1[0], v1[1]); w.w = cvt_pk_bf16(v1[2], v1[3]);
                    *(u32x4*)(rowp + bj * HALF) = w; } }
    }
};
__device__ __forceinline__ float sq8_bf16(const u32x4 w) {
    float s = 0.f;
#pragma unroll
    for (int i = 0; i < 4; ++i) { const float lo = __uint_as_float(w[i] << 16), hi = __uint_as_float(w[i] & 0xffff0000u); s = __builtin_fmaf(lo, lo, s); s = __builtin_fmaf(hi, hi, s); }
    return s; }
__device__ __forceinline__ float x4sum(float x) {
    auto s = __builtin_amdgcn_permlane16_swap(__float_as_uint(x), __float_as_uint(x), false, false); x = __uint_as_float(s[0]) + __uint_as_float(s[1]);
    auto t = __builtin_amdgcn_permlane32_swap(__float_as_uint(x), __float_as_uint(x), false, false); return __uint_as_float(t[0]) + __uint_as_float(t[1]); }
template <int NSS> struct EpiScaleBias {
    static constexpr bool PERM = true, AFTER_DRAIN = false;
    bf16_t* O; int ldc; const float* ssp; const float* bias;
    __device__ __forceinline__ void operator()(const f32x4 (&acc)[2][2][4][2], const Unit& u, int wr, int wc, int fr, int fq) const {
        const int row0 = u.pm * BM + wr * 64 + fr, col0 = u.pn * BM + wc * 32 + 8 * fq;
        const float* bp = bias + (size_t)panel_sel(u.pm) * 2 * ldc + col0;
        f32x4 bv[2][2];
#pragma unroll
        for (int bj = 0; bj < 2; ++bj)
#pragma unroll
            for (int n = 0; n < 2; ++n) bv[bj][n] = *(const f32x4*)(bp + bj * HALF + 4 * n) + *(const f32x4*)(bp + ldc + bj * HALF + 4 * n);
#pragma unroll
        for (int ai = 0; ai < 2; ++ai) {
            float rs[4];
#pragma unroll
            for (int m = 0; m < 4; ++m) { const float* sp = ssp + (size_t)(row0 + ai * HALF + m * 16) * NSS + (NSS / 4) * fq; float sq;
                if constexpr (NSS == 16) { const f32x4 pv = *(const f32x4*)sp; sq = (pv[0] + pv[1]) + (pv[2] + pv[3]); } else sq = sp[0];
                sq = x4sum(sq);
                rs[m] = __builtin_amdgcn_rsqf(sq * (1.0f / 1024.0f) + 1e-6f); }
#pragma unroll
            for (int m = 0; m < 4; ++m) { bf16_t* rowp = O + (size_t)(row0 + ai * HALF + m * 16) * ldc + col0;
#pragma unroll
                for (int bj = 0; bj < 2; ++bj) { const f32x4 v0 = rs[m] * acc[ai][bj][m][0] + bv[bj][0], v1 = rs[m] * acc[ai][bj][m][1] + bv[bj][1];
                    u32x4 w; w.x = cvt_pk_bf16(v0[0], v0[1]); w.y = cvt_pk_bf16(v0[2], v0[3]); w.z = cvt_pk_bf16(v1[0], v1[1]); w.w = cvt_pk_bf16(v1[2], v1[3]);
                    *(u32x4*)(rowp + bj * HALF) = w; } }
        }
    }
};
struct EpiResid {
    static constexpr bool PERM = true, AFTER_DRAIN = false;
    bf16_t* X; const float* Xlat; const float* Xctx; int ldc; const float* gate; int gate_stride; float* ssp;
    __device__ __forceinline__ void operator()(const f32x4 (&acc)[2][2][4][2], const Unit& u, int wr, int wc, int fr, int fq) const {
        const int row0 = u.pm * BM + wr * 64 + fr, col0 = u.pn * BM + wc * 32 + 8 * fq;
        const float* gp = gate + (size_t)(u.pm < 64 ? 0 : (u.pm < 128 ? 1 : 2)) * gate_stride + col0;
        f32x4 gv[2][2];
#pragma unroll
        for (int bj = 0; bj < 2; ++bj)
#pragma unroll
            for (int n = 0; n < 2; ++n) gv[bj][n] = *(const f32x4*)(gp + bj * HALF + 4 * n);
        float sq[2][4] = {{0.f, 0.f, 0.f, 0.f}, {0.f, 0.f, 0.f, 0.f}};
        if (Xlat != nullptr) {
#pragma unroll
            for (int am = 0; am < 2; ++am)
#pragma unroll
                for (int mh = 0; mh < 2; ++mh) {
                    f32x4 xv[2][2][2];
#pragma unroll
                    for (int m2 = 0; m2 < 2; ++m2) { const int row = row0 + am * HALF + (2 * mh + m2) * 16; const float* rowp = (u.pm < 128 ? Xlat + (size_t)row * ldc : Xctx + (size_t)(row - 32768) * ldc) + col0;
#pragma unroll
                        for (int bj = 0; bj < 2; ++bj)
#pragma unroll
                            for (int n = 0; n < 2; ++n) xv[m2][bj][n] = *(const f32x4*)(rowp + bj * HALF + 4 * n); }
#pragma unroll
                    for (int m2 = 0; m2 < 2; ++m2) { const int m = 2 * mh + m2; bf16_t* rowp = X + (size_t)(row0 + am * HALF + m * 16) * ldc + col0;
#pragma unroll
                        for (int bj = 0; bj < 2; ++bj) { const f32x4 v0 = xv[m2][bj][0] + gv[bj][0] * acc[am][bj][m][0], v1 = xv[m2][bj][1] + gv[bj][1] * acc[am][bj][m][1];
                            u32x4 w; w.x = cvt_pk_bf16(v0[0], v0[1]); w.y = cvt_pk_bf16(v0[2], v0[3]); w.z = cvt_pk_bf16(v1[0], v1[1]); w.w = cvt_pk_bf16(v1[2], v1[3]);
                            sq[am][m] += sq8_bf16(w);
                            *(u32x4*)(rowp + bj * HALF) = w; } }
                }
        } else {
#pragma unroll
            for (int am = 0; am < 2; ++am) {
                u32x4 xb[4][2];
#pragma unroll
                for (int m = 0; m < 4; ++m) { const bf16_t* rowp = X + (size_t)(row0 + am * HALF + m * 16) * ldc + col0;
#pragma unroll
                    for (int bj = 0; bj < 2; ++bj) xb[m][bj] = *(const u32x4*)(rowp + bj * HALF); }
#pragma unroll
                for (int m = 0; m < 4; ++m) { bf16_t* rowp = X + (size_t)(row0 + am * HALF + m * 16) * ldc + col0;
#pragma unroll
                    for (int bj = 0; bj < 2; ++bj) { const u32x4 b = xb[m][bj]; const f32x4 g0 = gv[bj][0], g1 = gv[bj][1], a0 = acc[am][bj][m][0], a1 = acc[am][bj][m][1];
                        u32x4 w;
                        w.x = cvt_pk_bf16(__uint_as_float(b.x << 16) + g0[0] * a0[0], __uint_as_float(b.x & 0xffff0000u) + g0[1] * a0[1]);
                        w.y = cvt_pk_bf16(__uint_as_float(b.y << 16) + g0[2] * a0[2], __uint_as_float(b.y & 0xffff0000u) + g0[3] * a0[3]);
                        w.z = cvt_pk_bf16(__uint_as_float(b.z << 16) + g1[0] * a1[0], __uint_as_float(b.z & 0xffff0000u) + g1[1] * a1[1]);
                        w.w = cvt_pk_bf16(__uint_as_float(b.w << 16) + g1[2] * a1[2], __uint_as_float(b.w & 0xffff0000u) + g1[3] * a1[3]);
                        sq[am][m] += sq8_bf16(w);
                        *(u32x4*)(rowp + bj * HALF) = w; } }
            }
        }
#pragma unroll
        for (int am = 0; am < 2; ++am)
#pragma unroll
            for (int m = 0; m < 4; ++m) { const float t = x4sum(sq[am][m]); if (fq == 0) ssp[(size_t)(row0 + am * HALF + m * 16) * 16 + 4 * u.pn + wc] = t; }
    }
};

template <class Epi, class Sched, bool STAMP = false>
__device__ __forceinline__ void gemm_phase(PG8_LAS unsigned char* lds, const Gemm g, const Sched& S, const Epi& E, unsigned long long* stamps) {
    int tid_ = threadIdx.x; asm volatile("" : "+v"(tid_));
    const int tid = tid_, wid = __builtin_amdgcn_readfirstlane(tid >> 6), lane = tid & 63, wr = wid >> 2, wc = wid & 3, fr = lane & 15, fq = lane >> 4;
    const int K = g.K, nt = K / BK;
    int ts_lo = 0, ts_hi = 0, nts = 0; const unsigned long long rt_entry = STAMP ? (unsigned long long)wall_clock64() : 0ull;
#define PG8_STAMP() do { if (STAMP && wid == 0 && nts < 64) { const unsigned long long _c = (unsigned long long)clock64(); \
        ts_lo = (lane == nts) ? (int)(unsigned)_c : ts_lo; ts_hi = (lane == nts) ? (int)(unsigned)(_c >> 32) : ts_hi; ++nts; } } while (0)
    PG8_STAMP();
    unsigned voffA[2], voffB[2];
#pragma unroll
    for (int i = 0; i < 2; ++i) { int R, C; stage_rc(tid * 16 + i * 8192, R, C); const int Rb = Epi::PERM ? ((R & ~31) + perm32(R & 31)) : R;
        voffA[i] = (unsigned)(R * K + C) * 2u; voffB[i] = (unsigned)(Rb * K + C) * 2u; }
    const size_t kstep = (size_t)(BK * 2);
    const size_t hstep = (size_t)HALF * K * 2;
    const size_t tstep = 2 * hstep;
    const unsigned ldsw = (unsigned)wid * 1024u;
    const int aoff = lds_byte(wr * 64 + fr, fq * 8), boff = lds_byte(wc * 32 + fr, fq * 8);
#define PG8_SA(b, h) (((b) * 2 + (h)) * HTB)
#define PG8_SB(b, h) ((4 + (b) * 2 + (h)) * HTB)
#define PG8_STAGE(bufoff, gbase, voff) do { _Pragma("unroll") for (int _i = 0; _i < 2; ++_i) \
        __builtin_amdgcn_global_load_lds((const unsigned*)((const char*)(gbase) + (voff)[_i]), (PG8_LAS unsigned*)(lds + (bufoff) + ldsw + _i * 8192), 16, 0, 0); } while (0)
#define PG8_LDA(dst, b, h) do { _Pragma("unroll") for (int m = 0; m < 4; ++m) _Pragma("unroll") for (int k = 0; k < 2; ++k) dst[m][k] = *(const PG8_LAS bf16x8*)(lds + PG8_SA(b, h) + aoff + m * 2048 + k * 1024); } while (0)
#define PG8_LDB(dst, b, h) do { _Pragma("unroll") for (int n = 0; n < 2; ++n) _Pragma("unroll") for (int k = 0; k < 2; ++k) dst[n][k] = *(const PG8_LAS bf16x8*)(lds + PG8_SB(b, h) + boff + n * 2048 + k * 1024); } while (0)
#define PG8_MMA(ai, bj, At, Bt) do { __builtin_amdgcn_s_setprio(1); _Pragma("unroll") for (int m = 0; m < 4; ++m) _Pragma("unroll") for (int n = 0; n < 2; ++n) _Pragma("unroll") for (int k = 0; k < 2; ++k) \
        acc[ai][bj][m][n] = __builtin_amdgcn_mfma_f32_16x16x32_bf16(Bt[n][k], At[m][k], acc[ai][bj][m][n], 0, 0, 0); __builtin_amdgcn_s_setprio(0); } while (0)
#define PG8_WAIT_V(n) asm volatile("s_waitcnt vmcnt(" #n ")" ::: "memory")
#define PG8_WAIT_L(n) asm volatile("s_waitcnt lgkmcnt(" #n ")" ::: "memory")
#define PG8_BAR __builtin_amdgcn_s_barrier()
#define PG8_SCHED __builtin_amdgcn_sched_barrier(0)
    Unit cur, nxt; int ui = 0;
    if (!S.next(0, cur)) return;
    f32x4 acc[2][2][4][2];
#pragma unroll
    for (int a = 0; a < 2; ++a)
#pragma unroll
        for (int b = 0; b < 2; ++b)
#pragma unroll
            for (int m = 0; m < 4; ++m)
#pragma unroll
                for (int n = 0; n < 2; ++n) acc[a][b][m][n] = (f32x4){0.f, 0.f, 0.f, 0.f};
    bf16x8 At[4][2], B0[2][2], B1[2][2];
    const char* cA = (const char*)g.A + (size_t)cur.pm * tstep; const char* cB = (const char*)g.Bt + (size_t)cur.pn * tstep + (size_t)panel_sel(cur.pm) * g.vbytes;
    S.a_ready(cur);
    PG8_STAGE(PG8_SB(0, 0), cB, voffB); PG8_STAGE(PG8_SA(0, 0), cA, voffA); PG8_STAGE(PG8_SB(0, 1), cB + hstep, voffB); PG8_STAGE(PG8_SA(0, 1), cA + hstep, voffA);
    if (wr == 1) PG8_BAR;
    PG8_WAIT_V(4); PG8_BAR;
    PG8_STAGE(PG8_SB(1, 0), cB + kstep, voffB); PG8_STAGE(PG8_SA(1, 0), cA + kstep, voffA); PG8_STAGE(PG8_SB(1, 1), cB + hstep + kstep, voffB);
    PG8_WAIT_V(6); PG8_BAR;
    PG8_STAMP();
    for (;;) {
        const bool has_next = S.next(ui + 1, nxt);
        const char* nA = has_next ? (const char*)g.A + (size_t)nxt.pm * tstep : cA; const char* nB = has_next ? (const char*)g.Bt + (size_t)nxt.pn * tstep + (size_t)panel_sel(nxt.pm) * g.vbytes : cB;
        for (int t = 0; t < nt; t += 2) {
            const bool last = (t == nt - 2);
            const char* a1 = cA + (size_t)(t + 1) * kstep;
            const char* a2 = last ? nA : cA + (size_t)(t + 2) * kstep; const char* b2 = last ? nB : cB + (size_t)(t + 2) * kstep;
            const char* a3 = a2 + kstep; const char* b3 = b2 + kstep;
            if (last && has_next) S.a_ready(nxt);
            PG8_LDB(B0, 0, 0); PG8_SCHED; PG8_LDA(At, 0, 0); PG8_STAGE(PG8_SA(1, 1), a1 + hstep, voffA);
            PG8_WAIT_L(8); PG8_BAR; PG8_WAIT_L(0); PG8_MMA(0, 0, At, B0); PG8_BAR; PG8_SCHED;
            PG8_LDB(B1, 0, 1); PG8_STAGE(PG8_SB(0, 0), b2, voffB);
            PG8_BAR; PG8_WAIT_L(0); PG8_MMA(0, 1, At, B1); PG8_BAR;
            PG8_LDA(At, 0, 1); PG8_STAGE(PG8_SA(0, 0), a2, voffA);
            PG8_BAR; PG8_WAIT_L(0); PG8_MMA(1, 0, At, B0); PG8_BAR; PG8_SCHED;
            PG8_STAGE(PG8_SB(0, 1), b2 + hstep, voffB);
            PG8_WAIT_V(6); PG8_BAR; PG8_MMA(1, 1, At, B1); PG8_BAR;
            PG8_LDB(B0, 1, 0); PG8_SCHED; PG8_LDA(At, 1, 0); PG8_STAGE(PG8_SA(0, 1), a2 + hstep, voffA);
            PG8_WAIT_L(8); PG8_BAR; PG8_WAIT_L(0); PG8_MMA(0, 0, At, B0); PG8_BAR; PG8_SCHED;
            PG8_LDB(B1, 1, 1); PG8_STAGE(PG8_SB(1, 0), b3, voffB);
            PG8_BAR; PG8_WAIT_L(0); PG8_MMA(0, 1, At, B1); PG8_BAR;
            PG8_LDA(At, 1, 1); PG8_STAGE(PG8_SA(1, 0), a3, voffA);
            PG8_BAR; PG8_WAIT_L(0); PG8_MMA(1, 0, At, B0); PG8_BAR; PG8_SCHED;
            PG8_STAGE(PG8_SB(1, 1), b3 + hstep, voffB);
            PG8_WAIT_V(6); PG8_BAR; PG8_MMA(1, 1, At, B1); PG8_BAR;
        }
        PG8_STAMP();
        if constexpr (!Epi::AFTER_DRAIN) { E(acc, cur, wr, wc, fr, fq); S.done(cur); }
        PG8_STAMP();
        if (!has_next) break;
#pragma unroll
        for (int a = 0; a < 2; ++a)
#pragma unroll
            for (int b = 0; b < 2; ++b)
#pragma unroll
                for (int m = 0; m < 4; ++m)
#pragma unroll
                    for (int n = 0; n < 2; ++n) acc[a][b][m][n] = (f32x4){0.f, 0.f, 0.f, 0.f};
        cur = nxt; cA = nA; cB = nB; ++ui;
    }
    PG8_WAIT_V(0);
    if (wr == 0) PG8_BAR;
    PG8_BAR;
    if constexpr (Epi::AFTER_DRAIN) { E.fused(acc, cur, wr, wc, fr, fq, lds, wid, lane); S.done(cur); }
    PG8_STAMP();
    if (STAMP && wid == 0) { stamps[lane] = lane < nts ? (((unsigned long long)(unsigned)ts_hi << 32) | (unsigned)ts_lo) : 0ull;
        if (lane == 62) stamps[62] = rt_entry; if (lane == 63) stamps[63] = (unsigned long long)wall_clock64(); }
#undef PG8_STAMP
#undef PG8_SA
#undef PG8_SB
#undef PG8_STAGE
#undef PG8_LDA
#undef PG8_LDB
#undef PG8_MMA
#undef PG8_WAIT_V
#undef PG8_WAIT_L
#undef PG8_BAR
#undef PG8_SCHED
}
}

#define LAS __attribute__((address_space(3)))
typedef unsigned short bf16_t;
constexpr int D = 1024, T = 16384, NLAT = 32768, CTXL = 256, NTOK = 33280, DEPTH = 4;
constexpr int IN_W = 2816, QW = 2048;
constexpr int C_GB = 0, C_GC = 256, C_XI = 512, C_SU = 768, C_SV = 1024, C_Q = 1280, C_K = 1792, C_V = 2304;
constexpr int MODW = 6144;
constexpr float EPS = 1e-6f;
constexpr int NTHR = 512, NWAVE = 8;
constexpr int ST_OFF = 131072 + 1024 + 20480 + 2048;
constexpr int LDS_BYTES = ST_OFF + 1024;

constexpr size_t MiB = 1u << 20;
constexpr size_t WS_CTL = 0;
constexpr size_t WS_MOD = 1 * MiB;
constexpr size_t WS_US = 1 * MiB + 512 * 1024;
constexpr size_t WS_VS = 1 * MiB + 768 * 1024;
constexpr size_t WS_WIN = 2 * MiB;
constexpr size_t WS_WOUT = WS_WIN + 22 * MiB;
constexpr size_t WS_WQ = WS_WOUT + 8 * MiB;
constexpr size_t WS_SUBK = WS_WQ + 16 * MiB;
constexpr size_t TSLICE = (size_t)16384 * 128;
constexpr size_t WS_UT = WS_SUBK + 2 * MiB;
constexpr size_t WS_VT = WS_UT + 128 * MiB;
constexpr size_t WS_XRES = WS_VT + 128 * MiB;
constexpr size_t WS_H = WS_XRES + 130 * MiB;
constexpr size_t WS_PROJ = WS_H + 65 * MiB;
constexpr size_t WS_H4 = WS_PROJ + 96 * MiB;
constexpr size_t WS_PW4 = WS_PROJ + 150 * MiB;
constexpr size_t WS_YCAT = WS_PROJ + 179 * MiB;
constexpr size_t WS_Q = WS_YCAT + 65 * MiB;
constexpr size_t WS_PIDX = WS_Q + 130 * MiB;
constexpr size_t WS_PG = WS_PIDX + 17 * MiB;
constexpr size_t WS_SGUW = WS_PG + 16 * MiB + 512 * 1024;
constexpr size_t WS_END = WS_PG + 17 * MiB;
constexpr size_t WS_WIN3 = WS_UT + 32 * MiB;
constexpr size_t WS_BIASP = WS_XRES + 65 * MiB;
constexpr size_t WS_WQ3 = WS_VT + 32 * MiB;
constexpr size_t WS_BIASP2 = WS_XRES + 65 * MiB + 512 * 1024;
constexpr size_t WS_SSP2 = WS_XRES + 70 * MiB;
constexpr size_t WS_SSP = WS_XRES + 66 * MiB;

struct P {
    const float *x, *c, *ctx, *c_ctx, *ada_w, *ada_b, *norm1_g, *w_in, *conv_w, *sgu_w, *sgu_b, *sgu_norm_g, *na_rpb, *out_norm_g, *w_out, *norm2_g,
                *peer_wq, *peer_subkeys, *peer_u, *peer_v, *final_norm_g;
    float* out; unsigned char* ws;
};

__device__ __forceinline__ float bf_lo(unsigned u) { return __uint_as_float(u << 16); }
__device__ __forceinline__ float bf_hi(unsigned u) { return __uint_as_float(u & 0xffff0000u); }
__device__ __forceinline__ float bf1(bf16_t b) { return __uint_as_float(((unsigned)b) << 16); }
__device__ __forceinline__ unsigned pk_bf16(float lo, float hi) { return pg8::cvt_pk_bf16(lo, hi); }
__device__ __forceinline__ float wave_sum(float v) {
#pragma unroll
    for (int o = 32; o >= 1; o >>= 1) v += __shfl_xor(v, o);
    return v; }
__device__ __forceinline__ float wave_max(float v) {
#pragma unroll
    for (int o = 32; o >= 1; o >>= 1) v = fmaxf(v, __shfl_xor(v, o));
    return v; }
__device__ __forceinline__ float gelu_tanh(float x) {
    const float y = 0.7978845608f * (x + 0.044715f * x * x * x);
    const float e = __expf(2.0f * y);
    const float th = 1.0f - 2.0f * __builtin_amdgcn_rcpf(1.0f + e);
    return 0.5f * x * (1.0f + th); }
__device__ __forceinline__ void unpack8(const uint4 v, float (&f)[8]) {
    f[0] = bf_lo(v.x); f[1] = bf_hi(v.x); f[2] = bf_lo(v.y); f[3] = bf_hi(v.y); f[4] = bf_lo(v.z); f[5] = bf_hi(v.z); f[6] = bf_lo(v.w); f[7] = bf_hi(v.w); }
__device__ __forceinline__ float dot8(const uint4 a, const uint4 b, float acc) {
    acc = fmaf(bf_lo(a.x), bf_lo(b.x), acc); acc = fmaf(bf_hi(a.x), bf_hi(b.x), acc);
    acc = fmaf(bf_lo(a.y), bf_lo(b.y), acc); acc = fmaf(bf_hi(a.y), bf_hi(b.y), acc);
    acc = fmaf(bf_lo(a.z), bf_lo(b.z), acc); acc = fmaf(bf_hi(a.z), bf_hi(b.z), acc);
    acc = fmaf(bf_lo(a.w), bf_lo(b.w), acc); acc = fmaf(bf_hi(a.w), bf_hi(b.w), acc);
    return acc; }
__device__ __forceinline__ int row_sel(int r) { return r < T ? 0 : (r < NLAT ? 1 : 2); }

__device__ __forceinline__ int otid() { int t = threadIdx.x; asm volatile("" : "+v"(t)); return t; }

__device__ __forceinline__ int owave() { return __builtin_amdgcn_readfirstlane(otid() >> 6); }

__device__ __forceinline__ void transpose_cvt(const float* src, int K, int N, bf16_t* dst, LAS float* tile) {
    const int tid = otid(), tn = N / 64, ntile = (K / 64) * tn;
    const int kk = tid >> 4, nn = (tid & 15) * 4;
    float4 v[2];
    if ((int)blockIdx.x < ntile) { const int k0 = ((int)blockIdx.x / tn) * 64, n0 = ((int)blockIdx.x % tn) * 64;
#pragma unroll
        for (int i = 0; i < 2; ++i) v[i] = *(const float4*)(src + (size_t)(k0 + kk + 32 * i) * N + n0 + nn); }
    for (int t = blockIdx.x; t < ntile; t += gridDim.x) {
        const int k0 = (t / tn) * 64, n0 = (t % tn) * 64;
#pragma unroll
        for (int i = 0; i < 2; ++i) { const int k = kk + 32 * i;
            tile[k * 65 + nn + 0] = v[i].x; tile[k * 65 + nn + 1] = v[i].y; tile[k * 65 + nn + 2] = v[i].z; tile[k * 65 + nn + 3] = v[i].w; }
        __syncthreads();
        { const int t2 = t + (int)gridDim.x;
          if (t2 < ntile) { const int k2 = (t2 / tn) * 64, n2 = (t2 % tn) * 64;
#pragma unroll
              for (int i = 0; i < 2; ++i) v[i] = *(const float4*)(src + (size_t)(k2 + kk + 32 * i) * N + n2 + nn); } }
        const int n = tid >> 3, kc = (tid & 7) * 8;
        uint4 w;
        w.x = pk_bf16(tile[(kc + 0) * 65 + n], tile[(kc + 1) * 65 + n]); w.y = pk_bf16(tile[(kc + 2) * 65 + n], tile[(kc + 3) * 65 + n]);
        w.z = pk_bf16(tile[(kc + 4) * 65 + n], tile[(kc + 5) * 65 + n]); w.w = pk_bf16(tile[(kc + 6) * 65 + n], tile[(kc + 7) * 65 + n]);
        *(uint4*)(dst + (size_t)(n0 + n) * K + k0 + kc) = w;
        __syncthreads();
    }
}
__device__ __forceinline__ void cvt_copy(const float* src, bf16_t* dst, size_t n) {
    const size_t stride = (size_t)gridDim.x * NTHR;
    for (size_t i = (size_t)blockIdx.x * NTHR + otid(); i < n / 8; i += stride) {
        const float4 a = ((const float4*)src)[2 * i], b = ((const float4*)src)[2 * i + 1];
        uint4 w; w.x = pk_bf16(a.x, a.y); w.y = pk_bf16(a.z, a.w); w.z = pk_bf16(b.x, b.y); w.w = pk_bf16(b.z, b.w);
        ((uint4*)dst)[i] = w; }
}
typedef float f32x2_t __attribute__((ext_vector_type(2)));
__device__ __forceinline__ void quant_rows_fp4(const float* src, unsigned char* dst, float* scale, int nrows) {
    const int lane = otid() & 63, gw = blockIdx.x * NWAVE + owave(), nw = gridDim.x * NWAVE;
    float4 nx[4];
    { const float4* sp = (const float4*)(src + (size_t)(gw < nrows ? gw : 0) * 1024 + lane * 16); nx[0] = sp[0]; nx[1] = sp[1]; nx[2] = sp[2]; nx[3] = sp[3]; }
    for (int r = gw; r < nrows; r += nw) {
        const float4 a = nx[0], b = nx[1], c = nx[2], d = nx[3];
        { const int r2 = (r + nw < nrows) ? r + nw : r; const float4* sp = (const float4*)(src + (size_t)r2 * 1024 + lane * 16); nx[0] = sp[0]; nx[1] = sp[1]; nx[2] = sp[2]; nx[3] = sp[3]; }
        float m = fmaxf(fmaxf(fmaxf(fabsf(a.x), fabsf(a.y)), fmaxf(fabsf(a.z), fabsf(a.w))), fmaxf(fmaxf(fabsf(b.x), fabsf(b.y)), fmaxf(fabsf(b.z), fabsf(b.w))));
        m = fmaxf(m, fmaxf(fmaxf(fmaxf(fabsf(c.x), fabsf(c.y)), fmaxf(fabsf(c.z), fabsf(c.w))), fmaxf(fmaxf(fabsf(d.x), fabsf(d.y)), fmaxf(fabsf(d.z), fabsf(d.w)))));
        m = wave_max(m); m = fmaxf(m, 1e-30f);
        const float inv = 6.0f / m;
        unsigned w0 = 0u, w1 = 0u;
        w0 = __builtin_amdgcn_cvt_scalef32_pk_fp4_f32(w0, a.x * inv, a.y * inv, 1.0f, 0); w0 = __builtin_amdgcn_cvt_scalef32_pk_fp4_f32(w0, a.z * inv, a.w * inv, 1.0f, 1);
        w0 = __builtin_amdgcn_cvt_scalef32_pk_fp4_f32(w0, b.x * inv, b.y * inv, 1.0f, 2); w0 = __builtin_amdgcn_cvt_scalef32_pk_fp4_f32(w0, b.z * inv, b.w * inv, 1.0f, 3);
        w1 = __builtin_amdgcn_cvt_scalef32_pk_fp4_f32(w1, c.x * inv, c.y * inv, 1.0f, 0); w1 = __builtin_amdgcn_cvt_scalef32_pk_fp4_f32(w1, c.z * inv, c.w * inv, 1.0f, 1);
        w1 = __builtin_amdgcn_cvt_scalef32_pk_fp4_f32(w1, d.x * inv, d.y * inv, 1.0f, 2); w1 = __builtin_amdgcn_cvt_scalef32_pk_fp4_f32(w1, d.z * inv, d.w * inv, 1.0f, 3);
        *(uint2*)(dst + (size_t)(lane >> 4) * TSLICE + (size_t)r * 128 + (lane & 15) * 8) = make_uint2(w0, w1);
        if (lane == 0) scale[r] = m * (1.0f / 6.0f);
    }
}
__device__ __forceinline__ void phase_prologue(const P& p, LAS unsigned char* lds) {
    unsigned char* ws = p.ws;
    transpose_cvt(p.w_in, D, IN_W, (bf16_t*)(ws + WS_WIN), (LAS float*)lds);
    transpose_cvt(p.w_out, D, D, (bf16_t*)(ws + WS_WOUT), (LAS float*)lds);
    cvt_copy(p.peer_subkeys, (bf16_t*)(ws + WS_SUBK), (size_t)DEPTH * 8 * 2 * 128 * 128);
    cvt_copy(p.sgu_w, (bf16_t*)(ws + WS_SGUW), (size_t)DEPTH * 4 * 128 * 128);
    quant_rows_fp4(p.peer_u, ws + WS_UT, (float*)(ws + WS_US), 16384);
    quant_rows_fp4(p.peer_v, ws + WS_VT, (float*)(ws + WS_VS), 16384);
}
constexpr int DEF_NCHUNK = 256 + 184;
__device__ __forceinline__ void deferred_chunk(const P& p, int L, int c, LAS unsigned char* lds) {
    unsigned char* ws = p.ws;
    const int tid = otid(), wave = __builtin_amdgcn_readfirstlane(tid >> 6), lane = tid & 63;
    if (c < 256) {
        const bool isv = c >= 128; const int row0 = (c & 127) * 128 + wave * 16;
        const float* src = (isv ? p.peer_v : p.peer_u) + ((size_t)L * 16384 + row0) * 1024 + lane * 16;
        unsigned char* dst = ws + (isv ? WS_VT : WS_UT) + (size_t)L * 16384 * 512 + (size_t)(lane >> 4) * TSLICE + (size_t)row0 * 128 + (lane & 15) * 8;
        float* scale = (float*)(ws + (isv ? WS_VS : WS_US)) + (size_t)L * 16384 + row0;
        for (int r4 = 0; r4 < 16; r4 += 4) {
            float4 x[4][4];
#pragma unroll
            for (int q = 0; q < 4; ++q) { const float4* sp = (const float4*)(src + (size_t)(r4 + q) * 1024); x[q][0] = sp[0]; x[q][1] = sp[1]; x[q][2] = sp[2]; x[q][3] = sp[3]; }
#pragma unroll
            for (int q = 0; q < 4; ++q) {
                const float4 a = x[q][0], b = x[q][1], cc = x[q][2], d = x[q][3];
                float m = fmaxf(fmaxf(fmaxf(fabsf(a.x), fabsf(a.y)), fmaxf(fabsf(a.z), fabsf(a.w))), fmaxf(fmaxf(fabsf(b.x), fabsf(b.y)), fmaxf(fabsf(b.z), fabsf(b.w))));
                m = fmaxf(m, fmaxf(fmaxf(fmaxf(fabsf(cc.x), fabsf(cc.y)), fmaxf(fabsf(cc.z), fabsf(cc.w))), fmaxf(fmaxf(fabsf(d.x), fabsf(d.y)), fmaxf(fabsf(d.z), fabsf(d.w)))));
                m = wave_max(m); m = fmaxf(m, 1e-30f);
                const float inv = 6.0f / m;
                unsigned w0 = 0u, w1 = 0u;
                w0 = __builtin_amdgcn_cvt_scalef32_pk_fp4_f32(w0, a.x * inv, a.y * inv, 1.0f, 0); w0 = __builtin_amdgcn_cvt_scalef32_pk_fp4_f32(w0, a.z * inv, a.w * inv, 1.0f, 1);
                w0 = __builtin_amdgcn_cvt_scalef32_pk_fp4_f32(w0, b.x * inv, b.y * inv, 1.0f, 2); w0 = __builtin_amdgcn_cvt_scalef32_pk_fp4_f32(w0, b.z * inv, b.w * inv, 1.0f, 3);
                w1 = __builtin_amdgcn_cvt_scalef32_pk_fp4_f32(w1, cc.x * inv, cc.y * inv, 1.0f, 0); w1 = __builtin_amdgcn_cvt_scalef32_pk_fp4_f32(w1, cc.z * inv, cc.w * inv, 1.0f, 1);
                w1 = __builtin_amdgcn_cvt_scalef32_pk_fp4_f32(w1, d.x * inv, d.y * inv, 1.0f, 2); w1 = __builtin_amdgcn_cvt_scalef32_pk_fp4_f32(w1, d.z * inv, d.w * inv, 1.0f, 3);
                *(uint2*)(dst + (size_t)(r4 + q) * 128) = make_uint2(w0, w1);
                if (lane == 0) scale[r4 + q] = m * (1.0f / 6.0f);
            }
        }
    } else {
        LAS float* tile = (LAS float*)lds;
        const int kk = tid >> 4, nn = (tid & 15) * 4, n = tid >> 3, kc = (tid & 7) * 8;
        auto tile_of = [&](int q, const float*& src, bf16_t*& dst, int& N, int& k0, int& n0) { int t = (c - 256) * 8 + q;
            if (t < 704) { src = p.w_in + (size_t)L * D * IN_W; dst = (bf16_t*)(ws + WS_WIN3) + (size_t)(L - 1) * 3 * IN_W * D; N = IN_W; k0 = (t & 15) * 64; n0 = (t >> 4) * 64; return; }
            else if (t < 960) { t -= 704; src = p.w_out + (size_t)L * D * D; dst = (bf16_t*)(ws + WS_WOUT) + (size_t)L * D * D; N = D; }
            else { t -= 960; src = p.peer_wq + (size_t)L * D * QW; dst = (bf16_t*)(ws + WS_WQ3) + (size_t)L * 3 * QW * D; N = QW; k0 = (t & 15) * 64; n0 = (t >> 4) * 64; return; }
            const int tn = N / 64; k0 = (t / tn) * 64; n0 = (t % tn) * 64; };
        const int t0_ = (c - 256) * 8;
        const bool isq = t0_ >= 960, win = t0_ < 704 || isq;
        const float* gvec = (isq ? p.norm2_g : p.norm1_g) + (size_t)L * D; const int modoff = isq ? 3 * D : 0, Nw = isq ? QW : IN_W;
        float bacc[3] = {0.f, 0.f, 0.f};
        float4 v[2];
        { const float* src; bf16_t* dst; int N, k0, n0; tile_of(0, src, dst, N, k0, n0);
#pragma unroll
          for (int i = 0; i < 2; ++i) v[i] = *(const float4*)(src + (size_t)(k0 + kk + 32 * i) * N + n0 + nn); }
        for (int q = 0; q < 8; ++q) {
            const float* src; bf16_t* dst; int N, k0, n0; tile_of(q, src, dst, N, k0, n0);
#pragma unroll
            for (int i = 0; i < 2; ++i) { const int k = kk + 32 * i; tile[k * 65 + nn + 0] = v[i].x; tile[k * 65 + nn + 1] = v[i].y; tile[k * 65 + nn + 2] = v[i].z; tile[k * 65 + nn + 3] = v[i].w; }
            __syncthreads();
            if (q + 1 < 8) { const float* s2; bf16_t* d2; int N2, k2, n2; tile_of(q + 1, s2, d2, N2, k2, n2);
#pragma unroll
                for (int i = 0; i < 2; ++i) v[i] = *(const float4*)(s2 + (size_t)(k2 + kk + 32 * i) * N2 + n2 + nn); }
            float tv[8];
#pragma unroll
            for (int i = 0; i < 8; ++i) tv[i] = tile[(kc + i) * 65 + n];
            if (win) {
                const float4 g0 = *(const float4*)(gvec + k0 + kc), g1 = *(const float4*)(gvec + k0 + kc + 4);
#pragma unroll
                for (int m = 0; m < 3; ++m) { const float* mr = (const float*)(ws + WS_MOD) + (size_t)(L * 3 + m) * MODW + modoff + k0 + kc;
                    const float4 h0 = *(const float4*)mr, h1 = *(const float4*)(mr + 4), c0 = *(const float4*)(mr + D), c1 = *(const float4*)(mr + D + 4);
                    uint4 w;
                    w.x = pk_bf16(tv[0] * (g0.x * (1.0f + c0.x)), tv[1] * (g0.y * (1.0f + c0.y))); w.y = pk_bf16(tv[2] * (g0.z * (1.0f + c0.z)), tv[3] * (g0.w * (1.0f + c0.w)));
                    w.z = pk_bf16(tv[4] * (g1.x * (1.0f + c1.x)), tv[5] * (g1.y * (1.0f + c1.y))); w.w = pk_bf16(tv[6] * (g1.z * (1.0f + c1.z)), tv[7] * (g1.w * (1.0f + c1.w)));
                    *(uint4*)(dst + ((size_t)m * Nw + n0 + n) * D + k0 + kc) = w;
                    bacc[m] += ((tv[0] * h0.x + tv[1] * h0.y) + (tv[2] * h0.z + tv[3] * h0.w)) + ((tv[4] * h1.x + tv[5] * h1.y) + (tv[6] * h1.z + tv[7] * h1.w)); }
            } else {
                uint4 w;
                w.x = pk_bf16(tv[0], tv[1]); w.y = pk_bf16(tv[2], tv[3]); w.z = pk_bf16(tv[4], tv[5]); w.w = pk_bf16(tv[6], tv[7]);
                *(uint4*)(dst + (size_t)(n0 + n) * D + k0 + kc) = w; }
            __syncthreads();
        }
        if (win) {
            const int t0 = t0_ - (isq ? 960 : 0), n0 = (t0 >> 4) * 64, half = (t0 >> 3) & 1; float* bp_ = (float*)(ws + (isq ? WS_BIASP2 : WS_BIASP));
#pragma unroll
            for (int m = 0; m < 3; ++m) { float b = bacc[m]; b += __shfl_xor(b, 1); b += __shfl_xor(b, 2); b += __shfl_xor(b, 4);
                if ((tid & 7) == 0) bp_[((size_t)(L * 3 + m) * 2 + half) * Nw + n0 + n] = b; }
        }
    }
}
__device__ __forceinline__ void deferred_drain(const P& p, int L, LAS unsigned char* lds, int quota) {
    if (L >= DEPTH) return;
    volatile LAS unsigned* st = (volatile LAS unsigned*)(lds + ST_OFF);
    unsigned* ctr = (unsigned*)(p.ws + WS_CTL) + 6144 + 64 * L;
    for (int n = 0; n < quota; ++n) {
        __syncthreads();
        if (threadIdx.x == 0) st[12] = __hip_atomic_fetch_add(ctr, 1u, __ATOMIC_RELAXED, __HIP_MEMORY_SCOPE_AGENT);
        __syncthreads();
        const int c = (int)st[12];
        if (c >= DEF_NCHUNK) break;
        deferred_chunk(p, L, c, lds);
    }
    __syncthreads();
}
__device__ __forceinline__ void phase_adaln(const P& p, LAS unsigned char* lds) {
    LAS float* sl = (LAS float*)lds; LAS float* part = sl + 3072;
    const int tid = otid(), wave = __builtin_amdgcn_readfirstlane(tid >> 6), lane = tid & 63;
    for (int i = tid; i < 3072; i += NTHR) { const int m = i >> 10, j = i & 1023; const float cv = (m < 2) ? p.c[m * 1024 + j] : p.c_ctx[j]; sl[i] = cv / (1.0f + __expf(-cv)); }
    __syncthreads();
    float* MOD = (float*)(p.ws + WS_MOD);
    const int rs = lane < 24 ? 0 : 1, c4 = lane < 24 ? lane : (lane < 48 ? lane - 24 : lane - 48);
    for (int item = blockIdx.x; item < DEPTH * 64; item += gridDim.x) {
        const int l = item >> 6, j0 = (item & 63) * 96;
        const float* W = p.ada_w + (size_t)l * D * MODW + j0 + 4 * c4 + (size_t)(wave * 128 + rs) * MODW;
        LAS const float* s0 = sl + wave * 128 + rs;
        float4 a0 = make_float4(0.f, 0.f, 0.f, 0.f), a1 = a0, a2 = a0;
#pragma unroll 16
        for (int i = 0; i < 64; ++i) { const float4 w = *(const float4*)(W + (size_t)(2 * i) * MODW); const float x0 = s0[2 * i], x1 = s0[1024 + 2 * i], x2 = s0[2048 + 2 * i];
            a0.x = fmaf(x0, w.x, a0.x); a0.y = fmaf(x0, w.y, a0.y); a0.z = fmaf(x0, w.z, a0.z); a0.w = fmaf(x0, w.w, a0.w);
            a1.x = fmaf(x1, w.x, a1.x); a1.y = fmaf(x1, w.y, a1.y); a1.z = fmaf(x1, w.z, a1.z); a1.w = fmaf(x1, w.w, a1.w);
            a2.x = fmaf(x2, w.x, a2.x); a2.y = fmaf(x2, w.y, a2.y); a2.z = fmaf(x2, w.z, a2.z); a2.w = fmaf(x2, w.w, a2.w); }
        if (lane < 48) { LAS float* pp = part + (size_t)((wave * 2 + rs) * 3) * 96 + 4 * c4;
            pp[0] = a0.x; pp[1] = a0.y; pp[2] = a0.z; pp[3] = a0.w; pp[96] = a1.x; pp[97] = a1.y; pp[98] = a1.z; pp[99] = a1.w; pp[192] = a2.x; pp[193] = a2.y; pp[194] = a2.z; pp[195] = a2.w; }
        __syncthreads();
        if (tid < 288) { const int m = tid / 96, c = tid - 96 * m; float sum = 0.f;
#pragma unroll
            for (int g = 0; g < 16; ++g) sum += part[(g * 3 + m) * 96 + c];
            MOD[(size_t)(l * 3 + m) * MODW + j0 + c] = sum + p.ada_b[l * MODW + j0 + c]; }
        __syncthreads();
    }
}
__device__ __forceinline__ void phase_norm(const P& p, int l, int which) {
    const float* g = (which ? p.norm2_g : p.norm1_g) + l * D;
    const float* mod = (const float*)(p.ws + WS_MOD) + (size_t)l * 3 * MODW + (which ? 3 * D : 0);
    const bf16_t* X = (const bf16_t*)(p.ws + WS_XRES); bf16_t* H = (bf16_t*)(p.ws + WS_H);
    const int lane = otid() & 63, gw = blockIdx.x * NWAVE + owave(), nw = gridDim.x * NWAVE;
    const int nrow = (which == 1 && l == DEPTH - 1) ? NLAT : NTOK;
    const bool first = (l == 0 && which == 0);
    for (int r = gw; r < nrow; r += nw) {
        const float* xr = r < NLAT ? p.x + (size_t)r * D : p.ctx + (size_t)(r - NLAT) * D; const bf16_t* xb = X + (size_t)r * D; const float* mr = mod + (size_t)row_sel(r) * MODW;
        float4 v[4]; float ss = 0.f;
#pragma unroll
        for (int i = 0; i < 4; ++i) { if (first) v[i] = *(const float4*)(xr + i * 256 + lane * 4); else { const uint2 w = *(const uint2*)(xb + i * 256 + lane * 4); v[i] = make_float4(bf_lo(w.x), bf_hi(w.x), bf_lo(w.y), bf_hi(w.y)); }
            ss += v[i].x * v[i].x + v[i].y * v[i].y + v[i].z * v[i].z + v[i].w * v[i].w; }
        ss = wave_sum(ss); const float rs = rsqrtf(ss * (1.0f / D) + EPS);
#pragma unroll
        for (int i = 0; i < 4; ++i) { const int col = i * 256 + lane * 4;
            const float4 gv = *(const float4*)(g + col), sh = *(const float4*)(mr + col), sc = *(const float4*)(mr + D + col);
            uint2 w; w.x = pk_bf16(v[i].x * rs * gv.x * (1.0f + sc.x) + sh.x, v[i].y * rs * gv.y * (1.0f + sc.y) + sh.y);
                     w.y = pk_bf16(v[i].z * rs * gv.z * (1.0f + sc.z) + sh.z, v[i].w * rs * gv.w * (1.0f + sc.w) + sh.w);
            *(uint2*)(H + (size_t)r * D + col) = w; }
    }
}
template <int C> __device__ __forceinline__ void fp4x3_pair_f(float x0, float x1, unsigned& a0, unsigned& a1, unsigned& a2) {
    a0 = __builtin_amdgcn_cvt_scalef32_pk_fp4_f32(a0, x0 * 0.5f, x1 * 0.5f, 1.0f, C);
    const auto q0 = __builtin_amdgcn_cvt_scalef32_pk_f32_fp4(a0, 1.0f, C);
    const float r0 = x0 - 2.0f * q0[0], r1 = x1 - 2.0f * q0[1];
    a1 = __builtin_amdgcn_cvt_scalef32_pk_fp4_f32(a1, r0 * 4.0f, r1 * 4.0f, 1.0f, C);
}
__device__ __forceinline__ void phase_norm2(const P& p, int l) {
    const float* g = p.norm2_g + l * D;
    const float* mod = (const float*)(p.ws + WS_MOD) + (size_t)l * 3 * MODW + 3 * D;
    const bf16_t* X = (const bf16_t*)(p.ws + WS_XRES); bf16_t* H = (bf16_t*)(p.ws + WS_H); unsigned char* H4 = p.ws + WS_H4;
    const int lane = otid() & 63, gw = blockIdx.x * NWAVE + owave(), nw = gridDim.x * NWAVE;
    const int nrow = (l == DEPTH - 1) ? NLAT : NTOK;
    for (int r = gw; r < nrow; r += nw) {
        const bf16_t* xr = X + (size_t)r * D + lane * 16; const float* mr = mod + (size_t)row_sel(r) * MODW + lane * 16; const float* gr = g + lane * 16;
        float v[16]; float ss = 0.f;
#pragma unroll
        for (int i = 0; i < 4; ++i) { const uint2 w = ((const uint2*)xr)[i]; const float4 t = make_float4(bf_lo(w.x), bf_hi(w.x), bf_lo(w.y), bf_hi(w.y)); v[4 * i] = t.x; v[4 * i + 1] = t.y; v[4 * i + 2] = t.z; v[4 * i + 3] = t.w; ss += t.x * t.x + t.y * t.y + t.z * t.z + t.w * t.w; }
        ss = wave_sum(ss); const float rs = rsqrtf(ss * (1.0f / D) + EPS);
        unsigned hb[8], a0[2] = {0u, 0u}, a1[2] = {0u, 0u}, a2[2] = {0u, 0u};
#pragma unroll
        for (int i = 0; i < 4; ++i) { const float4 gv = ((const float4*)gr)[i], sh = ((const float4*)mr)[i], sc = ((const float4*)(mr + D))[i];
            v[4 * i] = v[4 * i] * rs * gv.x * (1.0f + sc.x) + sh.x; v[4 * i + 1] = v[4 * i + 1] * rs * gv.y * (1.0f + sc.y) + sh.y;
            v[4 * i + 2] = v[4 * i + 2] * rs * gv.z * (1.0f + sc.z) + sh.z; v[4 * i + 3] = v[4 * i + 3] * rs * gv.w * (1.0f + sc.w) + sh.w; }
#pragma unroll
        for (int i = 0; i < 8; ++i) hb[i] = pk_bf16(v[2 * i], v[2 * i + 1]);
        uint4* hw = (uint4*)(H + (size_t)r * D + lane * 16); hw[0] = make_uint4(hb[0], hb[1], hb[2], hb[3]); hw[1] = make_uint4(hb[4], hb[5], hb[6], hb[7]);
#pragma unroll
        for (int d = 0; d < 2; ++d) {
            fp4x3_pair_f<0>(bf_lo(hb[4 * d]), bf_hi(hb[4 * d]), a0[d], a1[d], a2[d]); fp4x3_pair_f<1>(bf_lo(hb[4 * d + 1]), bf_hi(hb[4 * d + 1]), a0[d], a1[d], a2[d]);
            fp4x3_pair_f<2>(bf_lo(hb[4 * d + 2]), bf_hi(hb[4 * d + 2]), a0[d], a1[d], a2[d]); fp4x3_pair_f<3>(bf_lo(hb[4 * d + 3]), bf_hi(hb[4 * d + 3]), a0[d], a1[d], a2[d]); }
        unsigned char* h4 = H4 + (size_t)r * 1536 + lane * 8;
        *(uint2*)(h4) = make_uint2(a0[0], a0[1]); *(uint2*)(h4 + 512) = make_uint2(a1[0], a1[1]);
    }
}
__device__ __forceinline__ void h4_rows(const P& p, int l, int first, int step, int nrow) {
    const float* g = p.norm2_g + l * D;
    const float* mod = (const float*)(p.ws + WS_MOD) + (size_t)l * 3 * MODW + 3 * D;
    const bf16_t* X = (const bf16_t*)(p.ws + WS_XRES); unsigned char* H4 = p.ws + WS_H4; const float* SS = (const float*)(p.ws + WS_SSP2);
    const int lane = otid() & 63;
    if (first >= nrow) return;
    float gm[16], sh[16]; int cur_sel = -1;
    uint4 xn[2]; float4 sn[4];
    { const uint4* xp = (const uint4*)(X + (size_t)first * D + lane * 16); xn[0] = xp[0]; xn[1] = xp[1]; const float4* sp = (const float4*)(SS + (size_t)first * 16); sn[0] = sp[0]; sn[1] = sp[1]; sn[2] = sp[2]; sn[3] = sp[3]; }
    for (int r = first; r < nrow; r += step) {
        const uint4 x0 = xn[0], x1 = xn[1]; const float4 p0 = sn[0], p1 = sn[1], p2 = sn[2], p3 = sn[3];
        { const int r2 = (r + step < nrow) ? r + step : r; const uint4* xp = (const uint4*)(X + (size_t)r2 * D + lane * 16); xn[0] = xp[0]; xn[1] = xp[1];
          const float4* sp = (const float4*)(SS + (size_t)r2 * 16); sn[0] = sp[0]; sn[1] = sp[1]; sn[2] = sp[2]; sn[3] = sp[3]; }
        const int sel = row_sel(r);
        if (sel != cur_sel) {
            cur_sel = sel; const float* mr = mod + (size_t)sel * MODW + lane * 16; const float* gr = g + lane * 16;
#pragma unroll
            for (int i = 0; i < 4; ++i) { const float4 gv = ((const float4*)gr)[i], s4 = ((const float4*)mr)[i], c4 = ((const float4*)(mr + D))[i];
                gm[4 * i] = gv.x * (1.0f + c4.x); gm[4 * i + 1] = gv.y * (1.0f + c4.y); gm[4 * i + 2] = gv.z * (1.0f + c4.z); gm[4 * i + 3] = gv.w * (1.0f + c4.w);
                sh[4 * i] = s4.x; sh[4 * i + 1] = s4.y; sh[4 * i + 2] = s4.z; sh[4 * i + 3] = s4.w; }
        }
        const float sq = (((p0.x + p0.y) + (p0.z + p0.w)) + ((p1.x + p1.y) + (p1.z + p1.w))) + (((p2.x + p2.y) + (p2.z + p2.w)) + ((p3.x + p3.y) + (p3.z + p3.w)));
        const float rs = __builtin_amdgcn_rsqf(sq * (1.0f / 1024.0f) + 1e-6f);
        float v[16]; { float a[8], b[8]; unpack8(x0, a); unpack8(x1, b);
#pragma unroll
            for (int j = 0; j < 8; ++j) { v[j] = a[j]; v[8 + j] = b[j]; } }
#pragma unroll
        for (int i = 0; i < 16; ++i) v[i] = fmaf(v[i] * rs, gm[i], sh[i]);
        unsigned hb[8], a0[2] = {0u, 0u}, a1[2] = {0u, 0u}, a2[2] = {0u, 0u};
#pragma unroll
        for (int i = 0; i < 8; ++i) hb[i] = pk_bf16(v[2 * i], v[2 * i + 1]);
#pragma unroll
        for (int d = 0; d < 2; ++d) {
            fp4x3_pair_f<0>(bf_lo(hb[4 * d]), bf_hi(hb[4 * d]), a0[d], a1[d], a2[d]); fp4x3_pair_f<1>(bf_lo(hb[4 * d + 1]), bf_hi(hb[4 * d + 1]), a0[d], a1[d], a2[d]);
            fp4x3_pair_f<2>(bf_lo(hb[4 * d + 2]), bf_hi(hb[4 * d + 2]), a0[d], a1[d], a2[d]); fp4x3_pair_f<3>(bf_lo(hb[4 * d + 3]), bf_hi(hb[4 * d + 3]), a0[d], a1[d], a2[d]); }
        unsigned char* h4 = H4 + (size_t)r * 1536 + lane * 8;
        *(uint2*)(h4) = make_uint2(a0[0], a0[1]); *(uint2*)(h4 + 512) = make_uint2(a1[0], a1[1]);
    }
}
__device__ __forceinline__ void phase_conv(const P& p, int l) {
    const bf16_t* PR = (const bf16_t*)(p.ws + WS_PROJ); bf16_t* Y = (bf16_t*)(p.ws + WS_YCAT);
    const int lane = otid() & 63, gw = blockIdx.x * NWAVE + owave(), nw = gridDim.x * NWAVE, ch = lane * 4;
    const float4 cw0 = *(const float4*)(p.conv_w + (size_t)(l * 3 + 0) * 256 + ch), cw1 = *(const float4*)(p.conv_w + (size_t)(l * 3 + 1) * 256 + ch), cw2 = *(const float4*)(p.conv_w + (size_t)(l * 3 + 2) * 256 + ch);
    const float4 og = *(const float4*)(p.out_norm_g + (size_t)l * D + ch);
    const int nblk = ((l == DEPTH - 1) ? NLAT : NTOK) / 4;
    for (int bk = gw; bk < nblk; bk += nw) {
        const int r0 = 4 * bk;
        int pos, len; if (r0 < NLAT) { pos = r0 & (T - 1); len = T; } else { pos = (r0 - NLAT) & (CTXL - 1); len = CTXL; }
        const bf16_t* pr = PR + (size_t)r0 * IN_W + ch;
        uint2 gb[4], gc[6], xi[6];
#pragma unroll
        for (int q = 0; q < 4; ++q) gb[q] = *(const uint2*)(pr + (size_t)q * IN_W + C_GB);
#pragma unroll
        for (int q = 0; q < 6; ++q) { const bool ok = (q == 0) ? (pos > 0) : ((q == 5) ? (pos + 4 < len) : true); const bf16_t* pq = pr + (ptrdiff_t)((ok ? q : 1) - 1) * IN_W;
            gc[q] = *(const uint2*)(pq + C_GC); xi[q] = *(const uint2*)(pq + C_XI);
            if (!ok) { gc[q] = make_uint2(0u, 0u); xi[q] = make_uint2(0u, 0u); } }
#pragma unroll
        for (int q = 0; q < 4; ++q) {
            const uint2 gcm = gc[q], xim = xi[q], gcc = gc[q + 1], xic = xi[q + 1], gcp = gc[q + 2], xip = xi[q + 2], gbq = gb[q];
            float y[4];
            y[0] = bf_lo(gbq.x) * (bf_lo(gcm.x) * bf_lo(xim.x) * cw0.x + bf_lo(gcc.x) * bf_lo(xic.x) * cw1.x + bf_lo(gcp.x) * bf_lo(xip.x) * cw2.x);
            y[1] = bf_hi(gbq.x) * (bf_hi(gcm.x) * bf_hi(xim.x) * cw0.y + bf_hi(gcc.x) * bf_hi(xic.x) * cw1.y + bf_hi(gcp.x) * bf_hi(xip.x) * cw2.y);
            y[2] = bf_lo(gbq.y) * (bf_lo(gcm.y) * bf_lo(xim.y) * cw0.z + bf_lo(gcc.y) * bf_lo(xic.y) * cw1.z + bf_lo(gcp.y) * bf_lo(xip.y) * cw2.z);
            y[3] = bf_hi(gbq.y) * (bf_hi(gcm.y) * bf_hi(xim.y) * cw0.w + bf_hi(gcc.y) * bf_hi(xic.y) * cw1.w + bf_hi(gcp.y) * bf_hi(xip.y) * cw2.w);
            float ss = y[0] * y[0] + y[1] * y[1] + y[2] * y[2] + y[3] * y[3];
            ss += __shfl_xor(ss, 1); ss += __shfl_xor(ss, 2); ss += __shfl_xor(ss, 4); ss += __shfl_xor(ss, 8);
            const float rs = rsqrtf(ss * (1.0f / 64.0f) + EPS);
            uint2 w; w.x = pk_bf16(y[0] * rs * og.x, y[1] * rs * og.y); w.y = pk_bf16(y[2] * rs * og.z, y[3] * rs * og.w);
            *(uint2*)(Y + (size_t)(r0 + q) * D + ch) = w;
        }
    }
}
typedef short s16x8_t __attribute__((ext_vector_type(8)));
typedef short s16x4_t __attribute__((ext_vector_type(4)));
typedef float f32x4_t __attribute__((ext_vector_type(4)));
typedef unsigned u32x4_t __attribute__((ext_vector_type(4)));
__device__ __forceinline__ float x4_max(float x) {
    auto s = __builtin_amdgcn_permlane16_swap(__float_as_uint(x), __float_as_uint(x), false, false); x = fmaxf(__uint_as_float(s[0]), __uint_as_float(s[1]));
    auto t = __builtin_amdgcn_permlane32_swap(__float_as_uint(x), __float_as_uint(x), false, false); return fmaxf(__uint_as_float(t[0]), __uint_as_float(t[1])); }
__device__ __forceinline__ float x4_sum(float x) {
    auto s = __builtin_amdgcn_permlane16_swap(__float_as_uint(x), __float_as_uint(x), false, false); x = __uint_as_float(s[0]) + __uint_as_float(s[1]);
    auto t = __builtin_amdgcn_permlane32_swap(__float_as_uint(x), __float_as_uint(x), false, false); return __uint_as_float(t[0]) + __uint_as_float(t[1]); }
template <int OFF> __device__ __forceinline__ s16x4_t tr_read(unsigned vb) { s16x4_t r; asm volatile("ds_read_b64_tr_b16 %0, %1 offset:%2" : "=&v"(r) : "v"(vb), "i"(OFF) : "memory"); return r; }
constexpr int NA_VSTRIDE = 144;
constexpr int NA_NSLOT = 9;
constexpr int NA_CTX_ROW = NA_NSLOT * 64;
constexpr int NA_CK_OFF = (NA_CTX_ROW + 256) * NA_VSTRIDE;
constexpr int NA_RPB_OFF = NA_CK_OFF + 256 * 128;
static_assert(NA_RPB_OFF + 465 * 4 + 64 <= ST_OFF, "attention LDS image overlaps the control words");
__device__ __forceinline__ void phase_na(const P& p, int l, LAS unsigned char* lds) {
    const bf16_t* PR = (const bf16_t*)(p.ws + WS_PROJ); bf16_t* Y = (bf16_t*)(p.ws + WS_YCAT);
    const int tid = otid(), wave = __builtin_amdgcn_readfirstlane(tid >> 6), lane = tid & 63, g = lane >> 4, lq = lane & 15;
    LAS float* rpbl = (LAS float*)(lds + NA_RPB_OFF);
    const unsigned vbase = (unsigned)(uintptr_t)lds;
    const int G = (int)gridDim.x, per = (2048 + G - 1) / G, nctx_it = (l == DEPTH - 1) ? 0 : (32 + G - 1) / G;
    const int qt = wave & 3, rsel = wave >> 2;
    f32x4_t mk[2];
    { const int gc_ = qt * 16 + lq, cs_ = min(max(gc_ - 8, 0), 48), cw_ = min(max(qt * 16 - 8, 0), 32);
#pragma unroll
      for (int pq = 0; pq < 2; ++pq)
#pragma unroll
          for (int r = 0; r < 4; ++r) { const int col = cw_ + 16 * pq + 4 * g + r; mk[pq][r] = ((col >= cs_) && (col < cs_ + 16)) ? 0.f : -3.0e38f; } }
    int cur_b = -1, cur_h = -1, lo_row = 0, hi_row = 0;
    for (int it = 0; it < per + nctx_it; ++it) {
        bool isctx, valid; int b, h, gr0 = 0, hb = 0;
        if (it < per) { const int ul = (int)blockIdx.x * per + it; valid = ul < 2048; isctx = false; b = ul >> 10; h = (ul >> 7) & 7; gr0 = (ul & 127) * 2; }
        else { const int uc = (G - 1 - (int)blockIdx.x) + (it - per) * G;        valid = uc < 32; isctx = true; b = uc >> 4; h = (uc >> 1) & 7; hb = uc & 1; }
        if (!valid) continue;
        const int tokb = b * T, tokc = NLAT + b * CTXL;
        const int need_lo = min(max(gr0 - 4, 0), 248), need_hi = min(max(gr0 + 1 - 4, 0), 248) + 8;
        if (b != cur_b || h != cur_h) {
#pragma unroll
            for (int c = tid; c < 256 * 8; c += NTHR) { const int R = c >> 3, ch = c & 7;
                const u32x4_t v = *(const u32x4_t*)(PR + (size_t)(tokc + R) * IN_W + C_V + h * 64 + ch * 8), k = *(const u32x4_t*)(PR + (size_t)(tokc + R) * IN_W + C_K + h * 64 + ch * 8);
                *(LAS u32x4_t*)(lds + (NA_CTX_ROW + R) * NA_VSTRIDE + ch * 16) = v; *(LAS u32x4_t*)(lds + NA_CK_OFF + R * 128 + 16 * (ch ^ ((R >> 1) & 7))) = k; }
            if (tid < 465) rpbl[tid] = p.na_rpb[(size_t)(l * 8 + h) * 465 + tid] * 1.44269504f;
            cur_b = b; cur_h = h; lo_row = 0; hi_row = 0;
        }
        if (!isctx) {
            for (int R = need_lo; R < need_hi; ++R)
                if (R < lo_row || R >= hi_row) { const u32x4_t v = *(const u32x4_t*)(PR + (size_t)(tokb + R * 64 + (tid >> 3)) * IN_W + C_V + h * 64 + (tid & 7) * 8);
                    *(LAS u32x4_t*)(lds + ((R % NA_NSLOT) * 64 + (tid >> 3)) * NA_VSTRIDE + (tid & 7) * 16) = v; }
            lo_row = need_lo; hi_row = need_hi;
        }
        asm volatile("s_waitcnt lgkmcnt(0)" ::: "memory"); __builtin_amdgcn_s_barrier(); asm volatile("" ::: "memory");
        int nx_lo = 0, nx_n = 0; u32x4_t vn0 = (u32x4_t){0u, 0u, 0u, 0u}, vn1 = vn0;
        if (!isctx && it + 1 < per) { const int ul1 = (int)blockIdx.x * per + it + 1;
            if (ul1 < 2048 && (ul1 >> 7) == (((int)blockIdx.x * per + it) >> 7)) { const int g1 = (ul1 & 127) * 2; const int nhi = min(max(g1 + 1 - 4, 0), 248) + 8;
                nx_lo = hi_row; nx_n = nhi - hi_row;
                if (nx_n > 0) vn0 = *(const u32x4_t*)(PR + (size_t)(tokb + nx_lo * 64 + (tid >> 3)) * IN_W + C_V + h * 64 + (tid & 7) * 8);
                if (nx_n > 1) vn1 = *(const u32x4_t*)(PR + (size_t)(tokb + (nx_lo + 1) * 64 + (tid >> 3)) * IN_W + C_V + h * 64 + (tid & 7) * 8); } }
        const int gr = gr0 + rsel, rs_ = min(max(gr - 4, 0), 248);
        const int tq = isctx ? (tokc + hb * 128 + wave * 16 + lq) : (tokb + gr * 64 + qt * 16 + lq);
        const int cw0 = min(max(qt * 16 - 8, 0), 32);
        const int tokl = tokb + rs_ * 64;
        const int qq = lq >> 2, pp4 = lq & 3;
        f32x4_t O[4]; float mrow = -3.0e38f, lrow = 0.f;
#pragma unroll
        for (int c = 0; c < 4; ++c) O[c] = (f32x4_t){0.f, 0.f, 0.f, 0.f};
        const bf16_t* qp = PR + (size_t)tq * IN_W + C_Q + h * 64 + g * 8;
        const s16x8_t qf0 = *(const s16x8_t*)qp, qf1 = *(const s16x8_t*)(qp + 32);
        s16x8_t kfa[8], kfb[8];
#pragma unroll
        for (int k8 = 0; k8 < 8; ++k8) asm volatile("" : "=v"(kfa[k8]), "=v"(kfb[k8]));
        if (!isctx) {
#pragma unroll
            for (int k8 = 0; k8 < 8; ++k8) { const int tk = tokl + (k8 >> 1) * 64 + cw0 + 16 * (k8 & 1) + lq; const bf16_t* kp = PR + (size_t)tk * IN_W + C_K + h * 64 + g * 8;
                kfa[k8] = *(const s16x8_t*)kp; kfb[k8] = *(const s16x8_t*)(kp + 32); } }
        __builtin_amdgcn_sched_barrier(0);
#define NA_TRRD(BUF, KB_) do { const int kb = (KB_); const int R0 = (ROW0_OF_KB_EXPR); \
                const unsigned a0 = vbase + (unsigned)((R0 + qq) * NA_VSTRIDE + pp4 * 8), a1 = a0 + 16 * NA_VSTRIDE; \
                vl[BUF][0] = tr_read<0>(a0); vl[BUF][1] = tr_read<32>(a0); vl[BUF][2] = tr_read<64>(a0); vl[BUF][3] = tr_read<96>(a0); \
                vh[BUF][0] = tr_read<0>(a1); vh[BUF][1] = tr_read<32>(a1); vh[BUF][2] = tr_read<64>(a1); vh[BUF][3] = tr_read<96>(a1); } while (0)
#define NA_MERGE_PV() do { \
            mx = x4_max(mx); \
            const float mnew = fmaxf(mrow, mx), resc = __builtin_amdgcn_exp2f(mrow - mnew); f32x4_t lsv = (f32x4_t){0.f, 0.f, 0.f, 0.f}; \
            f32x2_t nm2 = (f32x2_t){-mnew, -mnew}; asm volatile("" : "+v"(nm2)); const f32x4_t nm4 = (f32x4_t){nm2[0], nm2[1], nm2[0], nm2[1]}; \
            _Pragma("unroll") for (int kt = 0; kt < 16; ++kt) { f32x4_t d = sc[kt] + nm4; d[0] = __builtin_amdgcn_exp2f(d[0]); d[1] = __builtin_amdgcn_exp2f(d[1]); d[2] = __builtin_amdgcn_exp2f(d[2]); d[3] = __builtin_amdgcn_exp2f(d[3]); sc[kt] = d; lsv += d; } \
            float ls = (lsv[0] + lsv[1]) + (lsv[2] + lsv[3]); \
            ls = x4_sum(ls); lrow = lrow * resc + ls; mrow = mnew; \
            _Pragma("unroll") for (int c = 0; c < 4; ++c) O[c] = O[c] * resc; \
            s16x4_t vl[2][4], vh[2][4]; \
            NA_TRRD(0, 0); \
            _Pragma("unroll") for (int kb_ = 0; kb_ < 8; ++kb_) { \
                asm volatile("s_waitcnt lgkmcnt(0)" ::: "memory"); __builtin_amdgcn_sched_barrier(0); \
                if (kb_ < 7) NA_TRRD((kb_ + 1) & 1, kb_ + 1);                \
                s16x8_t pf; \
                { const unsigned u0 = pk_bf16(sc[2 * kb_][0], sc[2 * kb_][1]), u1 = pk_bf16(sc[2 * kb_][2], sc[2 * kb_][3]), u2 = pk_bf16(sc[2 * kb_ + 1][0], sc[2 * kb_ + 1][1]), u3 = pk_bf16(sc[2 * kb_ + 1][2], sc[2 * kb_ + 1][3]); \
                  pf = __builtin_bit_cast(s16x8_t, make_uint4(u0, u1, u2, u3)); } \
                O[0] = __builtin_amdgcn_mfma_f32_16x16x32_bf16(NA_PK(vl[kb_ & 1][0], vh[kb_ & 1][0]), pf, O[0], 0, 0, 0); \
                O[1] = __builtin_amdgcn_mfma_f32_16x16x32_bf16(NA_PK(vl[kb_ & 1][1], vh[kb_ & 1][1]), pf, O[1], 0, 0, 0); \
                O[2] = __builtin_amdgcn_mfma_f32_16x16x32_bf16(NA_PK(vl[kb_ & 1][2], vh[kb_ & 1][2]), pf, O[2], 0, 0, 0); \
                O[3] = __builtin_amdgcn_mfma_f32_16x16x32_bf16(NA_PK(vl[kb_ & 1][3], vh[kb_ & 1][3]), pf, O[3], 0, 0, 0); \
                __builtin_amdgcn_sched_barrier(0); } } while (0)
#define NA_PK(L, H) (s16x8_t){L[0], L[1], L[2], L[3], H[0], H[1], H[2], H[3]}
        {
            f32x4_t sc[16];
            const unsigned sw = (unsigned)((lq >> 1) & 7);
            const LAS unsigned char* ka = lds + NA_CK_OFF + lq * 128 + 16 * ((unsigned)g ^ sw); const LAS unsigned char* kb2 = lds + NA_CK_OFF + lq * 128 + 16 * ((unsigned)(4 + g) ^ sw);
#pragma unroll
            for (int q4 = 0; q4 < 4; ++q4) {
                s16x8_t c0[4], c1[4];
#pragma unroll
                for (int k4 = 0; k4 < 4; ++k4) { const int kt = q4 * 4 + k4; c0[k4] = *(const LAS s16x8_t*)(ka + 2048 * kt); c1[k4] = *(const LAS s16x8_t*)(kb2 + 2048 * kt); }
#pragma unroll
                for (int k4 = 0; k4 < 4; ++k4) { f32x4_t acc = (f32x4_t){0.f, 0.f, 0.f, 0.f};
                    acc = __builtin_amdgcn_mfma_f32_16x16x32_bf16(c0[k4], qf0, acc, 0, 0, 0);
                    acc = __builtin_amdgcn_mfma_f32_16x16x32_bf16(c1[k4], qf1, acc, 0, 0, 0);
                    sc[q4 * 4 + k4] = acc; }
            }
            float mx = -3.0e38f;
#pragma unroll
            for (int kt = 0; kt < 16; ++kt)
#pragma unroll
                for (int r = 0; r < 4; ++r) mx = fmaxf(mx, sc[kt][r]);
            mx *= 0.125f * 1.44269504f;
#pragma unroll
            for (int kt = 0; kt < 16; ++kt) sc[kt] = sc[kt] * (0.125f * 1.44269504f);
#define ROW0_OF_KB_EXPR (NA_CTX_ROW + 32 * kb + 4 * g)
            NA_MERGE_PV();
#undef ROW0_OF_KB_EXPR
        }
        if (!isctx) {
            f32x4_t sc[16];
#pragma unroll
            for (int k8 = 0; k8 < 8; ++k8) { f32x4_t acc = (f32x4_t){0.f, 0.f, 0.f, 0.f};
                acc = __builtin_amdgcn_mfma_f32_16x16x32_bf16(kfa[k8], qf0, acc, 0, 0, 0);
                acc = __builtin_amdgcn_mfma_f32_16x16x32_bf16(kfb[k8], qf1, acc, 0, 0, 0);
                sc[k8] = acc; }
            __builtin_amdgcn_sched_barrier(0);
#pragma unroll
            for (int k8 = 0; k8 < 8; ++k8) { const int kt = 8 + k8;
                const int tk = tokl + (kt >> 1) * 64 + cw0 + 16 * (kt & 1) + lq; const bf16_t* kp = PR + (size_t)tk * IN_W + C_K + h * 64 + g * 8;
                kfa[k8] = *(const s16x8_t*)kp; kfb[k8] = *(const s16x8_t*)(kp + 32); }
            __builtin_amdgcn_sched_barrier(0);
#pragma unroll
            for (int k8 = 0; k8 < 8; ++k8) { f32x4_t acc = (f32x4_t){0.f, 0.f, 0.f, 0.f};
                acc = __builtin_amdgcn_mfma_f32_16x16x32_bf16(kfa[k8], qf0, acc, 0, 0, 0);
                acc = __builtin_amdgcn_mfma_f32_16x16x32_bf16(kfb[k8], qf1, acc, 0, 0, 0);
                sc[8 + k8] = acc; }
            __builtin_amdgcn_sched_barrier(0);
            float mx = -3.0e38f;
            const int gc = qt * 16 + lq;
            const LAS float* rb_ = rpbl + ((rs_ - gr + 7) * 31 + (cw0 + 4 * g - gc + 15));
#pragma unroll
            for (int kq = 0; kq < 4; ++kq) {
                float bq[16];
#pragma unroll
                for (int e = 0; e < 16; ++e) { const int kt = 4 * kq + (e >> 2), r = e & 3; bq[e] = rb_[31 * (kt >> 1) + 16 * (kt & 1) + r]; }
                asm volatile("" : "+v"(bq[0]), "+v"(bq[1]), "+v"(bq[2]), "+v"(bq[3]), "+v"(bq[4]), "+v"(bq[5]), "+v"(bq[6]), "+v"(bq[7]),
                                  "+v"(bq[8]), "+v"(bq[9]), "+v"(bq[10]), "+v"(bq[11]), "+v"(bq[12]), "+v"(bq[13]), "+v"(bq[14]), "+v"(bq[15]));
#pragma unroll
                for (int e4 = 0; e4 < 4; ++e4) { const int kt = 4 * kq + e4;
                    const f32x4_t b4 = (f32x4_t){bq[4 * e4], bq[4 * e4 + 1], bq[4 * e4 + 2], bq[4 * e4 + 3]} + mk[kt & 1];
                    const f32x4_t sv = sc[kt] * (0.125f * 1.44269504f) + b4; sc[kt] = sv;
                    mx = fmaxf(fmaxf(mx, sv[0]), sv[1]); mx = fmaxf(fmaxf(mx, sv[2]), sv[3]); }
            }
#define ROW0_OF_KB_EXPR (((rs_ + kb) % NA_NSLOT) * 64 + cw0 + 4 * g)
            NA_MERGE_PV();
#undef ROW0_OF_KB_EXPR
        }
#undef NA_PK
#undef NA_MERGE_PV
#undef NA_TRRD
        { const float inv = 1.0f / lrow; float ss = 0.f;
#pragma unroll
          for (int c = 0; c < 4; ++c) { O[c] = O[c] * inv; ss += O[c][0] * O[c][0] + O[c][1] * O[c][1] + O[c][2] * O[c][2] + O[c][3] * O[c][3]; }
          ss = x4_sum(ss); const float rn = rsqrtf(ss * (1.0f / 64.0f) + EPS);
          const float* og = p.out_norm_g + (size_t)l * D + 512 + h * 64 + 4 * g; bf16_t* yp = Y + (size_t)tq * D + 512 + h * 64 + 4 * g;
#pragma unroll
          for (int c = 0; c < 4; ++c) { const float4 gv = *(const float4*)(og + 16 * c);
              uint2 w; w.x = pk_bf16(O[c][0] * rn * gv.x, O[c][1] * rn * gv.y); w.y = pk_bf16(O[c][2] * rn * gv.z, O[c][3] * rn * gv.w);
              *(uint2*)(yp + 16 * c) = w; } }
        asm volatile("s_waitcnt lgkmcnt(0)" ::: "memory"); __builtin_amdgcn_s_barrier(); asm volatile("" ::: "memory");
        if (nx_n > 0) *(LAS u32x4_t*)(lds + (((nx_lo) % NA_NSLOT) * 64 + (tid >> 3)) * NA_VSTRIDE + (tid & 7) * 16) = vn0;
        if (nx_n > 1) *(LAS u32x4_t*)(lds + (((nx_lo + 1) % NA_NSLOT) * 64 + (tid >> 3)) * NA_VSTRIDE + (tid & 7) * 16) = vn1;
        if (nx_n > 0) hi_row = nx_lo + nx_n;
    }
    __syncthreads();
}
__device__ __forceinline__ void phase_sgu(const P& p, int l, LAS unsigned char* lds) {
    const bf16_t* PR = (const bf16_t*)(p.ws + WS_PROJ); bf16_t* Y = (bf16_t*)(p.ws + WS_YCAT);
    const bf16_t* WB = (const bf16_t*)(p.ws + WS_SGUW) + (size_t)l * 4 * 128 * 128;
    const int tid = otid(), wave = __builtin_amdgcn_readfirstlane(tid >> 6), lane = tid & 63, g = lane >> 4, lq = lane & 15;
    const unsigned vbase = (unsigned)(uintptr_t)lds;
    const int nitem = (((l == DEPTH - 1) ? NLAT : NTOK) / 128) * 4;
    for (int item = blockIdx.x; item < nitem; item += gridDim.x) {
        const int chunk = item >> 2, grp = item & 3, row0 = chunk * 128;
        { const int tok = tid >> 2, cg = (tid & 3) * 16;
          const bf16_t* src = PR + (size_t)(row0 + tok) * IN_W + C_SV + grp * 64 + cg;
          float f[16]; { float a[8], b[8]; unpack8(((const uint4*)src)[0], a); unpack8(((const uint4*)src)[1], b);
#pragma unroll
              for (int j = 0; j < 8; ++j) { f[j] = gelu_tanh(a[j]); f[8 + j] = gelu_tanh(b[j]); } }
          float ss = 0.f;
#pragma unroll
          for (int j = 0; j < 16; ++j) ss += f[j] * f[j];
          ss += __shfl_xor(ss, 1); ss += __shfl_xor(ss, 2);
          const float rs = rsqrtf(ss * (1.0f / 64.0f) + EPS);
          const float* gn = p.sgu_norm_g + (size_t)l * 256 + grp * 64 + cg;
          unsigned o[8];
#pragma unroll
          for (int j = 0; j < 8; ++j) o[j] = pk_bf16(f[2 * j] * rs * gn[2 * j], f[2 * j + 1] * rs * gn[2 * j + 1]);
          LAS u32x4_t* dst = (LAS u32x4_t*)(lds + tok * NA_VSTRIDE + cg * 2);
          dst[0] = (u32x4_t){o[0], o[1], o[2], o[3]}; dst[1] = (u32x4_t){o[4], o[5], o[6], o[7]}; }
        __syncthreads();
        const int tokp = row0 + wave * 16 + lq;
        f32x4_t O[4];
#pragma unroll
        for (int c = 0; c < 4; ++c) O[c] = (f32x4_t){0.f, 0.f, 0.f, 0.f};
        const bf16_t* wp = WB + ((size_t)grp * 128 + wave * 16 + lq) * 128 + g * 8;
        const int qq = lq >> 2, pp4 = lq & 3;
#pragma unroll
        for (int ks = 0; ks < 4; ++ks) {
            const s16x8_t wf = *(const s16x8_t*)(wp + 32 * ks);
            const unsigned a0 = vbase + (unsigned)((32 * ks + 8 * g + qq) * NA_VSTRIDE + pp4 * 8), a1 = a0 + 4 * NA_VSTRIDE;
            const s16x4_t l0 = tr_read<0>(a0), l1 = tr_read<32>(a0), l2 = tr_read<64>(a0), l3 = tr_read<96>(a0);
            const s16x4_t h0 = tr_read<0>(a1), h1 = tr_read<32>(a1), h2 = tr_read<64>(a1), h3 = tr_read<96>(a1);
            asm volatile("s_waitcnt lgkmcnt(0)" ::: "memory"); __builtin_amdgcn_sched_barrier(0);
#define SG_PK(L, H) (s16x8_t){L[0], L[1], L[2], L[3], H[0], H[1], H[2], H[3]}
            O[0] = __builtin_amdgcn_mfma_f32_16x16x32_bf16(SG_PK(l0, h0), wf, O[0], 0, 0, 0);
            O[1] = __builtin_amdgcn_mfma_f32_16x16x32_bf16(SG_PK(l1, h1), wf, O[1], 0, 0, 0);
            O[2] = __builtin_amdgcn_mfma_f32_16x16x32_bf16(SG_PK(l2, h2), wf, O[2], 0, 0, 0);
            O[3] = __builtin_amdgcn_mfma_f32_16x16x32_bf16(SG_PK(l3, h3), wf, O[3], 0, 0, 0);
#undef SG_PK
        }
        const float bias = p.sgu_b[(size_t)(l * 4 + grp) * 128 + wave * 16 + lq];
        const bf16_t* up = PR + (size_t)tokp * IN_W + C_SU + grp * 64 + 4 * g;
        float ss = 0.f;
#pragma unroll
        for (int c = 0; c < 4; ++c) { const uint2 uu = *(const uint2*)(up + 16 * c);
            O[c][0] = gelu_tanh(bf_lo(uu.x)) * (O[c][0] + bias); O[c][1] = gelu_tanh(bf_hi(uu.x)) * (O[c][1] + bias);
            O[c][2] = gelu_tanh(bf_lo(uu.y)) * (O[c][2] + bias); O[c][3] = gelu_tanh(bf_hi(uu.y)) * (O[c][3] + bias);
            ss += O[c][0] * O[c][0] + O[c][1] * O[c][1] + O[c][2] * O[c][2] + O[c][3] * O[c][3]; }
        ss = x4_sum(ss); const float rn = rsqrtf(ss * (1.0f / 64.0f) + EPS);
        const float* og = p.out_norm_g + (size_t)l * D + 256 + grp * 64 + 4 * g; bf16_t* yp = Y + (size_t)tokp * D + 256 + grp * 64 + 4 * g;
#pragma unroll
        for (int c = 0; c < 4; ++c) { const float4 gv = *(const float4*)(og + 16 * c);
            uint2 w; w.x = pk_bf16(O[c][0] * rn * gv.x, O[c][1] * rn * gv.y); w.y = pk_bf16(O[c][2] * rn * gv.z, O[c][3] * rn * gv.w);
            *(uint2*)(yp + 16 * c) = w; }
        __syncthreads();
    }
}
__device__ __forceinline__ float vmaxf(float a, float b) { float r; asm("v_max_f32 %0, %1, %2" : "=v"(r) : "v"(a), "v"(b)); return r; }
__device__ __forceinline__ float vminf(float a, float b) { float r; asm("v_min_f32 %0, %1, %2" : "=v"(r) : "v"(a), "v"(b)); return r; }
__device__ __forceinline__ float vmed3f(float a, float b, float c) { float r; asm("v_med3_f32 %0, %1, %2, %3" : "=v"(r) : "v"(a), "v"(b), "v"(c)); return r; }
template <int A, int B> __device__ __forceinline__ void ce_desc(float (&v)[16]) { const float x = v[A], y = v[B]; v[A] = vmaxf(x, y); v[B] = vminf(x, y); }
__device__ __forceinline__ void sort16_desc(float (&v)[16]) {
    ce_desc<0, 13>(v); ce_desc<1, 12>(v); ce_desc<2, 15>(v); ce_desc<3, 14>(v); ce_desc<4, 8>(v); ce_desc<5, 6>(v); ce_desc<7, 11>(v); ce_desc<9, 10>(v);
    ce_desc<0, 5>(v); ce_desc<1, 7>(v); ce_desc<2, 9>(v); ce_desc<3, 4>(v); ce_desc<6, 13>(v); ce_desc<8, 14>(v); ce_desc<10, 15>(v); ce_desc<11, 12>(v);
    ce_desc<0, 1>(v); ce_desc<2, 3>(v); ce_desc<4, 5>(v); ce_desc<6, 8>(v); ce_desc<7, 9>(v); ce_desc<10, 11>(v); ce_desc<12, 13>(v); ce_desc<14, 15>(v);
    ce_desc<0, 2>(v); ce_desc<1, 3>(v); ce_desc<4, 10>(v); ce_desc<5, 11>(v); ce_desc<6, 7>(v); ce_desc<8, 9>(v); ce_desc<12, 14>(v); ce_desc<13, 15>(v);
    ce_desc<1, 2>(v); ce_desc<3, 12>(v); ce_desc<4, 6>(v); ce_desc<5, 7>(v); ce_desc<8, 10>(v); ce_desc<9, 11>(v); ce_desc<13, 14>(v);
    ce_desc<1, 4>(v); ce_desc<2, 6>(v); ce_desc<5, 8>(v); ce_desc<7, 10>(v); ce_desc<9, 13>(v); ce_desc<11, 14>(v);
    ce_desc<2, 4>(v); ce_desc<3, 6>(v); ce_desc<9, 12>(v); ce_desc<11, 13>(v);
    ce_desc<3, 5>(v); ce_desc<6, 8>(v); ce_desc<7, 9>(v); ce_desc<10, 12>(v);
    ce_desc<3, 4>(v); ce_desc<5, 6>(v); ce_desc<7, 8>(v); ce_desc<9, 10>(v); ce_desc<11, 12>(v);
    ce_desc<6, 7>(v); ce_desc<8, 9>(v);
}
template <int J, int I> __device__ __forceinline__ void bm_step(float (&v)[16]) { if constexpr ((I ^ J) > I) ce_desc<I, (I ^ J)>(v); }
template <int J, int... I> __device__ __forceinline__ void bm_layer(float (&v)[16], std::integer_sequence<int, I...>) { (bm_step<J, I>(v), ...); }
__device__ __forceinline__ void bmerge16_desc(float (&v)[16]) {
    using S = std::make_integer_sequence<int, 16>; bm_layer<8>(v, S{}); bm_layer<4>(v, S{}); bm_layer<2>(v, S{}); bm_layer<1>(v, S{}); }
template <int... I> __device__ __forceinline__ void mtop_(float (&A)[16], const float (&B)[16], std::integer_sequence<int, I...>) { ((A[I] = vmaxf(A[I], B[15 - I])), ...); }
__device__ __forceinline__ void merge_top16(float (&A)[16], const float (&B)[16]) {
    mtop_(A, B, std::make_integer_sequence<int, 16>{}); bmerge16_desc(A); }
constexpr int TK_ROW = 272;
__device__ __forceinline__ void phase_topk(const P& p, int l, LAS unsigned char* lds) {
    const bf16_t* Q = (const bf16_t*)(p.ws + WS_Q); const bf16_t* SK = (const bf16_t*)(p.ws + WS_SUBK) + (size_t)l * 8 * 2 * 128 * 128;
    int* PIDX = (int*)(p.ws + WS_PIDX); float* PG = (float*)(p.ws + WS_PG); float* PUS = (float*)(p.ws + WS_YCAT);
    const float* US = (const float*)(p.ws + WS_US) + (size_t)l * 16384; const float* VS = (const float*)(p.ws + WS_VS) + (size_t)l * 16384;
    const int tid = otid(), wave = __builtin_amdgcn_readfirstlane(tid >> 6), lane = tid & 63, g = lane >> 4, lq = lane & 15;
    const int h = (int)blockIdx.x & 7, ngrp = (int)gridDim.x >> 3, grp = (int)blockIdx.x >> 3;
    if (grp < ngrp) {
        const u32x4_t* src = (const u32x4_t*)(SK + (size_t)h * 2 * 128 * 128);
#pragma unroll
        for (int c = tid; c < 256 * 16; c += NTHR) { const int row = c >> 4, ch = c & 15; *(LAS u32x4_t*)(lds + row * TK_ROW + ch * 16) = src[c]; }
    }
    __syncthreads();
    const int wid = wave * ngrp + grp, nwid = ngrp * NWAVE;
    const int h4_nrow = (l == DEPTH - 1) ? NLAT : NTOK;
    if (wave < 4) h4_rows(p, l, (int)blockIdx.x * NWAVE + wave, (int)gridDim.x * NWAVE, h4_nrow);
    s16x8_t qn[2][4];
    { const int t0 = (grp < ngrp && wid < NTOK / 16) ? wid : 0; const bf16_t* qp = Q + (size_t)(t0 * 16 + lq) * QW + h * 256 + g * 8;
#pragma unroll
      for (int pp = 0; pp < 2; ++pp)
#pragma unroll
          for (int ks = 0; ks < 4; ++ks) qn[pp][ks] = *(const s16x8_t*)(qp + pp * 128 + 32 * ks); }
    const int ntile = ((l == DEPTH - 1) ? NLAT : NTOK) / 16;
    for (int tile0 = (grp < ngrp ? wid : NTOK); tile0 < ntile; tile0 += 4 * nwid) {
        float top0[16], top1[16];
#pragma unroll
        for (int i = 0; i < 16; ++i) { top0[i] = 0.f; top1[i] = 0.f; }
        for (int j = 0; j < 4; ++j) {
            const int tile = tile0 + j * nwid;
            if (tile >= ntile) break;
            s16x8_t qc[2][4];
#pragma unroll
            for (int pp = 0; pp < 2; ++pp)
#pragma unroll
                for (int ks = 0; ks < 4; ++ks) qc[pp][ks] = qn[pp][ks];
            { const int tn = (tile + nwid < ntile) ? tile + nwid : tile; const bf16_t* qp = Q + (size_t)(tn * 16 + lq) * QW + h * 256 + g * 8;
#pragma unroll
              for (int pp = 0; pp < 2; ++pp)
#pragma unroll
                  for (int ks = 0; ks < 4; ++ks) qn[pp][ks] = *(const s16x8_t*)(qp + pp * 128 + 32 * ks); }
            float own[2][16];
            s16x8_t fr[2][8];
#define TK_RD(STEP, F) do { _Pragma("unroll") for (int t_ = 0; t_ < 2; ++t_) { const LAS unsigned char* kp_ = lds + (((STEP) >> 2) * 128 + (2 * ((STEP) & 3) + t_) * 16 + lq) * TK_ROW + g * 16; \
                _Pragma("unroll") for (int ks = 0; ks < 4; ++ks) F[t_ * 4 + ks] = *(const LAS s16x8_t*)(kp_ + 64 * ks); } } while (0)
            TK_RD(0, fr[0]);
            __builtin_amdgcn_sched_barrier(0);
#pragma unroll
            for (int pp = 0; pp < 2; ++pp) {
                float sc[32];
#pragma unroll
                for (int s2 = 0; s2 < 4; ++s2) {
                    const int step = pp * 4 + s2;
                    if (step < 7) TK_RD(step + 1, fr[(step + 1) & 1]);
                    __builtin_amdgcn_sched_barrier(0);
                    f32x4_t acc0 = (f32x4_t){0.f, 0.f, 0.f, 0.f}, acc1 = (f32x4_t){0.f, 0.f, 0.f, 0.f};
#pragma unroll
                    for (int ks = 0; ks < 4; ++ks) { acc0 = __builtin_amdgcn_mfma_f32_16x16x32_bf16(fr[step & 1][ks], qc[pp][ks], acc0, 0, 0, 0);
                                                     acc1 = __builtin_amdgcn_mfma_f32_16x16x32_bf16(fr[step & 1][4 + ks], qc[pp][ks], acc1, 0, 0, 0); }
#pragma unroll
                    for (int r = 0; r < 4; ++r) { sc[s2 * 8 + r] = __uint_as_float((__float_as_uint(acc0[r]) & ~127u) | (unsigned)(s2 * 32 + 4 * g + r));
                                                  sc[s2 * 8 + 4 + r] = __uint_as_float((__float_as_uint(acc1[r]) & ~127u) | (unsigned)(s2 * 32 + 16 + 4 * g + r)); }
                    __builtin_amdgcn_sched_barrier(0);
                }
                float A[16], B[16];
#pragma unroll
                for (int i = 0; i < 16; ++i) { A[i] = sc[i]; B[i] = sc[16 + i]; }
                sort16_desc(A); sort16_desc(B);
                merge_top16(A, B);
#pragma unroll
                for (int i = 0; i < 16; ++i) own[pp][i] = A[i];
            }
#undef TK_RD
            float X[16], Y[16];
#pragma unroll
            for (int i = 0; i < 16; ++i) { auto r = __builtin_amdgcn_permlane16_swap(__float_as_uint(own[0][i]), __float_as_uint(own[1][i]), false, false); X[i] = __uint_as_float(r[0]); Y[i] = __uint_as_float(r[1]); }
            merge_top16(X, Y);
#pragma unroll
            for (int i = 0; i < 16; ++i) { auto r = __builtin_amdgcn_permlane32_swap(__float_as_uint(X[i]), __float_as_uint(X[i]), false, false); X[i] = __uint_as_float(r[0]); Y[i] = __uint_as_float(r[1]); }
            merge_top16(X, Y);
            const bool mine = (g == j);
#pragma unroll
            for (int i = 0; i < 16; ++i) { auto r = __builtin_amdgcn_permlane16_swap(__float_as_uint(X[i]), __float_as_uint(X[i]), false, false);
                top0[i] = mine ? __uint_as_float(r[0]) : top0[i]; top1[i] = mine ? __uint_as_float(r[1]) : top1[i]; }
        }
        const int mytile = tile0 + g * nwid, tok = mytile * 16 + lq;
        unsigned ia7[16], jb[16];
#pragma unroll
        for (int i = 0; i < 16; ++i) { ia7[i] = (__float_as_uint(top0[i]) & 127u) << 7; jb[i] = __float_as_uint(top1[i]) & 127u; }
#define CAND(a, b) __uint_as_float((__float_as_uint(top0[a] + top1[b]) & ~16383u) | (ia7[a] | jb[b]))
        float L0[16], L1[16], L2[16], L3[16];
#pragma unroll
        for (int i = 0; i < 16; ++i) L0[i] = CAND(0, i);
#pragma unroll
        for (int i = 0; i < 8; ++i) L1[i] = CAND(1, i);
#pragma unroll
        for (int i = 8; i < 16; ++i) L1[i] = -3.0e38f;
        L2[0] = CAND(2, 0); L2[1] = CAND(2, 1); L2[2] = CAND(2, 2); L2[3] = CAND(2, 3); L2[4] = CAND(2, 4); L2[5] = CAND(3, 0); L2[6] = CAND(3, 1); L2[7] = CAND(3, 2);
        L2[8] = CAND(3, 3); L2[9] = CAND(4, 0); L2[10] = CAND(4, 1); L2[11] = CAND(4, 2); L2[12] = CAND(5, 0); L2[13] = CAND(5, 1); L2[14] = CAND(6, 0); L2[15] = CAND(6, 1);
        {
          float S[9]; const float x71 = CAND(7, 1);
#pragma unroll
          for (int i = 0; i < 9; ++i) S[i] = CAND(7 + i, 0);
          L3[0] = S[0];
#pragma unroll
          for (int i = 1; i < 9; ++i) L3[i] = vmed3f(S[i - 1], S[i], x71);
          L3[9] = vminf(S[8], x71); }
#pragma unroll
        for (int i = 10; i < 16; ++i) L3[i] = -3.0e38f;
#undef CAND
        sort16_desc(L2);
        merge_top16(L0, L1); merge_top16(L2, L3); merge_top16(L0, L2);
        float e[16], sum = 0.f; const float mx = __uint_as_float(__float_as_uint(L0[0]) & ~16383u);
#pragma unroll
        for (int i = 0; i < 16; ++i) { e[i] = __expf(__uint_as_float(__float_as_uint(L0[i]) & ~16383u) - mx); sum += e[i]; }
        const float inv = 1.0f / sum;
        if (mytile < ntile) {
            int* ip = PIDX + (size_t)tok * 128 + h * 16; float* gp = PG + (size_t)tok * 128 + h * 16; float* up = PUS + (size_t)tok * 128 + h * 16;
#pragma unroll
            for (int i = 0; i < 4; ++i) {
                const int ea = (int)(__float_as_uint(L0[4 * i]) & 16383u), eb = (int)(__float_as_uint(L0[4 * i + 1]) & 16383u), ec = (int)(__float_as_uint(L0[4 * i + 2]) & 16383u), ed = (int)(__float_as_uint(L0[4 * i + 3]) & 16383u);
                *(int4*)(ip + 4 * i) = make_int4((int)((pk_bf16(0.f, US[ea]) & 0xffff0000u) | (unsigned)ea), (int)((pk_bf16(0.f, US[eb]) & 0xffff0000u) | (unsigned)eb),
                                                 (int)((pk_bf16(0.f, US[ec]) & 0xffff0000u) | (unsigned)ec), (int)((pk_bf16(0.f, US[ed]) & 0xffff0000u) | (unsigned)ed));
                *(float4*)(gp + 4 * i) = make_float4(e[4 * i] * inv * VS[ea], e[4 * i + 1] * inv * VS[eb], e[4 * i + 2] * inv * VS[ec], e[4 * i + 3] * inv * VS[ed]);
}
        }
    }
    if (wave >= 4) h4_rows(p, l, (int)blockIdx.x * NWAVE + wave, (int)gridDim.x * NWAVE, h4_nrow);
}
template <int CTRL> __device__ __forceinline__ float dppf(float x) { return __builtin_bit_cast(float, __builtin_amdgcn_mov_dpp(__builtin_bit_cast(int, x), CTRL, 0xf, 0xf, true)); }
struct PeerGeom { int slice_lo, nslice, wid, nworkers; };
__device__ __forceinline__ PeerGeom peer_geom(LAS unsigned char* lds, int wave) {
    volatile LAS unsigned* st = (volatile LAS unsigned*)(lds + ST_OFF);
    const unsigned nx = st[1], rank = st[4], dense = st[6], base = st[7], total = st[8];
    PeerGeom g;
    if (nx == 8u && total > 0u && base + rank < total) { g.slice_lo = (int)(dense & 3u); g.nslice = 1; g.wid = (int)(base + rank) * NWAVE + wave; g.nworkers = (int)total * NWAVE; }
    else { g.slice_lo = 0; g.nslice = 4; g.wid = (int)blockIdx.x * NWAVE + wave; g.nworkers = (int)gridDim.x * NWAVE; }
    return g;
}
template <bool VP> struct PeerRaw { int2 e2; float2 g2; uint4 h[4]; };
template <bool VP> __device__ __forceinline__ void peer_load_raw(PeerRaw<VP>& R, int t, int lane, int colbase, const int* PIDX, const float* PG, const float* UP, const bf16_t* H) {
    R.e2 = *(const int2*)(PIDX + (size_t)t * 128 + 2 * lane);
    if (VP) R.g2 = *(const float2*)(PG + (size_t)t * 128 + 2 * lane);
    if (!VP) { const uint4* hp = (const uint4*)(H + (size_t)t * D + colbase); R.h[0] = hp[0]; R.h[1] = hp[1]; R.h[2] = hp[2]; R.h[3] = hp[3]; }
}
template <bool VP> __device__ __forceinline__ void peer_stage(const PeerRaw<VP>& R, LAS float* lw, int lane, int rg, int (&E)[16], float (&W)[16]) {
    *(LAS f32x2_t*)(lw + 2 * lane) = (f32x2_t){__int_as_float(R.e2.x), __int_as_float(R.e2.y)};
    if (VP) *(LAS f32x2_t*)(lw + 128 + 2 * lane) = (f32x2_t){R.g2.x, R.g2.y};
    __builtin_amdgcn_wave_barrier();
#pragma unroll
    for (int i = 0; i < 4; ++i) { const f32x4_t v = *(LAS f32x4_t*)(lw + 16 * rg + 4 * i); E[4 * i] = __float_as_int(v[0]); E[4 * i + 1] = __float_as_int(v[1]); E[4 * i + 2] = __float_as_int(v[2]); E[4 * i + 3] = __float_as_int(v[3]); }
    if (VP) {
#pragma unroll
        for (int i = 0; i < 4; ++i) { const f32x4_t v = *(LAS f32x4_t*)(lw + 128 + 16 * rg + 4 * i); W[4 * i] = v[0]; W[4 * i + 1] = v[1]; W[4 * i + 2] = v[2]; W[4 * i + 3] = v[3]; } }
    __builtin_amdgcn_wave_barrier();
}
__device__ __forceinline__ void unpack32_bf16(const uint4 (&h)[4], float (&f)[32]) {
#pragma unroll
    for (int i = 0; i < 4; ++i) { float a[8]; unpack8(h[i], a);
#pragma unroll
        for (int j = 0; j < 8; ++j) f[8 * i + j] = a[j]; }
}
typedef _Float16 h2_t __attribute__((ext_vector_type(2)));
__device__ __forceinline__ void cvt32_fp4_h2(const u32x4_t w, h2_t (&f)[16]) {
#pragma unroll
    for (int d = 0; d < 4; ++d) {
        f[4 * d + 0] = __builtin_bit_cast(h2_t, __builtin_amdgcn_cvt_scalef32_pk_f16_fp4(w[d], 1.0f, 0)); f[4 * d + 1] = __builtin_bit_cast(h2_t, __builtin_amdgcn_cvt_scalef32_pk_f16_fp4(w[d], 1.0f, 1));
        f[4 * d + 2] = __builtin_bit_cast(h2_t, __builtin_amdgcn_cvt_scalef32_pk_f16_fp4(w[d], 1.0f, 2)); f[4 * d + 3] = __builtin_bit_cast(h2_t, __builtin_amdgcn_cvt_scalef32_pk_f16_fp4(w[d], 1.0f, 3)); }
}
__device__ __forceinline__ void pack32_h2(const float (&f)[32], h2_t (&h)[16]) {
#pragma unroll
    for (int i = 0; i < 16; ++i) h[i] = __builtin_bit_cast(h2_t, __builtin_amdgcn_cvt_pkrtz(f[2 * i], f[2 * i + 1]));
}
constexpr int PEER_STAGE_OFF = 131072 + 1024;
template <bool VP> __device__ __forceinline__ void peer_rows4(const u32x4_t (&r)[4], int i0, const h2_t (&hf)[16], const float (&W)[16], float (&acc)[16], h2_t (&acc2)[16]) {
#pragma unroll
    for (int k = 0; k < 4; ++k) { h2_t f[16]; cvt32_fp4_h2(r[k], f);
        if (VP) { const h2_t wk = __builtin_bit_cast(h2_t, __builtin_amdgcn_cvt_pkrtz(W[i0 + k], W[i0 + k]));
#pragma unroll
            for (int j = 0; j < 16; ++j) acc2[j] = f[j] * wk + acc2[j];
            asm volatile("" : "+v"(acc2[0]), "+v"(acc2[1]), "+v"(acc2[2]), "+v"(acc2[3]), "+v"(acc2[4]), "+v"(acc2[5]), "+v"(acc2[6]), "+v"(acc2[7]), "+v"(acc2[8]), "+v"(acc2[9]), "+v"(acc2[10]), "+v"(acc2[11]), "+v"(acc2[12]), "+v"(acc2[13]), "+v"(acc2[14]), "+v"(acc2[15]));
        } else { h2_t d0 = {0, 0}, d1 = d0, d2 = d0, d3 = d0;
#pragma unroll
            for (int j = 0; j < 4; ++j) { d0 = f[j] * hf[j] + d0; d1 = f[4 + j] * hf[4 + j] + d1; d2 = f[8 + j] * hf[8 + j] + d2; d3 = f[12 + j] * hf[12 + j] + d3; }
            const h2_t dd = (d0 + d1) + (d2 + d3);
            float d = (float)dd.x + (float)dd.y;
            asm volatile("" : "+v"(d)); acc[i0 + k] = d; } }
}
typedef unsigned u32x2_t __attribute__((ext_vector_type(2)));
__device__ __forceinline__ void ld8_nowait(u32x2_t& d, const void* q) { asm volatile("global_load_dwordx2 %0, %1, off" : "=v"(d) : "v"(q) : "memory"); }
__device__ __forceinline__ void ld16_nowait(u32x4_t& d, const void* q) { asm volatile("global_load_dwordx4 %0, %1, off" : "=v"(d) : "v"(q) : "memory"); }
template <bool VP> __device__ __forceinline__ void phase_peer(const P& p, int l, LAS unsigned char* lds) {
    const int tid = otid(), wave = __builtin_amdgcn_readfirstlane(tid >> 6), lane = tid & 63, rg = lane >> 3, pc = lane & 7;
    const bool last = (l == DEPTH - 1); const int ntok = last ? NLAT : NTOK;
    const unsigned char* T4 = p.ws + (VP ? WS_VT : WS_UT) + (size_t)l * 16384 * 512;
    const int* PIDX = (const int*)(p.ws + WS_PIDX); const float* PG = (const float*)(p.ws + (VP ? WS_PG : WS_YCAT)); const bf16_t* H = (const bf16_t*)(p.ws + WS_H);
    float* UP = (float*)(p.ws + WS_PROJ); bf16_t* X = (bf16_t*)(p.ws + WS_XRES); const float* MOD = (const float*)(p.ws + WS_MOD);
    LAS float* lwb = (LAS float*)(lds + PEER_STAGE_OFF + wave * 2048);
    LAS unsigned char* ring = lds + wave * 16384;
    const PeerGeom G = peer_geom(lds, wave);
    const bool b3 = (lane & 8) != 0, b2 = (lane & 4) != 0, b1 = (lane & 2) != 0, b0 = (lane & 1) != 0;
    for (int si = 0; si < G.nslice; ++si) {
        const int s = G.slice_lo + si, colbase = 256 * s + 32 * pc;
        if (G.wid >= ntok) continue;
        const int ntk = (ntok - 1 - G.wid) / G.nworkers + 1;
        const unsigned char* T4c = T4 + 128 * s + 16 * pc;
        PeerRaw<VP> R; int E0[16], En[16]; float W[16], Wn[16]; h2_t hf[16], hfn[16];
#pragma unroll
        for (int i = 0; i < 16; ++i) { W[i] = 0.f; Wn[i] = 0.f; hf[i] = (h2_t){0, 0}; hfn[i] = (h2_t){0, 0}; }
        peer_load_raw<VP>(R, G.wid, lane, colbase, PIDX, PG, UP, H);
        if (!VP) { float t32[32]; unpack32_bf16(R.h, t32); pack32_h2(t32, hf); }
        peer_stage<VP>(R, lwb, lane, rg, E0, W);
#pragma unroll
        for (int i = 0; i < 16; ++i) __builtin_amdgcn_global_load_lds((const unsigned*)(T4c + ((unsigned)E0[i] << 9)), (LAS unsigned*)(ring + i * 1024), 16, 0, 0);
        { const int t1 = G.wid + ((1 < ntk) ? 1 : 0) * G.nworkers; peer_load_raw<VP>(R, t1, lane, colbase, PIDX, PG, UP, H); }
        if (!VP) { float t32[32]; unpack32_bf16(R.h, t32); pack32_h2(t32, hfn); }
        peer_stage<VP>(R, lwb + 256, lane, rg, En, Wn);
        for (int j = 0; j < ntk; ++j) {
            const int t = G.wid + j * G.nworkers;
            const int j2 = (j + 2 < ntk) ? j + 2 : ntk - 1; const int t2 = G.wid + j2 * G.nworkers;
            u32x2_t e2r, g2r = (u32x2_t){0u, 0u}; u32x4_t z4 = (u32x4_t){0u, 0u, 0u, 0u}, hr[4] = {z4, z4, z4, z4}, gvr = z4; u32x2_t xvr = (u32x2_t){0u, 0u};
            ld8_nowait(e2r, PIDX + (size_t)t2 * 128 + 2 * lane);
            if (VP) ld8_nowait(g2r, PG + (size_t)t2 * 128 + 2 * lane);
            else { const bf16_t* hp = H + (size_t)t2 * D + colbase; ld16_nowait(hr[0], hp); ld16_nowait(hr[1], hp + 8); ld16_nowait(hr[2], hp + 16); ld16_nowait(hr[3], hp + 24); }
            if (VP) { const int col = colbase + 4 * rg; ld8_nowait(xvr, X + (size_t)t * D + col); ld16_nowait(gvr, MOD + (size_t)(l * 3 + row_sel(t)) * MODW + 5 * D + col); }
            else { u32x2_t g8; ld8_nowait(g8, PG + (size_t)t * 128 + 2 * lane); gvr[0] = g8[0]; gvr[1] = g8[1]; }
            float acc[16]; h2_t acc2[16];
#pragma unroll
            for (int i = 0; i < 16; ++i) { acc[i] = 0.f; acc2[i] = (h2_t){0, 0}; }
#pragma unroll
            for (int g4 = 0; g4 < 4; ++g4) {
                __builtin_amdgcn_sched_barrier(0);
                asm volatile("s_waitcnt vmcnt(12)" ::: "memory");
                u32x4_t r[4];
#pragma unroll
                for (int k = 0; k < 4; ++k) r[k] = *(LAS u32x4_t*)(ring + (4 * g4 + k) * 1024 + lane * 16);
                asm volatile("s_waitcnt lgkmcnt(0)" ::: "memory");
#pragma unroll
                for (int k = 0; k < 4; ++k) __builtin_amdgcn_global_load_lds((const unsigned*)(T4c + ((unsigned)En[4 * g4 + k] << 9)), (LAS unsigned*)(ring + (4 * g4 + k) * 1024), 16, 0, 0);
                __builtin_amdgcn_sched_barrier(0);
                peer_rows4<VP>(r, 4 * g4, hf, W, acc, acc2);
            }
            __builtin_amdgcn_sched_barrier(0);
            asm volatile("s_waitcnt vmcnt(16)" : "+v"(e2r), "+v"(g2r), "+v"(xvr), "+v"(gvr), "+v"(hr[0]), "+v"(hr[1]), "+v"(hr[2]), "+v"(hr[3]) :: "memory");
            if (!VP) {
#pragma unroll
                for (int k = 0; k < 8; ++k) { const float tt = b2 ? acc[k + 8] : acc[k], ss = b2 ? acc[k] : acc[k + 8]; acc[k] = tt + dppf<0x141>(ss); }
#pragma unroll
                for (int k = 0; k < 4; ++k) { const float tt = b1 ? acc[k + 4] : acc[k], ss = b1 ? acc[k] : acc[k + 4]; acc[k] = tt + dppf<0x4E>(ss); }
#pragma unroll
                for (int k = 0; k < 2; ++k) { const float tt = b0 ? acc[k + 2] : acc[k], ss = b0 ? acc[k] : acc[k + 2]; acc[k] = tt + dppf<0xB1>(ss); }
                *(float2*)(UP + ((size_t)s * NTOK + t) * 128 + 2 * lane) = make_float2(acc[0] * __uint_as_float(gvr[0]), acc[1] * __uint_as_float(gvr[1]));
            } else {
                float av[32];
#pragma unroll
                for (int k = 0; k < 16; ++k) { av[2 * k] = (float)acc2[k].x; av[2 * k + 1] = (float)acc2[k].y; }
#pragma unroll
                for (int k = 0; k < 16; ++k) { auto r = __builtin_amdgcn_permlane32_swap(__float_as_uint(av[k]), __float_as_uint(av[k + 16]), false, false); av[k] = __uint_as_float(r[0]) + __uint_as_float(r[1]); }
#pragma unroll
                for (int k = 0; k < 8; ++k) { auto r = __builtin_amdgcn_permlane16_swap(__float_as_uint(av[k]), __float_as_uint(av[k + 8]), false, false); av[k] = __uint_as_float(r[0]) + __uint_as_float(r[1]); }
#pragma unroll
                for (int k = 0; k < 4; ++k) { const float tt = b3 ? av[k + 4] : av[k], ss = b3 ? av[k] : av[k + 4]; acc[k] = tt + dppf<0x128>(ss); }
                const int col = colbase + 4 * rg; uint2* xp = (uint2*)(X + (size_t)t * D + col);
                float4 xv = make_float4(bf_lo(xvr[0]), bf_hi(xvr[0]), bf_lo(xvr[1]), bf_hi(xvr[1]));
                xv.x = fmaf(__uint_as_float(gvr[0]), acc[0], xv.x); xv.y = fmaf(__uint_as_float(gvr[1]), acc[1], xv.y); xv.z = fmaf(__uint_as_float(gvr[2]), acc[2], xv.z); xv.w = fmaf(__uint_as_float(gvr[3]), acc[3], xv.w);
                *xp = make_uint2(pk_bf16(xv.x, xv.y), pk_bf16(xv.z, xv.w));
            }
#pragma unroll
            for (int i = 0; i < 16; ++i) W[i] = Wn[i];
            if (!VP) {
#pragma unroll
                for (int i = 0; i < 16; ++i) hf[i] = hfn[i]; }
            R.e2 = make_int2((int)e2r[0], (int)e2r[1]); R.g2 = make_float2(__uint_as_float(g2r[0]), __uint_as_float(g2r[1]));
            if (!VP) { const uint4 hh[4] = {make_uint4(hr[0][0], hr[0][1], hr[0][2], hr[0][3]), make_uint4(hr[1][0], hr[1][1], hr[1][2], hr[1][3]), make_uint4(hr[2][0], hr[2][1], hr[2][2], hr[2][3]), make_uint4(hr[3][0], hr[3][1], hr[3][2], hr[3][3])};
                float t32[32]; unpack32_bf16(hh, t32); pack32_h2(t32, hfn); }
            peer_stage<VP>(R, lwb + 256 * (j & 1), lane, rg, En, Wn);
        }
        asm volatile("s_waitcnt vmcnt(0)" ::: "memory");
    }
}
typedef int i32x8_t __attribute__((ext_vector_type(8)));
template <int C> __device__ __forceinline__ void fp4x3_pair(unsigned w, unsigned& a0, unsigned& a1, unsigned& a2) {
    const float x0 = bf_lo(w), x1 = bf_hi(w);
    a0 = __builtin_amdgcn_cvt_scalef32_pk_fp4_f32(a0, x0 * 0.5f, x1 * 0.5f, 1.0f, C);
    const f32x2_t q0 = __builtin_amdgcn_cvt_scalef32_pk_f32_fp4(a0, 1.0f, C);
    const float r0 = x0 - 2.0f * q0.x, r1 = x1 - 2.0f * q0.y;
    a1 = __builtin_amdgcn_cvt_scalef32_pk_fp4_f32(a1, r0 * 4.0f, r1 * 4.0f, 1.0f, C);
    const f32x2_t q1 = __builtin_amdgcn_cvt_scalef32_pk_f32_fp4(a1, 1.0f, C);
    a2 = __builtin_amdgcn_cvt_scalef32_pk_fp4_f32(a2, (r0 - 0.25f * q1.x) * 32.0f, (r1 - 0.25f * q1.y) * 32.0f, 1.0f, C);
}
__device__ __forceinline__ void h2_to_fp4x3(const u32x4_t (&raw)[4], i32x8_t& t0, i32x8_t& t1, i32x8_t& t2) {
#pragma unroll
    for (int d = 0; d < 4; ++d) { unsigned a0 = 0u, a1 = 0u, a2 = 0u;
        fp4x3_pair<0>(raw[d][0], a0, a1, a2); fp4x3_pair<1>(raw[d][1], a0, a1, a2); fp4x3_pair<2>(raw[d][2], a0, a1, a2); fp4x3_pair<3>(raw[d][3], a0, a1, a2);
        t0[d] = (int)a0; t1[d] = (int)a1; t2[d] = (int)a2; t0[4 + d] = 0; t1[4 + d] = 0; t2[4 + d] = 0; }
}
__device__ __forceinline__ void phase_peer_u(const P& p, int l, LAS unsigned char* lds) {
    const int tid = otid(), wave = __builtin_amdgcn_readfirstlane(tid >> 6), lane = tid & 63, r16 = lane & 15, kq = lane >> 4;
    const bool last = (l == DEPTH - 1); const int ntok = last ? NLAT : NTOK;
    const unsigned char* T4 = p.ws + WS_UT + (size_t)l * 16384 * 512;
    const unsigned char* PIDXb = p.ws + WS_PIDX; const unsigned char* PUSb = p.ws + WS_YCAT; const unsigned char* H4 = p.ws + WS_H4;
    float* UP = (float*)(p.ws + WS_PROJ);
    LAS unsigned char* meta = lds + PEER_STAGE_OFF + wave * 2560;
    LAS unsigned char* ring = lds + wave * 16384;
    const PeerGeom G = peer_geom(lds, wave);
    const int isel = r16 & 3;
    const int dm = lane >> 3, di = lane & 7;
    const int pc0 = (di - (dm >> 1)) & 7, pc1 = (di - (dm >> 1) - 4) & 7;
    const int rm = r16 & 7, rsl = r16 >> 3;
    const int rd0 = (8 * rm + ((kq + (rm >> 1) + 4 * rsl) & 7)) * 16, rd1 = (8 * rm + ((kq + 4 + (rm >> 1) + 4 * rsl) & 7)) * 16;
    for (int si = 0; si < G.nslice; ++si) {
        const int s = G.slice_lo + si;
        if (G.wid >= ntok) continue;
        const int ntk = (ntok - 1 - G.wid) / G.nworkers + 1;
        const unsigned char* T4a = T4 + (size_t)s * TSLICE + 16 * pc0; const unsigned char* T4b = T4 + (size_t)s * TSLICE + 16 * pc1;
#define PU_META(K) do { const int tk_ = G.wid + ((K) < ntk ? (K) : ntk - 1) * G.nworkers; LAS unsigned char* ms_ = meta + ((K) & 1) * 1280; \
            if (lane < 48) __builtin_amdgcn_global_load_lds((const unsigned*)(lane < 32 ? PIDXb + (size_t)tk_ * 512 + 16 * lane : H4 + (size_t)tk_ * 1536 + 128 * s + (lane < 40 ? 16 * (lane - 32) : 512 + 16 * (lane - 40))), (LAS unsigned*)ms_, 16, 0, 0); \
            } while (0)
#define PU_IDS(K, E) do { const LAS unsigned char* ms_ = meta + ((K) & 1) * 1280 + 32 * dm; _Pragma("unroll") for (int q4 = 0; q4 < 4; ++q4) { const u32x4_t ev = *(const LAS u32x4_t*)(ms_ + 256 * (q4 >> 1) + 16 * (q4 & 1)); \
            E[4 * q4] = (int)(ev[0] & 16383u); E[4 * q4 + 1] = (int)(ev[1] & 16383u); E[4 * q4 + 2] = (int)(ev[2] & 16383u); E[4 * q4 + 3] = (int)(ev[3] & 16383u); } } while (0)
#define PU_REGS(K, B0_, B1_, U0_, U1_) do { const LAS unsigned char* ms_ = meta + ((K) & 1) * 1280; \
            B0_[0] = *(const LAS u32x4_t*)(ms_ + 512 + 16 * kq); B0_[1] = *(const LAS u32x4_t*)(ms_ + 512 + 64 + 16 * kq); B1_[0] = *(const LAS u32x4_t*)(ms_ + 640 + 16 * kq); B1_[1] = *(const LAS u32x4_t*)(ms_ + 640 + 64 + 16 * kq); \
            U0_ = *(const LAS u32x4_t*)(ms_ + 32 * (4 * kq + isel)) & 0xffff0000u; U1_ = *(const LAS u32x4_t*)(ms_ + 32 * (4 * kq + isel) + 16) & 0xffff0000u; } while (0)
        int En[16]; u32x4_t Bc0[2], Bc1[2], Uc0, Uc1;
        PU_META(0); PU_META(1);
        asm volatile("s_waitcnt vmcnt(0)" ::: "memory");
        __builtin_amdgcn_sched_barrier(0);
        PU_IDS(0, En); PU_REGS(0, Bc0, Bc1, Uc0, Uc1);
        asm volatile("s_waitcnt lgkmcnt(0)" : "+v"(Bc0[0]), "+v"(Bc0[1]), "+v"(Bc1[0]), "+v"(Bc1[1]), "+v"(Uc0), "+v"(Uc1) :: "memory");
        __builtin_amdgcn_sched_barrier(0);
#pragma unroll
        for (int gI = 0; gI < 8; ++gI) {
            __builtin_amdgcn_global_load_lds((const unsigned*)(T4a + ((unsigned)En[gI] << 7)), (LAS unsigned*)(ring + (2 * gI) * 1024), 16, 0, 0);
            __builtin_amdgcn_global_load_lds((const unsigned*)(T4b + ((unsigned)En[8 + gI] << 7)), (LAS unsigned*)(ring + (2 * gI + 1) * 1024), 16, 0, 0); }
        __builtin_amdgcn_sched_barrier(0);
        for (int j = 0; j < ntk; ++j) {
            const int t = G.wid + j * G.nworkers;
            PU_META(j + 2);
            __builtin_amdgcn_sched_barrier(0);
            u32x4_t Bn0[2], Bn1[2], Un0, Un1;
            f32x4_t acc[8];
#pragma unroll
            for (int gI = 0; gI < 8; ++gI) acc[gI] = (f32x4_t){0.f, 0.f, 0.f, 0.f};
#pragma unroll
            for (int gI = 0; gI < 8; ++gI) {
                __builtin_amdgcn_sched_barrier(0);
                asm volatile("s_waitcnt vmcnt(15)" ::: "memory");
                __builtin_amdgcn_sched_barrier(0);
                if (gI == 0) { PU_IDS(j + 1, En); PU_REGS(j + 1, Bn0, Bn1, Un0, Un1); }
                const u32x4_t r0 = *(LAS u32x4_t*)(ring + (2 * gI + rsl) * 1024 + rd0), r1 = *(LAS u32x4_t*)(ring + (2 * gI + rsl) * 1024 + rd1);
                if (gI == 0) asm volatile("s_waitcnt lgkmcnt(0)" : "+v"(Bn0[0]), "+v"(Bn0[1]), "+v"(Bn1[0]), "+v"(Bn1[1]), "+v"(Un0), "+v"(Un1) :: "memory");
                else asm volatile("s_waitcnt lgkmcnt(0)" ::: "memory");
                __builtin_amdgcn_global_load_lds((const unsigned*)(T4a + ((unsigned)En[gI] << 7)), (LAS unsigned*)(ring + (2 * gI) * 1024), 16, 0, 0);
                __builtin_amdgcn_global_load_lds((const unsigned*)(T4b + ((unsigned)En[8 + gI] << 7)), (LAS unsigned*)(ring + (2 * gI + 1) * 1024), 16, 0, 0);
                __builtin_amdgcn_sched_barrier(0);
                const i32x8_t A0 = {(int)r0[0], (int)r0[1], (int)r0[2], (int)r0[3], 0, 0, 0, 0}, A1 = {(int)r1[0], (int)r1[1], (int)r1[2], (int)r1[3], 0, 0, 0, 0};
                const i32x8_t B00 = {(int)Bc0[0][0], (int)Bc0[0][1], (int)Bc0[0][2], (int)Bc0[0][3], 0, 0, 0, 0}, B10 = {(int)Bc1[0][0], (int)Bc1[0][1], (int)Bc1[0][2], (int)Bc1[0][3], 0, 0, 0, 0};
                const i32x8_t B01 = {(int)Bc0[1][0], (int)Bc0[1][1], (int)Bc0[1][2], (int)Bc0[1][3], 0, 0, 0, 0}, B11 = {(int)Bc1[1][0], (int)Bc1[1][1], (int)Bc1[1][2], (int)Bc1[1][3], 0, 0, 0, 0};
                acc[gI] = __builtin_amdgcn_mfma_scale_f32_16x16x128_f8f6f4(A0, B00, acc[gI], 4, 4, 0, 127, 0, 128);
                acc[gI] = __builtin_amdgcn_mfma_scale_f32_16x16x128_f8f6f4(A0, B10, acc[gI], 4, 4, 0, 127, 0, 125);
                acc[gI] = __builtin_amdgcn_mfma_scale_f32_16x16x128_f8f6f4(A1, B01, acc[gI], 4, 4, 0, 127, 0, 128);
                acc[gI] = __builtin_amdgcn_mfma_scale_f32_16x16x128_f8f6f4(A1, B11, acc[gI], 4, 4, 0, 127, 0, 125);
            }
            __builtin_amdgcn_sched_barrier(0);
            { float v[8];
#pragma unroll
              for (int gI = 0; gI < 8; ++gI) v[gI] = isel == 0 ? acc[gI][0] : (isel == 1 ? acc[gI][1] : (isel == 2 ? acc[gI][2] : acc[gI][3]));
              if (r16 < 4) { uint4* up = (uint4*)((bf16_t*)UP + ((size_t)s * NTOK + t) * 128 + 8 * (4 * kq + isel));
                  *up = make_uint4(pk_bf16(v[0] * __uint_as_float(Uc0[0]), v[1] * __uint_as_float(Uc0[1])), pk_bf16(v[2] * __uint_as_float(Uc0[2]), v[3] * __uint_as_float(Uc0[3])),
                                   pk_bf16(v[4] * __uint_as_float(Uc1[0]), v[5] * __uint_as_float(Uc1[1])), pk_bf16(v[6] * __uint_as_float(Uc1[2]), v[7] * __uint_as_float(Uc1[3]))); } }
            Bc0[0] = Bn0[0]; Bc0[1] = Bn0[1]; Bc1[0] = Bn1[0]; Bc1[1] = Bn1[1]; Uc0 = Un0; Uc1 = Un1;
        }
        asm volatile("s_waitcnt vmcnt(0)" ::: "memory");
#undef PU_META
#undef PU_IDS
#undef PU_REGS
    }
}
__device__ __forceinline__ void phase_peer_w(const P& p, int l) {
    const float* UP = (const float*)(p.ws + WS_PROJ); float* PG = (float*)(p.ws + WS_PG);
    const int ntok = (l == DEPTH - 1) ? NLAT : NTOK;
    const size_t n4 = (size_t)ntok * 32, stride = (size_t)gridDim.x * NTHR;
    for (size_t i = (size_t)blockIdx.x * NTHR + otid(); i < n4; i += stride) {
        float4 a = ((const float4*)UP)[i];
#pragma unroll
        for (int s = 1; s < 4; ++s) { const float4 b = ((const float4*)UP)[(size_t)s * NTOK * 32 + i]; a.x += b.x; a.y += b.y; a.z += b.z; a.w += b.w; }
        float4 g = ((float4*)PG)[i];
        g.x *= gelu_tanh(a.x); g.y *= gelu_tanh(a.y); g.z *= gelu_tanh(a.z); g.w *= gelu_tanh(a.w);
        ((float4*)PG)[i] = g;
    }
}
__device__ __forceinline__ void phase_peer_w4(const P& p, int l) {
    const bf16_t* UP = (const bf16_t*)(p.ws + WS_PROJ); const float* PG = (const float*)(p.ws + WS_PG); unsigned char* PW4 = p.ws + WS_PW4;
    const int ntok = (l == DEPTH - 1) ? NLAT : NTOK;
    const int lane = otid() & 63, gw = blockIdx.x * NWAVE + owave(), nw = gridDim.x * NWAVE;
    const int k0 = 2 * lane, p0 = 16 * (k0 & 7) + (k0 >> 3), p1 = 16 * ((k0 + 1) & 7) + ((k0 + 1) >> 3);
    for (int tb = gw; tb < ntok; tb += 4 * nw) {
        float u0[4][4], u1[4][4], g0[4], g1[4];
#pragma unroll
        for (int q = 0; q < 4; ++q) { const int t = min(tb + q * nw, ntok - 1);
#pragma unroll
            for (int sl = 0; sl < 4; ++sl) { const bf16_t* u = UP + ((size_t)sl * NTOK + t) * 128; u0[q][sl] = bf1(u[p0]); u1[q][sl] = bf1(u[p1]); }
            g0[q] = PG[(size_t)t * 128 + p0]; g1[q] = PG[(size_t)t * 128 + p1]; }
#pragma unroll
        for (int q = 0; q < 4; ++q) { const int t = tb + q * nw;
            const float a0 = (u0[q][0] + u0[q][1]) + (u0[q][2] + u0[q][3]), a1 = (u1[q][0] + u1[q][1]) + (u1[q][2] + u1[q][3]);
            const float w0 = g0[q] * gelu_tanh(a0), w1 = g1[q] * gelu_tanh(a1);
            const float am = fmaxf(wave_max(fmaxf(fabsf(w0), fabsf(w1))), 1e-30f), inv = 6.0f / am;
            const float b0 = w0 * inv, b1 = w1 * inv;
            const unsigned t0 = __builtin_amdgcn_cvt_scalef32_pk_fp4_f32(0u, b0, b1, 1.0f, 0);
            const auto q0 = __builtin_amdgcn_cvt_scalef32_pk_f32_fp4(t0, 1.0f, 0);
            const unsigned t1 = __builtin_amdgcn_cvt_scalef32_pk_fp4_f32(0u, (b0 - q0[0]) * 4.0f, (b1 - q0[1]) * 4.0f, 1.0f, 0);
            if (t < ntok) { PW4[(size_t)t * 144 + lane] = (unsigned char)(t0 & 0xffu); PW4[(size_t)t * 144 + 64 + lane] = (unsigned char)(t1 & 0xffu);
                if (lane == 0) *(float*)(PW4 + (size_t)t * 144 + 128) = am * (1.0f / 6.0f); } }
    }
}
template <int OFF> __device__ __forceinline__ u32x2_t tr4_read(unsigned ad) { u32x2_t r; asm volatile("ds_read_b64_tr_b4 %0, %1 offset:%2" : "=&v"(r) : "v"(ad), "i"(OFF) : "memory"); return r; }
__device__ __forceinline__ void ld4_nowait(unsigned& d, const void* q) { asm volatile("global_load_dword %0, %1, off" : "=v"(d) : "v"(q) : "memory"); }
__device__ __forceinline__ void ld2_nowait(unsigned& d, const void* q) { asm volatile("global_load_ushort %0, %1, off" : "=v"(d) : "v"(q) : "memory"); }
template <int HH, int A2, int Q> __device__ __forceinline__ void pv_read(u32x2_t (&lo)[2][4], u32x2_t (&hi)[2][4], unsigned rb, const unsigned (&po)[2][2]) {
    lo[A2][Q] = tr4_read<8192 * HH + 8 * (Q & 1)>(rb + po[A2][Q >> 1]); hi[A2][Q] = tr4_read<8192 * HH + 2048 + 8 * (Q & 1)>(rb + po[A2][Q >> 1]); }
__device__ __forceinline__ void phase_peer_v(const P& p, int l, LAS unsigned char* lds) {
    const int tid = otid(), wave = __builtin_amdgcn_readfirstlane(tid >> 6), lane = tid & 63, n16 = lane & 15, kg = lane >> 4, dm = lane >> 3, di = lane & 7;
    const bool last = (l == DEPTH - 1); const int ntok = last ? NLAT : NTOK;
    const unsigned char* T4 = p.ws + WS_VT + (size_t)l * 16384 * 512;
    const unsigned char* PIDXb = p.ws + WS_PIDX; const unsigned char* PW4 = p.ws + WS_PW4;
    bf16_t* X = (bf16_t*)(p.ws + WS_XRES); const float* MOD = (const float*)(p.ws + WS_MOD); float* SSP = (float*)(p.ws + WS_SSP) + (size_t)((l + 1) & 3) * 4 * NTOK;
    LAS unsigned char* meta = lds + PEER_STAGE_OFF + wave * 2560;
    LAS unsigned char* ring = lds + wave * 16384;
    const PeerGeom G = peer_geom(lds, wave);
    const int pc0 = (di - (dm >> 1)) & 7, pc1 = (di - (dm >> 1) - 4) & 7;
    const int tm = n16 & 7, trot = (tm >> 1) + 4 * (n16 >> 3), ub = kg >> 1;
    const unsigned rb = (unsigned)(uintptr_t)ring + (unsigned)((4 * (kg & 1) + (n16 >> 3)) * 1024 + 128 * tm);
    unsigned po[2][2];
#pragma unroll
    for (int a = 0; a < 2; ++a)
#pragma unroll
        for (int qh = 0; qh < 2; ++qh) po[a][qh] = (unsigned)(((4 * ub + 2 * a + qh + trot) & 7) * 16);
    const bool rowok = (((n16 >> 1) & 1) == ub);
    const int scA = (n16 & 1) ? 125 : 127;
    const int aoff = 512 + 64 * (n16 & 1) + 16 * (kg & 1);
    for (int si = 0; si < G.nslice; ++si) {
        const int s = G.slice_lo + si;
        if (G.wid >= ntok) continue;
        const int ntk = (ntok - 1 - G.wid) / G.nworkers + 1;
        const unsigned char* T4a = T4 + (size_t)s * TSLICE + 16 * pc0; const unsigned char* T4b = T4 + (size_t)s * TSLICE + 16 * pc1;
        float gt[3][4];
#pragma unroll
        for (int sel = 0; sel < 3; ++sel)
#pragma unroll
            for (int c4 = 0; c4 < 4; ++c4) gt[sel][c4] = MOD[(size_t)(l * 3 + sel) * MODW + 5 * D + 256 * s + 64 * c4 + lane];
        asm volatile("s_waitcnt vmcnt(0)" : "+v"(gt[0][0]), "+v"(gt[0][1]), "+v"(gt[0][2]), "+v"(gt[0][3]), "+v"(gt[1][0]), "+v"(gt[1][1]), "+v"(gt[1][2]), "+v"(gt[1][3]), "+v"(gt[2][0]), "+v"(gt[2][1]), "+v"(gt[2][2]), "+v"(gt[2][3]) :: "memory");
#define PV_META(K) do { const int tk_ = G.wid + ((K) < ntk ? (K) : ntk - 1) * G.nworkers; LAS unsigned char* ms_ = meta + ((K) & 1) * 1280; \
            if (lane < 41) __builtin_amdgcn_global_load_lds((const unsigned*)(lane < 32 ? PIDXb + (size_t)tk_ * 512 + 16 * lane : PW4 + (size_t)tk_ * 144 + 16 * (lane - 32)), (LAS unsigned*)ms_, 16, 0, 0); \
            if (lane < 32) __builtin_amdgcn_global_load_lds((const unsigned*)((const unsigned char*)(X + (size_t)tk_ * D + 256 * s) + 16 * lane), (LAS unsigned*)(ms_ + 768), 16, 0, 0); } while (0)
#define PV_IDS(K, E) do { const LAS unsigned char* ms_ = meta + ((K) & 1) * 1280 + 64 * dm; _Pragma("unroll") for (int q4 = 0; q4 < 4; ++q4) { const u32x4_t ev = *(const LAS u32x4_t*)(ms_ + 16 * q4); \
            E[4 * q4] = (int)(ev[0] & 16383u); E[4 * q4 + 1] = (int)(ev[1] & 16383u); E[4 * q4 + 2] = (int)(ev[2] & 16383u); E[4 * q4 + 3] = (int)(ev[3] & 16383u); } } while (0)
#define PV_REGS(K, A_, X_, S_) do { const LAS unsigned char* ms_ = meta + ((K) & 1) * 1280; A_[0] = *(const LAS u32x4_t*)(ms_ + aoff); A_[1] = *(const LAS u32x4_t*)(ms_ + aoff + 32); \
            S_ = *(const LAS float*)(ms_ + 640); _Pragma("unroll") for (int c4 = 0; c4 < 4; ++c4) X_[c4] = (unsigned)*(const LAS unsigned short*)(ms_ + 768 + 2 * (64 * c4 + lane)); } while (0)
        int En[16]; u32x4_t Ac[2]; unsigned xc[4]; float sgc;
        PV_META(0); PV_META(1);
        asm volatile("s_waitcnt vmcnt(0)" ::: "memory");
        __builtin_amdgcn_sched_barrier(0);
        PV_IDS(0, En); PV_REGS(0, Ac, xc, sgc);
        asm volatile("s_waitcnt lgkmcnt(0)" : "+v"(Ac[0]), "+v"(Ac[1]), "+v"(xc[0]), "+v"(xc[1]), "+v"(xc[2]), "+v"(xc[3]), "+v"(sgc) :: "memory");
        __builtin_amdgcn_sched_barrier(0);
#pragma unroll
        for (int sl = 0; sl < 16; ++sl) __builtin_amdgcn_global_load_lds((const unsigned*)(((sl & 1) ? T4b : T4a) + ((unsigned)En[sl] << 7)), (LAS unsigned*)(ring + sl * 1024), 16, 0, 0);
        __builtin_amdgcn_sched_barrier(0);
        for (int j = 0; j < ntk; ++j) {
            const int t = G.wid + j * G.nworkers;
            PV_META(j + 2);
            __builtin_amdgcn_sched_barrier(0);
            f32x4_t acc[2] = {(f32x4_t){0.f, 0.f, 0.f, 0.f}, (f32x4_t){0.f, 0.f, 0.f, 0.f}};
            u32x4_t An[2]; unsigned xn[4]; float sgn;
#pragma unroll
            for (int hh = 0; hh < 2; ++hh) {
                __builtin_amdgcn_sched_barrier(0);
                asm volatile("s_waitcnt vmcnt(10)" ::: "memory");
                __builtin_amdgcn_sched_barrier(0);
                if (hh == 0) { PV_IDS(j + 1, En); PV_REGS(j + 1, An, xn, sgn); }
                u32x2_t lo[2][4], hi[2][4];
                if (hh == 0) { pv_read<0, 0, 0>(lo, hi, rb, po); pv_read<0, 1, 0>(lo, hi, rb, po); pv_read<0, 0, 1>(lo, hi, rb, po); pv_read<0, 1, 1>(lo, hi, rb, po);
                               pv_read<0, 0, 2>(lo, hi, rb, po); pv_read<0, 1, 2>(lo, hi, rb, po); pv_read<0, 0, 3>(lo, hi, rb, po); pv_read<0, 1, 3>(lo, hi, rb, po); }
                else         { pv_read<1, 0, 0>(lo, hi, rb, po); pv_read<1, 1, 0>(lo, hi, rb, po); pv_read<1, 0, 1>(lo, hi, rb, po); pv_read<1, 1, 1>(lo, hi, rb, po);
                               pv_read<1, 0, 2>(lo, hi, rb, po); pv_read<1, 1, 2>(lo, hi, rb, po); pv_read<1, 0, 3>(lo, hi, rb, po); pv_read<1, 1, 3>(lo, hi, rb, po); }
                asm volatile("s_waitcnt lgkmcnt(0)" : "+v"(lo[0][0]), "+v"(lo[0][1]), "+v"(lo[0][2]), "+v"(lo[0][3]), "+v"(lo[1][0]), "+v"(lo[1][1]), "+v"(lo[1][2]), "+v"(lo[1][3]),
                                                      "+v"(hi[0][0]), "+v"(hi[0][1]), "+v"(hi[0][2]), "+v"(hi[0][3]), "+v"(hi[1][0]), "+v"(hi[1][1]), "+v"(hi[1][2]), "+v"(hi[1][3]) :: "memory");
                __builtin_amdgcn_sched_barrier(0);
#pragma unroll
                for (int sl = 0; sl < 8; ++sl) __builtin_amdgcn_global_load_lds((const unsigned*)((((8 * hh + sl) & 1) ? T4b : T4a) + ((unsigned)En[8 * hh + sl] << 7)), (LAS unsigned*)(ring + (8 * hh + sl) * 1024), 16, 0, 0);
                __builtin_amdgcn_sched_barrier(0);
#pragma unroll
                for (int q = 0; q < 4; ++q) {
                    const bool ok = rowok && ((n16 >> 2) == q);
                    const i32x8_t Aq = {ok ? (int)Ac[hh][0] : 0, ok ? (int)Ac[hh][1] : 0, ok ? (int)Ac[hh][2] : 0, ok ? (int)Ac[hh][3] : 0, 0, 0, 0, 0};
#pragma unroll
                    for (int a = 0; a < 2; ++a) {
                        const i32x8_t B = {(int)lo[a][q][0], (int)lo[a][q][1], (int)hi[a][q][0], (int)hi[a][q][1], 0, 0, 0, 0};
                        acc[a] = __builtin_amdgcn_mfma_scale_f32_16x16x128_f8f6f4(Aq, B, acc[a], 4, 4, 0, scA, 0, 127); }
                }
            }
            __builtin_amdgcn_sched_barrier(0);
            { const int sel = row_sel(t); float ssq = 0.f;
#pragma unroll
              for (int c4 = 0; c4 < 4; ++c4) { const int a = c4 & 1, u = c4 >> 1; const float r = acc[a][2 * u] + acc[a][2 * u + 1];
                  const float gate = sel == 0 ? gt[0][c4] : (sel == 1 ? gt[1][c4] : gt[2][c4]);
                  const float xv = fmaf(gate * sgc, r, __uint_as_float(xc[c4] << 16));
                  const unsigned xb = pk_bf16(xv, 0.f) & 0xffffu; const float xr = __uint_as_float(xb << 16); ssq = fmaf(xr, xr, ssq);
                  X[(size_t)t * D + 256 * s + 64 * c4 + lane] = (bf16_t)xb; }
              if (!last) {
                  ssq += dppf<0xB1>(ssq); ssq += dppf<0x4E>(ssq); ssq += dppf<0x141>(ssq); ssq += dppf<0x140>(ssq); ssq = x4_sum(ssq);
                  if (lane == 0) SSP[(size_t)t * 4 + s] = ssq; } }
            Ac[0] = An[0]; Ac[1] = An[1]; sgc = sgn;
#pragma unroll
            for (int c4 = 0; c4 < 4; ++c4) xc[c4] = xn[c4];
        }
        asm volatile("s_waitcnt vmcnt(0)" ::: "memory");
#undef PV_META
#undef PV_IDS
#undef PV_REGS
    }
}
__device__ __forceinline__ void phase_final(const P& p) {
    const bf16_t* X = (const bf16_t*)(p.ws + WS_XRES);
    const int lane = otid() & 63, gw = blockIdx.x * NWAVE + owave(), nw = gridDim.x * NWAVE;
    for (int r = gw; r < NLAT; r += nw) {
        const bf16_t* xr = X + (size_t)r * D; float4 v[4]; float ss = 0.f;
#pragma unroll
        for (int i = 0; i < 4; ++i) { const uint2 w = *(const uint2*)(xr + i * 256 + lane * 4); v[i] = make_float4(bf_lo(w.x), bf_hi(w.x), bf_lo(w.y), bf_hi(w.y)); ss += v[i].x * v[i].x + v[i].y * v[i].y + v[i].z * v[i].z + v[i].w * v[i].w; }
        ss = wave_sum(ss); const float rs = rsqrtf(ss * (1.0f / D) + EPS);
#pragma unroll
        for (int i = 0; i < 4; ++i) { const int col = i * 256 + lane * 4; const float4 gv = *(const float4*)(p.final_norm_g + col);
            float4 o; o.x = v[i].x * rs * gv.x; o.y = v[i].y * rs * gv.y; o.z = v[i].z * rs * gv.z; o.w = v[i].w * rs * gv.w;
            *(float4*)(p.out + (size_t)r * D + col) = o; }
    }
}
__device__ __forceinline__ bool gemm_has_slack(int ntiles) {
    const int G = (int)gridDim.x, c = (int)blockIdx.x; const int mine = c < ntiles ? (ntiles - c + G - 1) / G : 0, most = (ntiles + G - 1) / G;
    return mine < most;
}
__device__ __forceinline__ void gemm_slack_work(const P& p, int l, LAS unsigned char* lds, bool before) {
    if (((blockIdx.x & 1) != 0) != before) return;
    if (l + 1 < DEPTH) deferred_drain(p, l + 1, lds, 1);
    else if (before) { for (int i = 0; i < 3; ++i) __builtin_amdgcn_s_sleep(127); }
}
__device__ __forceinline__ void phase_gemm_in(const P& p, int l, LAS unsigned char* lds) {
    pg8::Gemm g{(const bf16_t*)(p.ws + WS_H), (const bf16_t*)(p.ws + WS_WIN) + (size_t)l * IN_W * D, NTOK, IN_W, D};
    pg8::StaticOrder S; S.init(NTOK, IN_W, (int)gridDim.x, (int)blockIdx.x);
    pg8::EpiStoreBf16 E{(bf16_t*)(p.ws + WS_PROJ), IN_W};
    const bool slack = gemm_has_slack((NTOK / 256) * (IN_W / 256));
    if (slack) gemm_slack_work(p, l, lds, true);
    if (l == 0) pg8::gemm_phase<pg8::EpiStoreBf16, pg8::StaticOrder, false>(lds, g, S, E, nullptr);
    else {
        pg8::Gemm g3{(const bf16_t*)(p.ws + WS_XRES), (const bf16_t*)(p.ws + WS_WIN3) + (size_t)(l - 1) * 3 * IN_W * D, NTOK, IN_W, D, (size_t)IN_W * D * 2};
        pg8::EpiScaleBias<4> E3{(bf16_t*)(p.ws + WS_PROJ), IN_W, (const float*)(p.ws + WS_SSP) + (size_t)l * 4 * NTOK, (const float*)(p.ws + WS_BIASP) + (size_t)l * 3 * 2 * IN_W};
        pg8::gemm_phase<pg8::EpiScaleBias<4>, pg8::StaticOrder, false>(lds, g3, S, E3, nullptr); }
    if (slack) gemm_slack_work(p, l, lds, false);
}
__device__ __forceinline__ void phase_gemm_out(const P& p, int l, LAS unsigned char* lds) {
    const int M = (l == DEPTH - 1) ? NLAT : NTOK;
    pg8::Gemm g{(const bf16_t*)(p.ws + WS_YCAT), (const bf16_t*)(p.ws + WS_WOUT) + (size_t)l * D * D, M, D, D};
    pg8::StaticOrder S; S.init(M, D, (int)gridDim.x, (int)blockIdx.x);
    pg8::EpiResid E{(bf16_t*)(p.ws + WS_XRES), l == 0 ? p.x : (const float*)nullptr, l == 0 ? p.ctx : (const float*)nullptr, D, (const float*)(p.ws + WS_MOD) + (size_t)l * 3 * MODW + 2 * D, MODW, (float*)(p.ws + WS_SSP2)};
    const bool slack = gemm_has_slack((M / 256) * (D / 256));
    if (slack) gemm_slack_work(p, l, lds, true);
    pg8::gemm_phase<pg8::EpiResid, pg8::StaticOrder, false>(lds, g, S, E, nullptr);
    if (slack) gemm_slack_work(p, l, lds, false);
}
__device__ __forceinline__ void phase_gemm_q(const P& p, int l, LAS unsigned char* lds) {
    const int M = (l == DEPTH - 1) ? NLAT : NTOK;
    pg8::Gemm g{(const bf16_t*)(p.ws + WS_XRES), (const bf16_t*)(p.ws + WS_WQ3) + (size_t)l * 3 * QW * D, M, QW, D, (size_t)QW * D * 2};
    pg8::StaticOrder S; S.init(M, QW, (int)gridDim.x, (int)blockIdx.x);
    pg8::EpiScaleBias<16> E{(bf16_t*)(p.ws + WS_Q), QW, (const float*)(p.ws + WS_SSP2), (const float*)(p.ws + WS_BIASP2) + (size_t)l * 3 * 2 * QW};
    const bool slack = gemm_has_slack((M / 256) * (QW / 256));
    if (slack) gemm_slack_work(p, l, lds, true);
    pg8::gemm_phase<pg8::EpiScaleBias<16>, pg8::StaticOrder, false>(lds, g, S, E, nullptr);
    if (slack) gemm_slack_work(p, l, lds, false);
}


#define XB_TMO      128
#define XB_XCNT(j)  (256  + 64 * (j))
#define XB_XSUB(j)  (1280 + 64 * (j))
#define XB_XGEN(j)  (2304 + 64 * (j))
#define XB_TOP      3328
#define XB_TOPGEN   3392
#define XCD_BAR_WORDS 3456
#define XB_SPIN_CAP (1u << 18)

__device__ __forceinline__ unsigned xb_ld(unsigned* p)              { return __hip_atomic_load(p, __ATOMIC_RELAXED, __HIP_MEMORY_SCOPE_AGENT); }
__device__ __forceinline__ unsigned xb_add(unsigned* p, unsigned v) { return __hip_atomic_fetch_add(p, v, __ATOMIC_RELAXED, __HIP_MEMORY_SCOPE_AGENT); }
__device__ __forceinline__ unsigned xb_xcc_id() { return (unsigned)__builtin_amdgcn_s_getreg((3 << 11) | 20) & 0xFu; }
#define XB_SPIN(cond, bar) do { unsigned _sp = 0; while (cond) { __builtin_amdgcn_s_sleep(1); \
    if ((++_sp & 255u) == 0u) { if (xb_ld(&(bar)[XB_TMO])) break; if (_sp > XB_SPIN_CAP) { atomicAdd(&(bar)[XB_TMO], 1u); break; } } } } while (0)
struct XcdBarrier {
    unsigned* bar; unsigned x;
    volatile LAS unsigned* st;
};

__device__ __forceinline__ XcdBarrier xcd_barrier_post(unsigned* bar, volatile LAS unsigned* st) {
    XcdBarrier b; b.bar = bar; b.x = xb_xcc_id(); b.st = st;
    if (threadIdx.x == 0) (void)xb_add(&bar[XB_XCNT(b.x)], 1u);
    return b;
}
__device__ __forceinline__ void xcd_barrier_complete(unsigned* bar, unsigned x, unsigned& nloc, unsigned& nx) {
    const unsigned G = gridDim.x * gridDim.y * gridDim.z;
    unsigned sum, cnt, mine, sp = 0u;
    for (;;) {
        sum = 0u; cnt = 0u; mine = 0u;
#pragma unroll
        for (unsigned j = 0; j < 16; ++j) { const unsigned c = xb_ld(&bar[XB_XCNT(j)]); sum += c; cnt += (c > 0u) ? 1u : 0u; mine = (j == x) ? c : mine; }
        if (sum == G) break;
        __builtin_amdgcn_s_sleep(1);
        if ((++sp & 255u) == 0u) { if (xb_ld(&bar[XB_TMO])) break; if (sp > XB_SPIN_CAP) { atomicAdd(&bar[XB_TMO], 1u); break; } }
    }
    nloc = mine > 0u ? mine : 1u; nx = cnt > 0u ? cnt : 1u;
}

__device__ __forceinline__ void xcd_barrier(const XcdBarrier& b) {
    asm volatile("s_waitcnt vmcnt(0)" ::: "memory");
    __syncthreads();
    if (threadIdx.x == 0) {
        unsigned* bar = b.bar;
        __builtin_amdgcn_s_waitcnt(0);
        unsigned nloc = b.st[0], nx = b.st[1];
        if (nloc == 0u) { xcd_barrier_complete(bar, b.x, nloc, nx); b.st[0] = nloc; b.st[1] = nx; }
        const unsigned old = xb_add(&bar[XB_XSUB(b.x)], 1u);
        const unsigned gen = old / nloc;
        if (old + 1u == (gen + 1u) * nloc) {
            __builtin_amdgcn_fence(__ATOMIC_RELEASE, "agent");
            asm volatile("s_waitcnt vmcnt(0)" ::: "memory");
            const unsigned og = xb_add(&bar[XB_TOP], 1u);
            const unsigned tg = og / nx;
            if (og + 1u == (tg + 1u) * nx) xb_add(&bar[XB_TOPGEN], 1u);
            else XB_SPIN(xb_ld(&bar[XB_TOPGEN]) == tg, bar);
            __builtin_amdgcn_fence(__ATOMIC_ACQUIRE, "agent");
            xb_add(&bar[XB_XGEN(b.x)], 1u);
            asm volatile("s_waitcnt vmcnt(0)" ::: "memory");
        } else {
            XB_SPIN(xb_ld(&bar[XB_XGEN(b.x)]) == gen, bar);
            __builtin_amdgcn_fence(__ATOMIC_ACQUIRE, "agent");
            asm volatile("s_waitcnt vmcnt(0)" ::: "memory");
        }
    }
    __syncthreads();
}

__global__ void __launch_bounds__(NTHR, 2) k_mega(P p) {
    extern __shared__ __attribute__((aligned(16))) unsigned char shm[];
    LAS unsigned char* lds = (LAS unsigned char*)shm;
    volatile LAS unsigned* st = (volatile LAS unsigned*)(lds + ST_OFF);
    if (threadIdx.x < 16) st[threadIdx.x] = 0u;
    __syncthreads();
    (void)xcd_barrier_post((unsigned*)(p.ws + WS_CTL), st);
    if (threadIdx.x == 0) st[4] = xb_add((unsigned*)(p.ws + WS_CTL) + 4096 + 64 * xb_xcc_id(), 1u);
#define GRID_BAR() do { XcdBarrier b_; { size_t z_ = 0; asm volatile("" : "+s"(z_)); b_.bar = (unsigned*)(p.ws + z_ + WS_CTL); } b_.x = xb_xcc_id(); \
        b_.st = (volatile LAS unsigned*)((LAS unsigned char*)shm + ST_OFF); xcd_barrier(b_); } while (0)
    { P q = p; { size_t z_ = 0; asm volatile("" : "+s"(z_)); q.ws = p.ws + z_; } phase_prologue(q, lds); }
    { P q = p; { size_t z_ = 0; asm volatile("" : "+s"(z_)); q.ws = p.ws + z_; } phase_adaln(q, lds); }
    GRID_BAR();
    if (threadIdx.x == 0) {
        unsigned cnt[16], dense = 0u, npop = 0u; const unsigned x = xb_xcc_id();
        for (unsigned j = 0; j < 16u; ++j) { cnt[j] = xb_ld((unsigned*)(p.ws + WS_CTL) + XB_XCNT(j)); if (cnt[j] > 0u) { if (j < x) ++dense; ++npop; } }
        unsigned base = 0u, total = 0u, k = 0u;
        for (unsigned j = 0; j < 16u; ++j) if (cnt[j] > 0u) { if ((k & 3u) == (dense & 3u)) { if (k < dense) base += cnt[j]; total += cnt[j]; } ++k; }
        st[6] = dense; st[7] = base; st[8] = (npop == 8u) ? total : 0u; }
    __syncthreads();
    { P q = p; { size_t z_ = 0; asm volatile("" : "+s"(z_)); q.ws = p.ws + z_; } phase_norm(q, 0, 0);
      for (int c = 256 + 120 + (int)blockIdx.x; c < DEF_NCHUNK; c += (int)gridDim.x) { __syncthreads(); deferred_chunk(q, 0, c, lds); } }
    GRID_BAR();
    for (int l = 0; l < DEPTH; ++l) {
        { P q = p; { size_t z_ = 0; asm volatile("" : "+s"(z_)); q.ws = p.ws + z_; } phase_gemm_in(q, l, lds); }
        GRID_BAR();
        { P q = p; { size_t z_ = 0; asm volatile("" : "+s"(z_)); q.ws = p.ws + z_; } phase_conv(q, l); }
        { P q = p; { size_t z_ = 0; asm volatile("" : "+s"(z_)); q.ws = p.ws + z_; } phase_sgu(q, l, lds); }
        { P q = p; { size_t z_ = 0; asm volatile("" : "+s"(z_)); q.ws = p.ws + z_; } phase_na(q, l, lds); }
        GRID_BAR();
        { P q = p; { size_t z_ = 0; asm volatile("" : "+s"(z_)); q.ws = p.ws + z_; } phase_gemm_out(q, l, lds); }
        GRID_BAR();
        { P q = p; { size_t z_ = 0; asm volatile("" : "+s"(z_)); q.ws = p.ws + z_; } phase_gemm_q(q, l, lds); }
        GRID_BAR();
        { P q = p; { size_t z_ = 0; asm volatile("" : "+s"(z_)); q.ws = p.ws + z_; } phase_topk(q, l, lds); }
        GRID_BAR();
        { P q = p; { size_t z_ = 0; asm volatile("" : "+s"(z_)); q.ws = p.ws + z_; } phase_peer_u(q, l, lds); }
        GRID_BAR();
        { P q = p; { size_t z_ = 0; asm volatile("" : "+s"(z_)); q.ws = p.ws + z_; } phase_peer_w4(q, l); }
        GRID_BAR();
        { P q = p; { size_t z_ = 0; asm volatile("" : "+s"(z_)); q.ws = p.ws + z_; } phase_peer_v(q, l, lds); if (l + 1 < DEPTH) deferred_drain(q, l + 1, lds, 1 << 30); }
        GRID_BAR();
        if (l + 1 == DEPTH) { P q = p; { size_t z_ = 0; asm volatile("" : "+s"(z_)); q.ws = p.ws + z_; } phase_final(q); }
    }
}

extern "C" void kernel_launch(void* const* d_in, const int* in_sizes, int n_in, void* d_out, int out_size, void* d_ws, size_t ws_size, hipStream_t stream) {
    static int grid = 0;
    if (grid == 0) {
        if (n_in != 21 || ws_size < WS_END) { fprintf(stderr, "kernel_launch: expected 21 inputs and >= %zu bytes of workspace, got %d and %zu\n", (size_t)WS_END, n_in, ws_size); grid = -1; return; }
        int dev = 0, cus = 0, per_cu = 0;
        if (hipGetDevice(&dev) != hipSuccess || hipDeviceGetAttribute(&cus, hipDeviceAttributeMultiprocessorCount, dev) != hipSuccess || cus <= 0) cus = 256;
        if (hipFuncSetAttribute((const void*)k_mega, hipFuncAttributeMaxDynamicSharedMemorySize, LDS_BYTES) != hipSuccess) { fprintf(stderr, "kernel_launch: hipFuncSetAttribute failed\n"); grid = -1; return; }
        if (hipOccupancyMaxActiveBlocksPerMultiprocessor(&per_cu, (const void*)k_mega, NTHR, LDS_BYTES) != hipSuccess || per_cu < 1) { fprintf(stderr, "kernel_launch: occupancy query reports %d workgroups per CU\n", per_cu); per_cu = 1; }
        (void)hipGetLastError();
        grid = cus;
    }
    if (grid < 0) return;
    (void)hipMemsetAsync((unsigned char*)d_ws + WS_CTL, 0, 65536, stream);
    P p{};
    const float** pf = (const float**)&p;
    for (int i = 0; i < 21; ++i) pf[i] = (const float*)d_in[i];
    p.out = (float*)d_out; p.ws = (unsigned char*)d_ws;
    hipLaunchKernelGGL(k_mega, dim3(grid), dim3(NTHR), LDS_BYTES, stream, p);
}
```

```cpp
#include <hip/hip_runtime.h>
#include <cstdio>
#include <cstdint>
#include <utility>

#ifndef ONE_LAUNCH
#define ONE_LAUNCH 0
#endif

__device__ __forceinline__ int hw_tid();
namespace pg8 {
#define PG8_LAS __attribute__((address_space(3)))
typedef unsigned short bf16_t;
typedef short bf16x8 __attribute__((ext_vector_type(8)));
typedef float f32x4 __attribute__((ext_vector_type(4)));
typedef unsigned u32x4 __attribute__((ext_vector_type(4)));
constexpr int BM = 256, BK = 64, HALF = 128, HTB = HALF * BK * 2  , STAGE_BYTES = 8 * HTB, NXCD = 8, WGM = 8;

__host__ __device__ __forceinline__ int lds_byte(int r, int c) { const int st = (r >> 4) * 2 + (c >> 5), rr = r & 15, cc = c & 31, ob = rr * 64 + cc * 2; return st * 1024 + (ob ^ (((ob >> 9) & 1) << 5)); }
__host__ __device__ __forceinline__ void stage_rc(int b, int& R, int& C) { const int st = b / 1024, sb = b % 1024, swz = sb ^ (((sb >> 9) & 1) << 5); R = (st >> 1) * 16 + swz / 64; C = (st & 1) * 32 + (swz % 64) / 2; }
__host__ __device__ __forceinline__ int perm32(int rho) { const int n = rho >> 4, i = rho & 15; return 8 * (i >> 2) + 4 * n + (i & 3); }

struct Unit { int pm, pn; };
struct Gemm { const bf16_t* A; const bf16_t* Bt; int M, N, K; size_t vbytes; };
__host__ __device__ __forceinline__ int panel_sel(int pm) { return pm < 64 ? 0 : (pm < 128 ? 1 : 2); }

struct StaticOrder {
    int nM, nN, nwg, G, c;
    __host__ __device__ void init(int M, int N, int G_, int c_) { nM = M / BM; nN = N / BM; nwg = nM * nN; G = G_; c = c_; }
    __host__ __device__ bool next(int i, Unit& u) const {
        const long L = (long)i * G + c; if (L >= nwg) return false;
        int wgid = (int)L; { const int q = nwg / NXCD, r = nwg % NXCD, xcd = wgid % NXCD, off = wgid / NXCD; wgid = (xcd < r ? xcd * (q + 1) : r * (q + 1) + (xcd - r) * q) + off; }
        const int nig = WGM * nN, gid = wgid / nig, fm = gid * WGM, gsz = (nM - fm) < WGM ? (nM - fm) : WGM;
        u.pm = fm + ((wgid % nig) % gsz); u.pn = (wgid % nig) / gsz; return true;
    }
    __device__ __forceinline__ void a_ready(const Unit&) const {}
    __device__ __forceinline__ void done(const Unit&) const {}
};

__device__ __forceinline__ unsigned cvt_pk_bf16(float lo, float hi) { unsigned r; asm volatile("v_cvt_pk_bf16_f32 %0, %1, %2" : "=v"(r) : "v"(lo), "v"(hi)); return r; }

struct EpiStoreBf16 {
    static constexpr bool PERM = true, AFTER_DRAIN = false;
    bf16_t* O; int ldc;
    __device__ __forceinline__ void operator()(const f32x4 (&acc)[2][2][4][2], const Unit& u, int wr, int wc, int fr, int fq) const {
        const int row0 = u.pm * BM + wr * 64 + fr, col0 = u.pn * BM + wc * 32 + 8 * fq;
#pragma unroll
        for (int ai = 0; ai < 2; ++ai)
#pragma unroll
            for (int m = 0; m < 4; ++m) { bf16_t* rowp = O + (size_t)(row0 + ai * HALF + m * 16) * ldc + col0;
#pragma unroll
                for (int bj = 0; bj < 2; ++bj) { const f32x4 v0 = acc[ai][bj][m][0], v1 = acc[ai][bj][m][1];
                    u32x4 w; w.x = cvt_pk_bf16(v0[0], v0[1]); w.y = cvt_pk_bf16(v0[2], v0[3]); w.z = cvt_pk_bf16(v1[0], v1[1]); w.w = cvt_pk_bf16(v1[2], v1[3]);
                    *(u32x4*)(rowp + bj * HALF) = w; } }
    }
};
__device__ __forceinline__ float sq8_bf16(const u32x4 w) {
    float s = 0.f;
#pragma unroll
    for (int i = 0; i < 4; ++i) { const float lo = __uint_as_float(w[i] << 16), hi = __uint_as_float(w[i] & 0xffff0000u); s = __builtin_fmaf(lo, lo, s); s = __builtin_fmaf(hi, hi, s); }
    return s; }
__device__ __forceinline__ float x4sum(float x) {
    auto s = __builtin_amdgcn_permlane16_swap(__float_as_uint(x), __float_as_uint(x), false, false); x = __uint_as_float(s[0]) + __uint_as_float(s[1]);
    auto t = __builtin_amdgcn_permlane32_swap(__float_as_uint(x), __float_as_uint(x), false, false); return __uint_as_float(t[0]) + __uint_as_float(t[1]); }
template <int NSS> struct EpiScaleBias {
    static constexpr bool PERM = true, AFTER_DRAIN = false;
    bf16_t* O; int ldc; const float* ssp; const float* bias; int hm_rows;
    __device__ __forceinline__ void operator()(const f32x4 (&acc)[2][2][4][2], const Unit& u, int wr, int wc, int fr, int fq) const {
        const int row0 = u.pm * BM + wr * 64 + fr, col0 = u.pn * BM + wc * 32 + 8 * fq;
        const float* bp = bias + (size_t)panel_sel(u.pm) * 2 * ldc + col0;
        f32x4 bv[2][2];
#pragma unroll
        for (int bj = 0; bj < 2; ++bj)
#pragma unroll
            for (int n = 0; n < 2; ++n) bv[bj][n] = *(const f32x4*)(bp + bj * HALF + 4 * n) + *(const f32x4*)(bp + ldc + bj * HALF + 4 * n);
#pragma unroll
        for (int ai = 0; ai < 2; ++ai) {
            float rs[4];
#pragma unroll
            for (int m = 0; m < 4; ++m) { const float* sp = ssp + (size_t)(row0 + ai * HALF + m * 16) * NSS + (NSS / 4) * fq; float sq;
                if constexpr (NSS == 16) { const f32x4 pv = *(const f32x4*)sp; sq = (pv[0] + pv[1]) + (pv[2] + pv[3]); } else sq = sp[0];
                sq = x4sum(sq);
                rs[m] = __builtin_amdgcn_rsqf(sq * (1.0f / 1024.0f) + 1e-6f); }
#pragma unroll
            for (int m = 0; m < 4; ++m) { const int row = row0 + ai * HALF + m * 16;
                bf16_t* rowp = (NSS == 16) ? O + ((size_t)u.pn * hm_rows + row) * BM + (col0 - u.pn * BM) : O + (size_t)row * ldc + col0;
#pragma unroll
                for (int bj = 0; bj < 2; ++bj) { const f32x4 v0 = rs[m] * acc[ai][bj][m][0] + bv[bj][0], v1 = rs[m] * acc[ai][bj][m][1] + bv[bj][1];
                    u32x4 w; w.x = cvt_pk_bf16(v0[0], v0[1]); w.y = cvt_pk_bf16(v0[2], v0[3]); w.z = cvt_pk_bf16(v1[0], v1[1]); w.w = cvt_pk_bf16(v1[2], v1[3]);
                    *(u32x4*)(rowp + bj * HALF) = w; } }
        }
    }
};
struct EpiResid {
    static constexpr bool PERM = true, AFTER_DRAIN = false;
    bf16_t* X; const float* Xlat; const float* Xctx; int ldc; const float* gate; int gate_stride; float* ssp;
    __device__ __forceinline__ void operator()(const f32x4 (&acc)[2][2][4][2], const Unit& u, int wr, int wc, int fr, int fq) const {
        const int row0 = u.pm * BM + wr * 64 + fr, col0 = u.pn * BM + wc * 32 + 8 * fq;
        const float* gp = gate + (size_t)(u.pm < 64 ? 0 : (u.pm < 128 ? 1 : 2)) * gate_stride + col0;
        f32x4 gv[2][2];
#pragma unroll
        for (int bj = 0; bj < 2; ++bj)
#pragma unroll
            for (int n = 0; n < 2; ++n) gv[bj][n] = *(const f32x4*)(gp + bj * HALF + 4 * n);
        float sq[2][4] = {{0.f, 0.f, 0.f, 0.f}, {0.f, 0.f, 0.f, 0.f}};
        if (Xlat != nullptr) {
#pragma unroll
            for (int am = 0; am < 2; ++am)
#pragma unroll
                for (int mh = 0; mh < 2; ++mh) {
                    f32x4 xv[2][2][2];
#pragma unroll
                    for (int m2 = 0; m2 < 2; ++m2) { const int row = row0 + am * HALF + (2 * mh + m2) * 16; const float* rowp = (u.pm < 128 ? Xlat + (size_t)row * ldc : Xctx + (size_t)(row - 32768) * ldc) + col0;
#pragma unroll
                        for (int bj = 0; bj < 2; ++bj)
#pragma unroll
                            for (int n = 0; n < 2; ++n) xv[m2][bj][n] = *(const f32x4*)(rowp + bj * HALF + 4 * n); }
#pragma unroll
                    for (int m2 = 0; m2 < 2; ++m2) { const int m = 2 * mh + m2; bf16_t* rowp = X + (size_t)(row0 + am * HALF + m * 16) * ldc + col0;
#pragma unroll
                        for (int bj = 0; bj < 2; ++bj) { const f32x4 v0 = xv[m2][bj][0] + gv[bj][0] * acc[am][bj][m][0], v1 = xv[m2][bj][1] + gv[bj][1] * acc[am][bj][m][1];
                            u32x4 w; w.x = cvt_pk_bf16(v0[0], v0[1]); w.y = cvt_pk_bf16(v0[2], v0[3]); w.z = cvt_pk_bf16(v1[0], v1[1]); w.w = cvt_pk_bf16(v1[2], v1[3]);
                            sq[am][m] += sq8_bf16(w);
                            *(u32x4*)(rowp + bj * HALF) = w; } }
                }
        } else {
#pragma unroll
            for (int am = 0; am < 2; ++am) {
                u32x4 xb[4][2];
#pragma unroll
                for (int m = 0; m < 4; ++m) { const bf16_t* rowp = X + (size_t)(row0 + am * HALF + m * 16) * ldc + col0;
#pragma unroll
                    for (int bj = 0; bj < 2; ++bj) xb[m][bj] = *(const u32x4*)(rowp + bj * HALF); }
#pragma unroll
                for (int m = 0; m < 4; ++m) { bf16_t* rowp = X + (size_t)(row0 + am * HALF + m * 16) * ldc + col0;
#pragma unroll
                    for (int bj = 0; bj < 2; ++bj) { const u32x4 b = xb[m][bj]; const f32x4 g0 = gv[bj][0], g1 = gv[bj][1], a0 = acc[am][bj][m][0], a1 = acc[am][bj][m][1];
                        u32x4 w;
                        w.x = cvt_pk_bf16(__uint_as_float(b.x << 16) + g0[0] * a0[0], __uint_as_float(b.x & 0xffff0000u) + g0[1] * a0[1]);
                        w.y = cvt_pk_bf16(__uint_as_float(b.y << 16) + g0[2] * a0[2], __uint_as_float(b.y & 0xffff0000u) + g0[3] * a0[3]);
                        w.z = cvt_pk_bf16(__uint_as_float(b.z << 16) + g1[0] * a1[0], __uint_as_float(b.z & 0xffff0000u) + g1[1] * a1[1]);
                        w.w = cvt_pk_bf16(__uint_as_float(b.w << 16) + g1[2] * a1[2], __uint_as_float(b.w & 0xffff0000u) + g1[3] * a1[3]);
                        sq[am][m] += sq8_bf16(w);
                        *(u32x4*)(rowp + bj * HALF) = w; } }
            }
        }
#pragma unroll
        for (int am = 0; am < 2; ++am)
#pragma unroll
            for (int m = 0; m < 4; ++m) { const float t = x4sum(sq[am][m]); if (fq == 0) ssp[(size_t)(row0 + am * HALF + m * 16) * 16 + 4 * u.pn + wc] = t; }
    }
};

template <class Epi, class Sched, bool STAMP = false>
__device__ __forceinline__ void gemm_phase(PG8_LAS unsigned char* lds, const Gemm g, const Sched& S, const Epi& E, unsigned long long* stamps) {
    int tid_ = hw_tid(); asm volatile("" : "+v"(tid_));
    const int tid = tid_, wid = __builtin_amdgcn_readfirstlane(tid >> 6), lane = tid & 63, wr = wid >> 2, wc = wid & 3, fr = lane & 15, fq = lane >> 4;
    const int K = g.K, nt = K / BK;
    int ts_lo = 0, ts_hi = 0, nts = 0; const unsigned long long rt_entry = STAMP ? (unsigned long long)wall_clock64() : 0ull;
#define PG8_STAMP() do { if (STAMP && wid == 0 && nts < 64) { const unsigned long long _c = (unsigned long long)clock64(); \
        ts_lo = (lane == nts) ? (int)(unsigned)_c : ts_lo; ts_hi = (lane == nts) ? (int)(unsigned)(_c >> 32) : ts_hi; ++nts; } } while (0)
    PG8_STAMP();
    unsigned voffA[2], voffB[2];
#pragma unroll
    for (int i = 0; i < 2; ++i) { int R, C; stage_rc(tid * 16 + i * 8192, R, C); const int Rb = Epi::PERM ? ((R & ~31) + perm32(R & 31)) : R;
        voffA[i] = (unsigned)(R * K + C) * 2u; voffB[i] = (unsigned)(Rb * K + C) * 2u; }
    const size_t kstep = (size_t)(BK * 2);
    const size_t hstep = (size_t)HALF * K * 2;
    const size_t tstep = 2 * hstep;
    const unsigned ldsw = (unsigned)wid * 1024u;
    const int aoff = lds_byte(wr * 64 + fr, fq * 8), boff = lds_byte(wc * 32 + fr, fq * 8);
#define PG8_SA(b, h) (((b) * 2 + (h)) * HTB)
#define PG8_SB(b, h) ((4 + (b) * 2 + (h)) * HTB)
#define PG8_STAGE(bufoff, gbase, voff) do { _Pragma("unroll") for (int _i = 0; _i < 2; ++_i) \
        __builtin_amdgcn_global_load_lds((const unsigned*)((const char*)(gbase) + (voff)[_i]), (PG8_LAS unsigned*)(lds + (bufoff) + ldsw + _i * 8192), 16, 0, 0); } while (0)
#define PG8_LDA(dst, b, h) do { _Pragma("unroll") for (int m = 0; m < 4; ++m) _Pragma("unroll") for (int k = 0; k < 2; ++k) dst[m][k] = *(const PG8_LAS bf16x8*)(lds + PG8_SA(b, h) + aoff + m * 2048 + k * 1024); } while (0)
#define PG8_LDB(dst, b, h) do { _Pragma("unroll") for (int n = 0; n < 2; ++n) _Pragma("unroll") for (int k = 0; k < 2; ++k) dst[n][k] = *(const PG8_LAS bf16x8*)(lds + PG8_SB(b, h) + boff + n * 2048 + k * 1024); } while (0)
#define PG8_MMA(ai, bj, At, Bt) do { __builtin_amdgcn_s_setprio(1); _Pragma("unroll") for (int m = 0; m < 4; ++m) _Pragma("unroll") for (int n = 0; n < 2; ++n) _Pragma("unroll") for (int k = 0; k < 2; ++k) \
        acc[ai][bj][m][n] = __builtin_amdgcn_mfma_f32_16x16x32_bf16(Bt[n][k], At[m][k], acc[ai][bj][m][n], 0, 0, 0); __builtin_amdgcn_s_setprio(0); } while (0)
#define PG8_WAIT_V(n) asm volatile("s_waitcnt vmcnt(" #n ")" ::: "memory")
#define PG8_WAIT_L(n) asm volatile("s_waitcnt lgkmcnt(" #n ")" ::: "memory")
#define PG8_BAR __builtin_amdgcn_s_barrier()
#define PG8_SCHED __builtin_amdgcn_sched_barrier(0)
    Unit cur, nxt; int ui = 0;
    if (!S.next(0, cur)) return;
    f32x4 acc[2][2][4][2];
#pragma unroll
    for (int a = 0; a < 2; ++a)
#pragma unroll
        for (int b = 0; b < 2; ++b)
#pragma unroll
            for (int m = 0; m < 4; ++m)
#pragma unroll
                for (int n = 0; n < 2; ++n) acc[a][b][m][n] = (f32x4){0.f, 0.f, 0.f, 0.f};
    bf16x8 At[4][2], B0[2][2], B1[2][2];
    const char* cA = (const char*)g.A + (size_t)cur.pm * tstep; const char* cB = (const char*)g.Bt + (size_t)cur.pn * tstep + (size_t)panel_sel(cur.pm) * g.vbytes;
    S.a_ready(cur);
    PG8_STAGE(PG8_SB(0, 0), cB, voffB); PG8_STAGE(PG8_SA(0, 0), cA, voffA); PG8_STAGE(PG8_SB(0, 1), cB + hstep, voffB); PG8_STAGE(PG8_SA(0, 1), cA + hstep, voffA);
    if (wr == 1) PG8_BAR;
    PG8_WAIT_V(4); PG8_BAR;
    PG8_STAGE(PG8_SB(1, 0), cB + kstep, voffB); PG8_STAGE(PG8_SA(1, 0), cA + kstep, voffA); PG8_STAGE(PG8_SB(1, 1), cB + hstep + kstep, voffB);
    PG8_WAIT_V(6); PG8_BAR;
    PG8_STAMP();
    for (;;) {
        const bool has_next = S.next(ui + 1, nxt);
        const char* nA = has_next ? (const char*)g.A + (size_t)nxt.pm * tstep : cA; const char* nB = has_next ? (const char*)g.Bt + (size_t)nxt.pn * tstep + (size_t)panel_sel(nxt.pm) * g.vbytes : cB;
        for (int t = 0; t < nt; t += 2) {
            const bool last = (t == nt - 2);
            const char* a1 = cA + (size_t)(t + 1) * kstep;
            const char* a2 = last ? nA : cA + (size_t)(t + 2) * kstep; const char* b2 = last ? nB : cB + (size_t)(t + 2) * kstep;
            const char* a3 = a2 + kstep; const char* b3 = b2 + kstep;
            if (last && has_next) S.a_ready(nxt);
            PG8_LDB(B0, 0, 0); PG8_SCHED; PG8_LDA(At, 0, 0); PG8_STAGE(PG8_SA(1, 1), a1 + hstep, voffA);
            PG8_WAIT_L(8); PG8_BAR; PG8_WAIT_L(0); PG8_MMA(0, 0, At, B0); PG8_BAR; PG8_SCHED;
            PG8_LDB(B1, 0, 1); PG8_STAGE(PG8_SB(0, 0), b2, voffB);
            PG8_BAR; PG8_WAIT_L(0); PG8_MMA(0, 1, At, B1); PG8_BAR;
            PG8_LDA(At, 0, 1); PG8_STAGE(PG8_SA(0, 0), a2, voffA);
            PG8_BAR; PG8_WAIT_L(0); PG8_MMA(1, 0, At, B0); PG8_BAR; PG8_SCHED;
            PG8_STAGE(PG8_SB(0, 1), b2 + hstep, voffB);
            PG8_WAIT_V(6); PG8_BAR; PG8_MMA(1, 1, At, B1); PG8_BAR;
            PG8_LDB(B0, 1, 0); PG8_SCHED; PG8_LDA(At, 1, 0); PG8_STAGE(PG8_SA(0, 1), a2 + hstep, voffA);
            PG8_WAIT_L(8); PG8_BAR; PG8_WAIT_L(0); PG8_MMA(0, 0, At, B0); PG8_BAR; PG8_SCHED;
            PG8_LDB(B1, 1, 1); PG8_STAGE(PG8_SB(1, 0), b3, voffB);
            PG8_BAR; PG8_WAIT_L(0); PG8_MMA(0, 1, At, B1); PG8_BAR;
            PG8_LDA(At, 1, 1); PG8_STAGE(PG8_SA(1, 0), a3, voffA);
            PG8_BAR; PG8_WAIT_L(0); PG8_MMA(1, 0, At, B0); PG8_BAR; PG8_SCHED;
            PG8_STAGE(PG8_SB(1, 1), b3 + hstep, voffB);
            PG8_WAIT_V(6); PG8_BAR; PG8_MMA(1, 1, At, B1); PG8_BAR;
        }
        PG8_STAMP();
        if constexpr (!Epi::AFTER_DRAIN) { E(acc, cur, wr, wc, fr, fq); S.done(cur); }
        PG8_STAMP();
        if (!has_next) break;
#pragma unroll
        for (int a = 0; a < 2; ++a)
#pragma unroll
            for (int b = 0; b < 2; ++b)
#pragma unroll
                for (int m = 0; m < 4; ++m)
#pragma unroll
                    for (int n = 0; n < 2; ++n) acc[a][b][m][n] = (f32x4){0.f, 0.f, 0.f, 0.f};
        cur = nxt; cA = nA; cB = nB; ++ui;
    }
    PG8_WAIT_V(0);
    if (wr == 0) PG8_BAR;
    PG8_BAR;
    if constexpr (Epi::AFTER_DRAIN) { E.fused(acc, cur, wr, wc, fr, fq, lds, wid, lane); S.done(cur); }
    PG8_STAMP();
    if (STAMP && wid == 0) { stamps[lane] = lane < nts ? (((unsigned long long)(unsigned)ts_hi << 32) | (unsigned)ts_lo) : 0ull;
        if (lane == 62) stamps[62] = rt_entry; if (lane == 63) stamps[63] = (unsigned long long)wall_clock64(); }
#undef PG8_STAMP
#undef PG8_SA
#undef PG8_SB
#undef PG8_STAGE
#undef PG8_LDA
#undef PG8_LDB
#undef PG8_MMA
#undef PG8_WAIT_V
#undef PG8_WAIT_L
#undef PG8_BAR
#undef PG8_SCHED
}
}

#define LAS __attribute__((address_space(3)))
typedef unsigned short bf16_t;
constexpr int D = 1024, T = 16384, NLAT = 32768, CTXL = 256, NTOK = 33280, DEPTH = 4;
constexpr int IN_W = 2816, QW = 2048;
constexpr int C_GB = 0, C_GC = 256, C_XI = 512, C_SU = 768, C_SV = 1024, C_Q = 1280, C_K = 1792, C_V = 2304;
constexpr int MODW = 6144;
constexpr float EPS = 1e-6f;
constexpr int NTHR = 512, NWAVE = 8;
constexpr int ST_OFF = 131072 + 1024 + 20480 + 2048;
constexpr int LDS_BYTES = ST_OFF + 1024;

constexpr size_t MiB = 1u << 20;
constexpr size_t WS_CTL = 0;
constexpr size_t WS_MOD = 1 * MiB;
constexpr size_t WS_US = 1 * MiB + 512 * 1024;
constexpr size_t WS_VS = 1 * MiB + 768 * 1024;
constexpr size_t WS_WIN = 2 * MiB;
constexpr size_t WS_WOUT = WS_WIN + 22 * MiB;
constexpr size_t WS_WQ = WS_WOUT + 8 * MiB;
constexpr size_t WS_SUBK = WS_WQ + 16 * MiB;
constexpr size_t TSLICE = (size_t)16384 * 128;
constexpr size_t WS_UT = WS_SUBK + 2 * MiB;
constexpr size_t WS_VT = WS_UT + 128 * MiB;
constexpr size_t WS_XRES = WS_VT + 128 * MiB;
constexpr size_t WS_H = WS_XRES + 130 * MiB;
constexpr size_t WS_PROJ = WS_H + 65 * MiB;
constexpr size_t WS_H4 = WS_PROJ + 96 * MiB;
constexpr size_t WS_PW4 = WS_PROJ + 150 * MiB;
constexpr size_t WS_YCAT = WS_PROJ + 179 * MiB;
constexpr size_t WS_Q = WS_YCAT + 65 * MiB;
constexpr size_t WS_PIDX = WS_Q + 130 * MiB;
constexpr size_t WS_PG = WS_PIDX + 17 * MiB;
constexpr size_t WS_SGUW = WS_PG + 16 * MiB + 512 * 1024;
constexpr size_t WS_END = WS_PG + 17 * MiB;
constexpr size_t WS_WIN3 = WS_UT + 32 * MiB;
constexpr size_t WS_BIASP = WS_XRES + 65 * MiB;
constexpr size_t WS_WQ3 = WS_VT + 32 * MiB;
constexpr size_t WS_BIASP2 = WS_XRES + 65 * MiB + 512 * 1024;
constexpr size_t WS_SSP2 = WS_XRES + 70 * MiB;
constexpr size_t WS_SSP = WS_XRES + 66 * MiB;

struct P {
    const float *x, *c, *ctx, *c_ctx, *ada_w, *ada_b, *norm1_g, *w_in, *conv_w, *sgu_w, *sgu_b, *sgu_norm_g, *na_rpb, *out_norm_g, *w_out, *norm2_g,
                *peer_wq, *peer_subkeys, *peer_u, *peer_v, *final_norm_g;
    float* out; unsigned char* ws;
};

__device__ __forceinline__ float bf_lo(unsigned u) { return __uint_as_float(u << 16); }
__device__ __forceinline__ float bf_hi(unsigned u) { return __uint_as_float(u & 0xffff0000u); }
__device__ __forceinline__ float bf1(bf16_t b) { return __uint_as_float(((unsigned)b) << 16); }
__device__ __forceinline__ unsigned pk_bf16(float lo, float hi) { return pg8::cvt_pk_bf16(lo, hi); }
__device__ __forceinline__ float wave_sum(float v) {
#pragma unroll
    for (int o = 32; o >= 1; o >>= 1) v += __shfl_xor(v, o);
    return v; }
__device__ __forceinline__ float wave_max(float v) {
#pragma unroll
    for (int o = 32; o >= 1; o >>= 1) v = fmaxf(v, __shfl_xor(v, o));
    return v; }
__device__ __forceinline__ float gelu_tanh(float x) {
    const float y = 0.7978845608f * (x + 0.044715f * x * x * x);
    const float e = __expf(2.0f * y);
    const float th = 1.0f - 2.0f * __builtin_amdgcn_rcpf(1.0f + e);
    return 0.5f * x * (1.0f + th); }
__device__ __forceinline__ void unpack8(const uint4 v, float (&f)[8]) {
    f[0] = bf_lo(v.x); f[1] = bf_hi(v.x); f[2] = bf_lo(v.y); f[3] = bf_hi(v.y); f[4] = bf_lo(v.z); f[5] = bf_hi(v.z); f[6] = bf_lo(v.w); f[7] = bf_hi(v.w); }
__device__ __forceinline__ float dot8(const uint4 a, const uint4 b, float acc) {
    acc = fmaf(bf_lo(a.x), bf_lo(b.x), acc); acc = fmaf(bf_hi(a.x), bf_hi(b.x), acc);
    acc = fmaf(bf_lo(a.y), bf_lo(b.y), acc); acc = fmaf(bf_hi(a.y), bf_hi(b.y), acc);
    acc = fmaf(bf_lo(a.z), bf_lo(b.z), acc); acc = fmaf(bf_hi(a.z), bf_hi(b.z), acc);
    acc = fmaf(bf_lo(a.w), bf_lo(b.w), acc); acc = fmaf(bf_hi(a.w), bf_hi(b.w), acc);
    return acc; }
__device__ __forceinline__ int row_sel(int r) { return r < T ? 0 : (r < NLAT ? 1 : 2); }

constexpr int WTAB_WORD = 64;
__device__ __forceinline__ int hw_tid() {
    extern __shared__ __attribute__((aligned(16))) unsigned char shm_t[];
    const unsigned slot = (unsigned)__builtin_amdgcn_s_getreg((5 << 11) | 4);
    const unsigned w = ((volatile LAS unsigned*)((LAS unsigned char*)shm_t + ST_OFF))[WTAB_WORD + slot];
    unsigned lane; asm volatile("v_mbcnt_lo_u32_b32 %0, -1, 0\n\tv_mbcnt_hi_u32_b32 %0, -1, %0" : "=v"(lane));
    return (int)((__builtin_amdgcn_readfirstlane(w) << 6) | lane); }
__device__ __forceinline__ int otid() { int t = hw_tid(); asm volatile("" : "+v"(t)); return t; }

__device__ __forceinline__ int obid() { int b = (int)blockIdx.x; asm volatile("" : "+s"(b)); return b; }
__device__ __forceinline__ int ogrid() { int g = (int)gridDim.x; asm volatile("" : "+s"(g)); return g; }
__device__ __forceinline__ int owave() { return __builtin_amdgcn_readfirstlane(otid() >> 6); }

__device__ __forceinline__ void transpose_cvt(const float* src, int K, int N, bf16_t* dst, LAS float* tile) {
    const int tid = otid(), tn = N / 64, ntile = (K / 64) * tn;
    const int kk = tid >> 4, nn = (tid & 15) * 4;
    float4 v[2];
    if (obid() < ntile) { const int k0 = (obid() / tn) * 64, n0 = (obid() % tn) * 64;
#pragma unroll
        for (int i = 0; i < 2; ++i) v[i] = *(const float4*)(src + (size_t)(k0 + kk + 32 * i) * N + n0 + nn); }
    for (int t = obid(); t < ntile; t += ogrid()) {
        const int k0 = (t / tn) * 64, n0 = (t % tn) * 64;
#pragma unroll
        for (int i = 0; i < 2; ++i) { const int k = kk + 32 * i;
            tile[k * 65 + nn + 0] = v[i].x; tile[k * 65 + nn + 1] = v[i].y; tile[k * 65 + nn + 2] = v[i].z; tile[k * 65 + nn + 3] = v[i].w; }
        __syncthreads();
        { const int t2 = t + ogrid();
          if (t2 < ntile) { const int k2 = (t2 / tn) * 64, n2 = (t2 % tn) * 64;
#pragma unroll
              for (int i = 0; i < 2; ++i) v[i] = *(const float4*)(src + (size_t)(k2 + kk + 32 * i) * N + n2 + nn); } }
        const int n = tid >> 3, kc = (tid & 7) * 8;
        uint4 w;
        w.x = pk_bf16(tile[(kc + 0) * 65 + n], tile[(kc + 1) * 65 + n]); w.y = pk_bf16(tile[(kc + 2) * 65 + n], tile[(kc + 3) * 65 + n]);
        w.z = pk_bf16(tile[(kc + 4) * 65 + n], tile[(kc + 5) * 65 + n]); w.w = pk_bf16(tile[(kc + 6) * 65 + n], tile[(kc + 7) * 65 + n]);
        *(uint4*)(dst + (size_t)(n0 + n) * K + k0 + kc) = w;
        __syncthreads();
    }
}
__device__ __forceinline__ void cvt_copy(const float* src, bf16_t* dst, size_t n) {
    const size_t stride = (size_t)ogrid() * NTHR;
    for (size_t i = (size_t)obid() * NTHR + otid(); i < n / 8; i += stride) {
        const float4 a = ((const float4*)src)[2 * i], b = ((const float4*)src)[2 * i + 1];
        uint4 w; w.x = pk_bf16(a.x, a.y); w.y = pk_bf16(a.z, a.w); w.z = pk_bf16(b.x, b.y); w.w = pk_bf16(b.z, b.w);
        ((uint4*)dst)[i] = w; }
}
typedef float f32x2_t __attribute__((ext_vector_type(2)));
__device__ __forceinline__ void quant_rows_fp4(const float* src, unsigned char* dst, float* scale, int nrows) {
    const int lane = otid() & 63, gw = obid() * NWAVE + owave(), nw = ogrid() * NWAVE;
    float4 nx[4];
    { const float4* sp = (const float4*)(src + (size_t)(gw < nrows ? gw : 0) * 1024 + lane * 16); nx[0] = sp[0]; nx[1] = sp[1]; nx[2] = sp[2]; nx[3] = sp[3]; }
    for (int r = gw; r < nrows; r += nw) {
        const float4 a = nx[0], b = nx[1], c = nx[2], d = nx[3];
        { const int r2 = (r + nw < nrows) ? r + nw : r; const float4* sp = (const float4*)(src + (size_t)r2 * 1024 + lane * 16); nx[0] = sp[0]; nx[1] = sp[1]; nx[2] = sp[2]; nx[3] = sp[3]; }
        float m = fmaxf(fmaxf(fmaxf(fabsf(a.x), fabsf(a.y)), fmaxf(fabsf(a.z), fabsf(a.w))), fmaxf(fmaxf(fabsf(b.x), fabsf(b.y)), fmaxf(fabsf(b.z), fabsf(b.w))));
        m = fmaxf(m, fmaxf(fmaxf(fmaxf(fabsf(c.x), fabsf(c.y)), fmaxf(fabsf(c.z), fabsf(c.w))), fmaxf(fmaxf(fabsf(d.x), fabsf(d.y)), fmaxf(fabsf(d.z), fabsf(d.w)))));
        m = wave_max(m); m = fmaxf(m, 1e-30f);
        const float inv = 6.0f / m;
        unsigned w0 = 0u, w1 = 0u;
        w0 = __builtin_amdgcn_cvt_scalef32_pk_fp4_f32(w0, a.x * inv, a.y * inv, 1.0f, 0); w0 = __builtin_amdgcn_cvt_scalef32_pk_fp4_f32(w0, a.z * inv, a.w * inv, 1.0f, 1);
        w0 = __builtin_amdgcn_cvt_scalef32_pk_fp4_f32(w0, b.x * inv, b.y * inv, 1.0f, 2); w0 = __builtin_amdgcn_cvt_scalef32_pk_fp4_f32(w0, b.z * inv, b.w * inv, 1.0f, 3);
        w1 = __builtin_amdgcn_cvt_scalef32_pk_fp4_f32(w1, c.x * inv, c.y * inv, 1.0f, 0); w1 = __builtin_amdgcn_cvt_scalef32_pk_fp4_f32(w1, c.z * inv, c.w * inv, 1.0f, 1);
        w1 = __builtin_amdgcn_cvt_scalef32_pk_fp4_f32(w1, d.x * inv, d.y * inv, 1.0f, 2); w1 = __builtin_amdgcn_cvt_scalef32_pk_fp4_f32(w1, d.z * inv, d.w * inv, 1.0f, 3);
        *(uint2*)(dst + (size_t)(lane >> 4) * TSLICE + (size_t)r * 128 + (lane & 15) * 8) = make_uint2(w0, w1);
        if (lane == 0) scale[r] = m * (1.0f / 6.0f);
    }
}
__device__ __forceinline__ void phase_prologue(const P& p, LAS unsigned char* lds) {
    unsigned char* ws = p.ws;
    transpose_cvt(p.w_in, D, IN_W, (bf16_t*)(ws + WS_WIN), (LAS float*)lds);
    transpose_cvt(p.w_out, D, D, (bf16_t*)(ws + WS_WOUT), (LAS float*)lds);
    cvt_copy(p.peer_subkeys, (bf16_t*)(ws + WS_SUBK), (size_t)DEPTH * 8 * 2 * 128 * 128);
    cvt_copy(p.sgu_w, (bf16_t*)(ws + WS_SGUW), (size_t)DEPTH * 4 * 128 * 128);
    quant_rows_fp4(p.peer_u, ws + WS_UT, (float*)(ws + WS_US), 16384);
    quant_rows_fp4(p.peer_v, ws + WS_VT, (float*)(ws + WS_VS), 16384);
}
constexpr int DEF_NCHUNK = 256 + 184;
__device__ __forceinline__ void deferred_chunk(const P& p, int L, int c, LAS unsigned char* lds) {
    unsigned char* ws = p.ws;
    const int tid = otid(), wave = __builtin_amdgcn_readfirstlane(tid >> 6), lane = tid & 63;
    if (c < 256) {
        const bool isv = c >= 128; const int row0 = (c & 127) * 128 + wave * 16;
        const float* src = (isv ? p.peer_v : p.peer_u) + ((size_t)L * 16384 + row0) * 1024 + lane * 16;
        unsigned char* dst = ws + (isv ? WS_VT : WS_UT) + (size_t)L * 16384 * 512 + (size_t)(lane >> 4) * TSLICE + (size_t)row0 * 128 + (lane & 15) * 8;
        float* scale = (float*)(ws + (isv ? WS_VS : WS_US)) + (size_t)L * 16384 + row0;
        for (int r4 = 0; r4 < 16; r4 += 4) {
            float4 x[4][4];
#pragma unroll
            for (int q = 0; q < 4; ++q) { const float4* sp = (const float4*)(src + (size_t)(r4 + q) * 1024); x[q][0] = sp[0]; x[q][1] = sp[1]; x[q][2] = sp[2]; x[q][3] = sp[3]; }
#pragma unroll
            for (int q = 0; q < 4; ++q) {
                const float4 a = x[q][0], b = x[q][1], cc = x[q][2], d = x[q][3];
                float m = fmaxf(fmaxf(fmaxf(fabsf(a.x), fabsf(a.y)), fmaxf(fabsf(a.z), fabsf(a.w))), fmaxf(fmaxf(fabsf(b.x), fabsf(b.y)), fmaxf(fabsf(b.z), fabsf(b.w))));
                m = fmaxf(m, fmaxf(fmaxf(fmaxf(fabsf(cc.x), fabsf(cc.y)), fmaxf(fabsf(cc.z), fabsf(cc.w))), fmaxf(fmaxf(fabsf(d.x), fabsf(d.y)), fmaxf(fabsf(d.z), fabsf(d.w)))));
                m = wave_max(m); m = fmaxf(m, 1e-30f);
                const float inv = 6.0f / m;
                unsigned w0 = 0u, w1 = 0u;
                w0 = __builtin_amdgcn_cvt_scalef32_pk_fp4_f32(w0, a.x * inv, a.y * inv, 1.0f, 0); w0 = __builtin_amdgcn_cvt_scalef32_pk_fp4_f32(w0, a.z * inv, a.w * inv, 1.0f, 1);
                w0 = __builtin_amdgcn_cvt_scalef32_pk_fp4_f32(w0, b.x * inv, b.y * inv, 1.0f, 2); w0 = __builtin_amdgcn_cvt_scalef32_pk_fp4_f32(w0, b.z * inv, b.w * inv, 1.0f, 3);
                w1 = __builtin_amdgcn_cvt_scalef32_pk_fp4_f32(w1, cc.x * inv, cc.y * inv, 1.0f, 0); w1 = __builtin_amdgcn_cvt_scalef32_pk_fp4_f32(w1, cc.z * inv, cc.w * inv, 1.0f, 1);
                w1 = __builtin_amdgcn_cvt_scalef32_pk_fp4_f32(w1, d.x * inv, d.y * inv, 1.0f, 2); w1 = __builtin_amdgcn_cvt_scalef32_pk_fp4_f32(w1, d.z * inv, d.w * inv, 1.0f, 3);
                *(uint2*)(dst + (size_t)(r4 + q) * 128) = make_uint2(w0, w1);
                if (lane == 0) scale[r4 + q] = m * (1.0f / 6.0f);
            }
        }
    } else {
        LAS float* tile = (LAS float*)lds;
        const int kk = tid >> 4, nn = (tid & 15) * 4, n = tid >> 3, kc = (tid & 7) * 8;
        auto tile_of = [&](int q, const float*& src, bf16_t*& dst, int& N, int& k0, int& n0) { int t = (c - 256) * 8 + q;
            if (t < 704) { src = p.w_in + (size_t)L * D * IN_W; dst = (bf16_t*)(ws + WS_WIN3) + (size_t)(L - 1) * 3 * IN_W * D; N = IN_W; k0 = (t & 15) * 64; n0 = (t >> 4) * 64; return; }
            else if (t < 960) { t -= 704; src = p.w_out + (size_t)L * D * D; dst = (bf16_t*)(ws + WS_WOUT) + (size_t)L * D * D; N = D; }
            else { t -= 960; src = p.peer_wq + (size_t)L * D * QW; dst = (bf16_t*)(ws + WS_WQ3) + (size_t)L * 3 * QW * D; N = QW; k0 = (t & 15) * 64; n0 = (t >> 4) * 64; return; }
            const int tn = N / 64; k0 = (t / tn) * 64; n0 = (t % tn) * 64; };
        const int t0_ = (c - 256) * 8;
        const bool isq = t0_ >= 960, win = t0_ < 704 || isq;
        const float* gvec = (isq ? p.norm2_g : p.norm1_g) + (size_t)L * D; const int modoff = isq ? 3 * D : 0, Nw = isq ? QW : IN_W;
        float bacc[3] = {0.f, 0.f, 0.f};
        float4 v[2];
        { const float* src; bf16_t* dst; int N, k0, n0; tile_of(0, src, dst, N, k0, n0);
#pragma unroll
          for (int i = 0; i < 2; ++i) v[i] = *(const float4*)(src + (size_t)(k0 + kk + 32 * i) * N + n0 + nn); }
        for (int q = 0; q < 8; ++q) {
            const float* src; bf16_t* dst; int N, k0, n0; tile_of(q, src, dst, N, k0, n0);
#pragma unroll
            for (int i = 0; i < 2; ++i) { const int k = kk + 32 * i; tile[k * 65 + nn + 0] = v[i].x; tile[k * 65 + nn + 1] = v[i].y; tile[k * 65 + nn + 2] = v[i].z; tile[k * 65 + nn + 3] = v[i].w; }
            __syncthreads();
            if (q + 1 < 8) { const float* s2; bf16_t* d2; int N2, k2, n2; tile_of(q + 1, s2, d2, N2, k2, n2);
#pragma unroll
                for (int i = 0; i < 2; ++i) v[i] = *(const float4*)(s2 + (size_t)(k2 + kk + 32 * i) * N2 + n2 + nn); }
            float tv[8];
#pragma unroll
            for (int i = 0; i < 8; ++i) tv[i] = tile[(kc + i) * 65 + n];
            if (win) {
                const float4 g0 = *(const float4*)(gvec + k0 + kc), g1 = *(const float4*)(gvec + k0 + kc + 4);
#pragma unroll
                for (int m = 0; m < 3; ++m) { const float* mr = (const float*)(ws + WS_MOD) + (size_t)(L * 3 + m) * MODW + modoff + k0 + kc;
                    const float4 h0 = *(const float4*)mr, h1 = *(const float4*)(mr + 4), c0 = *(const float4*)(mr + D), c1 = *(const float4*)(mr + D + 4);
                    uint4 w;
                    w.x = pk_bf16(tv[0] * (g0.x * (1.0f + c0.x)), tv[1] * (g0.y * (1.0f + c0.y))); w.y = pk_bf16(tv[2] * (g0.z * (1.0f + c0.z)), tv[3] * (g0.w * (1.0f + c0.w)));
                    w.z = pk_bf16(tv[4] * (g1.x * (1.0f + c1.x)), tv[5] * (g1.y * (1.0f + c1.y))); w.w = pk_bf16(tv[6] * (g1.z * (1.0f + c1.z)), tv[7] * (g1.w * (1.0f + c1.w)));
                    *(uint4*)(dst + ((size_t)m * Nw + n0 + n) * D + k0 + kc) = w;
                    bacc[m] += ((tv[0] * h0.x + tv[1] * h0.y) + (tv[2] * h0.z + tv[3] * h0.w)) + ((tv[4] * h1.x + tv[5] * h1.y) + (tv[6] * h1.z + tv[7] * h1.w)); }
            } else {
                uint4 w;
                w.x = pk_bf16(tv[0], tv[1]); w.y = pk_bf16(tv[2], tv[3]); w.z = pk_bf16(tv[4], tv[5]); w.w = pk_bf16(tv[6], tv[7]);
                *(uint4*)(dst + (size_t)(n0 + n) * D + k0 + kc) = w; }
            __syncthreads();
        }
        if (win) {
            const int t0 = t0_ - (isq ? 960 : 0), n0 = (t0 >> 4) * 64, half = (t0 >> 3) & 1; float* bp_ = (float*)(ws + (isq ? WS_BIASP2 : WS_BIASP));
#pragma unroll
            for (int m = 0; m < 3; ++m) { float b = bacc[m]; b += __shfl_xor(b, 1); b += __shfl_xor(b, 2); b += __shfl_xor(b, 4);
                if ((tid & 7) == 0) bp_[((size_t)(L * 3 + m) * 2 + half) * Nw + n0 + n] = b; }
        }
    }
}
__device__ __forceinline__ void deferred_drain(const P& p, int L, LAS unsigned char* lds, int quota) {
    if (L >= DEPTH) return;
    volatile LAS unsigned* st = (volatile LAS unsigned*)(lds + ST_OFF);
    unsigned* ctr = (unsigned*)(p.ws + WS_CTL) + 6144 + 64 * L;
    for (int n = 0; n < quota; ++n) {
        __syncthreads();
        if (hw_tid() == 0) st[12] = __hip_atomic_fetch_add(ctr, 1u, __ATOMIC_RELAXED, __HIP_MEMORY_SCOPE_AGENT);
        __syncthreads();
        const int c = (int)st[12];
        if (c >= DEF_NCHUNK) break;
        deferred_chunk(p, L, c, lds);
    }
    __syncthreads();
}
__device__ __forceinline__ void phase_adaln(const P& p, LAS unsigned char* lds) {
    LAS float* sl = (LAS float*)lds; LAS float* part = sl + 3072;
    const int tid = otid(), wave = __builtin_amdgcn_readfirstlane(tid >> 6), lane = tid & 63;
    for (int i = tid; i < 3072; i += NTHR) { const int m = i >> 10, j = i & 1023; const float cv = (m < 2) ? p.c[m * 1024 + j] : p.c_ctx[j]; sl[i] = cv / (1.0f + __expf(-cv)); }
    __syncthreads();
    float* MOD = (float*)(p.ws + WS_MOD);
    const int rs = lane < 24 ? 0 : 1, c4 = lane < 24 ? lane : (lane < 48 ? lane - 24 : lane - 48);
    for (int item = obid(); item < DEPTH * 64; item += ogrid()) {
        const int l = item >> 6, j0 = (item & 63) * 96;
        const float* W = p.ada_w + (size_t)l * D * MODW + j0 + 4 * c4 + (size_t)(wave * 128 + rs) * MODW;
        LAS const float* s0 = sl + wave * 128 + rs;
        float4 a0 = make_float4(0.f, 0.f, 0.f, 0.f), a1 = a0, a2 = a0;
#pragma unroll 16
        for (int i = 0; i < 64; ++i) { const float4 w = *(const float4*)(W + (size_t)(2 * i) * MODW); const float x0 = s0[2 * i], x1 = s0[1024 + 2 * i], x2 = s0[2048 + 2 * i];
            a0.x = fmaf(x0, w.x, a0.x); a0.y = fmaf(x0, w.y, a0.y); a0.z = fmaf(x0, w.z, a0.z); a0.w = fmaf(x0, w.w, a0.w);
            a1.x = fmaf(x1, w.x, a1.x); a1.y = fmaf(x1, w.y, a1.y); a1.z = fmaf(x1, w.z, a1.z); a1.w = fmaf(x1, w.w, a1.w);
            a2.x = fmaf(x2, w.x, a2.x); a2.y = fmaf(x2, w.y, a2.y); a2.z = fmaf(x2, w.z, a2.z); a2.w = fmaf(x2, w.w, a2.w); }
        if (lane < 48) { LAS float* pp = part + (size_t)((wave * 2 + rs) * 3) * 96 + 4 * c4;
            pp[0] = a0.x; pp[1] = a0.y; pp[2] = a0.z; pp[3] = a0.w; pp[96] = a1.x; pp[97] = a1.y; pp[98] = a1.z; pp[99] = a1.w; pp[192] = a2.x; pp[193] = a2.y; pp[194] = a2.z; pp[195] = a2.w; }
        __syncthreads();
        if (tid < 288) { const int m = tid / 96, c = tid - 96 * m; float sum = 0.f;
#pragma unroll
            for (int g = 0; g < 16; ++g) sum += part[(g * 3 + m) * 96 + c];
            MOD[(size_t)(l * 3 + m) * MODW + j0 + c] = sum + p.ada_b[l * MODW + j0 + c]; }
        __syncthreads();
    }
}
__device__ __forceinline__ void phase_norm(const P& p, int l, int which) {
    const float* g = (which ? p.norm2_g : p.norm1_g) + l * D;
    const float* mod = (const float*)(p.ws + WS_MOD) + (size_t)l * 3 * MODW + (which ? 3 * D : 0);
    const bf16_t* X = (const bf16_t*)(p.ws + WS_XRES); bf16_t* H = (bf16_t*)(p.ws + WS_H);
    const int lane = otid() & 63, gw = obid() * NWAVE + owave(), nw = ogrid() * NWAVE;
    const int nrow = (which == 1 && l == DEPTH - 1) ? NLAT : NTOK;
    const bool first = (l == 0 && which == 0);
    for (int r = gw; r < nrow; r += nw) {
        const float* xr = r < NLAT ? p.x + (size_t)r * D : p.ctx + (size_t)(r - NLAT) * D; const bf16_t* xb = X + (size_t)r * D; const float* mr = mod + (size_t)row_sel(r) * MODW;
        float4 v[4]; float ss = 0.f;
#pragma unroll
        for (int i = 0; i < 4; ++i) { if (first) v[i] = *(const float4*)(xr + i * 256 + lane * 4); else { const uint2 w = *(const uint2*)(xb + i * 256 + lane * 4); v[i] = make_float4(bf_lo(w.x), bf_hi(w.x), bf_lo(w.y), bf_hi(w.y)); }
            ss += v[i].x * v[i].x + v[i].y * v[i].y + v[i].z * v[i].z + v[i].w * v[i].w; }
        ss = wave_sum(ss); const float rs = rsqrtf(ss * (1.0f / D) + EPS);
#pragma unroll
        for (int i = 0; i < 4; ++i) { const int col = i * 256 + lane * 4;
            const float4 gv = *(const float4*)(g + col), sh = *(const float4*)(mr + col), sc = *(const float4*)(mr + D + col);
            uint2 w; w.x = pk_bf16(v[i].x * rs * gv.x * (1.0f + sc.x) + sh.x, v[i].y * rs * gv.y * (1.0f + sc.y) + sh.y);
                     w.y = pk_bf16(v[i].z * rs * gv.z * (1.0f + sc.z) + sh.z, v[i].w * rs * gv.w * (1.0f + sc.w) + sh.w);
            *(uint2*)(H + (size_t)r * D + col) = w; }
    }
}
template <int C> __device__ __forceinline__ void fp4x3_pair_f(float x0, float x1, unsigned& a0, unsigned& a1, unsigned& a2) {
    a0 = __builtin_amdgcn_cvt_scalef32_pk_fp4_f32(a0, x0 * 0.5f, x1 * 0.5f, 1.0f, C);
    const auto q0 = __builtin_amdgcn_cvt_scalef32_pk_f32_fp4(a0, 1.0f, C);
    const float r0 = x0 - 2.0f * q0[0], r1 = x1 - 2.0f * q0[1];
    a1 = __builtin_amdgcn_cvt_scalef32_pk_fp4_f32(a1, r0 * 4.0f, r1 * 4.0f, 1.0f, C);
}
__device__ __forceinline__ void phase_norm2(const P& p, int l) {
    const float* g = p.norm2_g + l * D;
    const float* mod = (const float*)(p.ws + WS_MOD) + (size_t)l * 3 * MODW + 3 * D;
    const bf16_t* X = (const bf16_t*)(p.ws + WS_XRES); bf16_t* H = (bf16_t*)(p.ws + WS_H); unsigned char* H4 = p.ws + WS_H4;
    const int lane = otid() & 63, gw = obid() * NWAVE + owave(), nw = ogrid() * NWAVE;
    const int nrow = (l == DEPTH - 1) ? NLAT : NTOK;
    for (int r = gw; r < nrow; r += nw) {
        const bf16_t* xr = X + (size_t)r * D + lane * 16; const float* mr = mod + (size_t)row_sel(r) * MODW + lane * 16; const float* gr = g + lane * 16;
        float v[16]; float ss = 0.f;
#pragma unroll
        for (int i = 0; i < 4; ++i) { const uint2 w = ((const uint2*)xr)[i]; const float4 t = make_float4(bf_lo(w.x), bf_hi(w.x), bf_lo(w.y), bf_hi(w.y)); v[4 * i] = t.x; v[4 * i + 1] = t.y; v[4 * i + 2] = t.z; v[4 * i + 3] = t.w; ss += t.x * t.x + t.y * t.y + t.z * t.z + t.w * t.w; }
        ss = wave_sum(ss); const float rs = rsqrtf(ss * (1.0f / D) + EPS);
        unsigned hb[8], a0[2] = {0u, 0u}, a1[2] = {0u, 0u}, a2[2] = {0u, 0u};
#pragma unroll
        for (int i = 0; i < 4; ++i) { const float4 gv = ((const float4*)gr)[i], sh = ((const float4*)mr)[i], sc = ((const float4*)(mr + D))[i];
            v[4 * i] = v[4 * i] * rs * gv.x * (1.0f + sc.x) + sh.x; v[4 * i + 1] = v[4 * i + 1] * rs * gv.y * (1.0f + sc.y) + sh.y;
            v[4 * i + 2] = v[4 * i + 2] * rs * gv.z * (1.0f + sc.z) + sh.z; v[4 * i + 3] = v[4 * i + 3] * rs * gv.w * (1.0f + sc.w) + sh.w; }
#pragma unroll
        for (int i = 0; i < 8; ++i) hb[i] = pk_bf16(v[2 * i], v[2 * i + 1]);
        uint4* hw = (uint4*)(H + (size_t)r * D + lane * 16); hw[0] = make_uint4(hb[0], hb[1], hb[2], hb[3]); hw[1] = make_uint4(hb[4], hb[5], hb[6], hb[7]);
#pragma unroll
        for (int d = 0; d < 2; ++d) {
            fp4x3_pair_f<0>(bf_lo(hb[4 * d]), bf_hi(hb[4 * d]), a0[d], a1[d], a2[d]); fp4x3_pair_f<1>(bf_lo(hb[4 * d + 1]), bf_hi(hb[4 * d + 1]), a0[d], a1[d], a2[d]);
            fp4x3_pair_f<2>(bf_lo(hb[4 * d + 2]), bf_hi(hb[4 * d + 2]), a0[d], a1[d], a2[d]); fp4x3_pair_f<3>(bf_lo(hb[4 * d + 3]), bf_hi(hb[4 * d + 3]), a0[d], a1[d], a2[d]); }
        unsigned char* h4 = H4 + (size_t)r * 1536 + lane * 8;
        *(uint2*)(h4) = make_uint2(a0[0], a0[1]); *(uint2*)(h4 + 512) = make_uint2(a1[0], a1[1]);
    }
}
__device__ __forceinline__ void h4_rows(const P& p, int l, int first, int step, int nrow) {
    const float* g = p.norm2_g + l * D;
    const float* mod = (const float*)(p.ws + WS_MOD) + (size_t)l * 3 * MODW + 3 * D;
    const bf16_t* X = (const bf16_t*)(p.ws + WS_XRES); unsigned char* H4 = p.ws + WS_H4; const float* SS = (const float*)(p.ws + WS_SSP2);
    const int lane = otid() & 63;
    if (first >= nrow) return;
    float gm[16], sh[16]; int cur_sel = -1;
    uint4 xn[2]; float4 sn[4];
    { const uint4* xp = (const uint4*)(X + (size_t)first * D + lane * 16); xn[0] = xp[0]; xn[1] = xp[1]; const float4* sp = (const float4*)(SS + (size_t)first * 16); sn[0] = sp[0]; sn[1] = sp[1]; sn[2] = sp[2]; sn[3] = sp[3]; }
    for (int r = first; r < nrow; r += step) {
        const uint4 x0 = xn[0], x1 = xn[1]; const float4 p0 = sn[0], p1 = sn[1], p2 = sn[2], p3 = sn[3];
        { const int r2 = (r + step < nrow) ? r + step : r; const uint4* xp = (const uint4*)(X + (size_t)r2 * D + lane * 16); xn[0] = xp[0]; xn[1] = xp[1];
          const float4* sp = (const float4*)(SS + (size_t)r2 * 16); sn[0] = sp[0]; sn[1] = sp[1]; sn[2] = sp[2]; sn[3] = sp[3]; }
        const int sel = row_sel(r);
        if (sel != cur_sel) {
            cur_sel = sel; const float* mr = mod + (size_t)sel * MODW + lane * 16; const float* gr = g + lane * 16;
#pragma unroll
            for (int i = 0; i < 4; ++i) { const float4 gv = ((const float4*)gr)[i], s4 = ((const float4*)mr)[i], c4 = ((const float4*)(mr + D))[i];
                gm[4 * i] = gv.x * (1.0f + c4.x); gm[4 * i + 1] = gv.y * (1.0f + c4.y); gm[4 * i + 2] = gv.z * (1.0f + c4.z); gm[4 * i + 3] = gv.w * (1.0f + c4.w);
                sh[4 * i] = s4.x; sh[4 * i + 1] = s4.y; sh[4 * i + 2] = s4.z; sh[4 * i + 3] = s4.w; }
        }
        const float sq = (((p0.x + p0.y) + (p0.z + p0.w)) + ((p1.x + p1.y) + (p1.z + p1.w))) + (((p2.x + p2.y) + (p2.z + p2.w)) + ((p3.x + p3.y) + (p3.z + p3.w)));
        const float rs = __builtin_amdgcn_rsqf(sq * (1.0f / 1024.0f) + 1e-6f);
        float v[16]; { float a[8], b[8]; unpack8(x0, a); unpack8(x1, b);
#pragma unroll
            for (int j = 0; j < 8; ++j) { v[j] = a[j]; v[8 + j] = b[j]; } }
#pragma unroll
        for (int i = 0; i < 16; ++i) v[i] = fmaf(v[i] * rs, gm[i], sh[i]);
        unsigned hb[8], a0[2] = {0u, 0u}, a1[2] = {0u, 0u}, a2[2] = {0u, 0u};
#pragma unroll
        for (int i = 0; i < 8; ++i) hb[i] = pk_bf16(v[2 * i], v[2 * i + 1]);
#pragma unroll
        for (int d = 0; d < 2; ++d) {
            fp4x3_pair_f<0>(bf_lo(hb[4 * d]), bf_hi(hb[4 * d]), a0[d], a1[d], a2[d]); fp4x3_pair_f<1>(bf_lo(hb[4 * d + 1]), bf_hi(hb[4 * d + 1]), a0[d], a1[d], a2[d]);
            fp4x3_pair_f<2>(bf_lo(hb[4 * d + 2]), bf_hi(hb[4 * d + 2]), a0[d], a1[d], a2[d]); fp4x3_pair_f<3>(bf_lo(hb[4 * d + 3]), bf_hi(hb[4 * d + 3]), a0[d], a1[d], a2[d]); }
        unsigned char* h4 = H4 + (size_t)r * 1536 + lane * 8;
        *(uint2*)(h4) = make_uint2(a0[0], a0[1]); *(uint2*)(h4 + 512) = make_uint2(a1[0], a1[1]);
    }
}
__device__ __forceinline__ void phase_conv(const P& p, int l) {
    const bf16_t* PR = (const bf16_t*)(p.ws + WS_PROJ); bf16_t* Y = (bf16_t*)(p.ws + WS_YCAT);
    const int lane = otid() & 63, gw = obid() * NWAVE + owave(), nw = ogrid() * NWAVE, ch = lane * 4;
    const float4 cw0 = *(const float4*)(p.conv_w + (size_t)(l * 3 + 0) * 256 + ch), cw1 = *(const float4*)(p.conv_w + (size_t)(l * 3 + 1) * 256 + ch), cw2 = *(const float4*)(p.conv_w + (size_t)(l * 3 + 2) * 256 + ch);
    const float4 og = *(const float4*)(p.out_norm_g + (size_t)l * D + ch);
    const int nblk = ((l == DEPTH - 1) ? NLAT : NTOK) / 4;
    for (int bk = gw; bk < nblk; bk += nw) {
        const int r0 = 4 * bk;
        int pos, len; if (r0 < NLAT) { pos = r0 & (T - 1); len = T; } else { pos = (r0 - NLAT) & (CTXL - 1); len = CTXL; }
        const bf16_t* pr = PR + (size_t)r0 * IN_W + ch;
        uint2 gb[4], gc[6], xi[6];
#pragma unroll
        for (int q = 0; q < 4; ++q) gb[q] = *(const uint2*)(pr + (size_t)q * IN_W + C_GB);
#pragma unroll
        for (int q = 0; q < 6; ++q) { const bool ok = (q == 0) ? (pos > 0) : ((q == 5) ? (pos + 4 < len) : true); const bf16_t* pq = pr + (ptrdiff_t)((ok ? q : 1) - 1) * IN_W;
            gc[q] = *(const uint2*)(pq + C_GC); xi[q] = *(const uint2*)(pq + C_XI);
            if (!ok) { gc[q] = make_uint2(0u, 0u); xi[q] = make_uint2(0u, 0u); } }
#pragma unroll
        for (int q = 0; q < 4; ++q) {
            const uint2 gcm = gc[q], xim = xi[q], gcc = gc[q + 1], xic = xi[q + 1], gcp = gc[q + 2], xip = xi[q + 2], gbq = gb[q];
            float y[4];
            y[0] = bf_lo(gbq.x) * (bf_lo(gcm.x) * bf_lo(xim.x) * cw0.x + bf_lo(gcc.x) * bf_lo(xic.x) * cw1.x + bf_lo(gcp.x) * bf_lo(xip.x) * cw2.x);
            y[1] = bf_hi(gbq.x) * (bf_hi(gcm.x) * bf_hi(xim.x) * cw0.y + bf_hi(gcc.x) * bf_hi(xic.x) * cw1.y + bf_hi(gcp.x) * bf_hi(xip.x) * cw2.y);
            y[2] = bf_lo(gbq.y) * (bf_lo(gcm.y) * bf_lo(xim.y) * cw0.z + bf_lo(gcc.y) * bf_lo(xic.y) * cw1.z + bf_lo(gcp.y) * bf_lo(xip.y) * cw2.z);
            y[3] = bf_hi(gbq.y) * (bf_hi(gcm.y) * bf_hi(xim.y) * cw0.w + bf_hi(gcc.y) * bf_hi(xic.y) * cw1.w + bf_hi(gcp.y) * bf_hi(xip.y) * cw2.w);
            float ss = y[0] * y[0] + y[1] * y[1] + y[2] * y[2] + y[3] * y[3];
            ss += __shfl_xor(ss, 1); ss += __shfl_xor(ss, 2); ss += __shfl_xor(ss, 4); ss += __shfl_xor(ss, 8);
            const float rs = rsqrtf(ss * (1.0f / 64.0f) + EPS);
            uint2 w; w.x = pk_bf16(y[0] * rs * og.x, y[1] * rs * og.y); w.y = pk_bf16(y[2] * rs * og.z, y[3] * rs * og.w);
            *(uint2*)(Y + (size_t)(r0 + q) * D + ch) = w;
        }
    }
}
typedef short s16x8_t __attribute__((ext_vector_type(8)));
typedef short s16x4_t __attribute__((ext_vector_type(4)));
typedef float f32x4_t __attribute__((ext_vector_type(4)));
typedef unsigned u32x4_t __attribute__((ext_vector_type(4)));
__device__ __forceinline__ float x4_max(float x) {
    auto s = __builtin_amdgcn_permlane16_swap(__float_as_uint(x), __float_as_uint(x), false, false); x = fmaxf(__uint_as_float(s[0]), __uint_as_float(s[1]));
    auto t = __builtin_amdgcn_permlane32_swap(__float_as_uint(x), __float_as_uint(x), false, false); return fmaxf(__uint_as_float(t[0]), __uint_as_float(t[1])); }
__device__ __forceinline__ float x4_sum(float x) {
    auto s = __builtin_amdgcn_permlane16_swap(__float_as_uint(x), __float_as_uint(x), false, false); x = __uint_as_float(s[0]) + __uint_as_float(s[1]);
    auto t = __builtin_amdgcn_permlane32_swap(__float_as_uint(x), __float_as_uint(x), false, false); return __uint_as_float(t[0]) + __uint_as_float(t[1]); }
template <int OFF> __device__ __forceinline__ s16x4_t tr_read(unsigned vb) { s16x4_t r; asm volatile("ds_read_b64_tr_b16 %0, %1 offset:%2" : "=&v"(r) : "v"(vb), "i"(OFF) : "memory"); return r; }
constexpr int NA_VSTRIDE = 144;
constexpr int NA_NSLOT = 9;
constexpr int NA_CTX_ROW = NA_NSLOT * 64;
constexpr int NA_CK_OFF = (NA_CTX_ROW + 256) * NA_VSTRIDE;
constexpr int NA_RPB_OFF = NA_CK_OFF + 256 * 128;
static_assert(NA_RPB_OFF + 465 * 4 + 64 <= ST_OFF, "attention LDS image overlaps the control words");
__device__ __forceinline__ void phase_na(const P& p, int l, LAS unsigned char* lds) {
    const bf16_t* PR = (const bf16_t*)(p.ws + WS_PROJ); bf16_t* Y = (bf16_t*)(p.ws + WS_YCAT);
    const int tid = otid(), wave = __builtin_amdgcn_readfirstlane(tid >> 6), lane = tid & 63, g = lane >> 4, lq = lane & 15;
    LAS float* rpbl = (LAS float*)(lds + NA_RPB_OFF);
    const unsigned vbase = (unsigned)(uintptr_t)lds;
    const int G = ogrid(), per = (2048 + G - 1) / G, nctx_it = (l == DEPTH - 1) ? 0 : (32 + G - 1) / G;
    const int qt = wave & 3, rsel = wave >> 2;
    f32x4_t mk[2];
    { const int gc_ = qt * 16 + lq, cs_ = min(max(gc_ - 8, 0), 48), cw_ = min(max(qt * 16 - 8, 0), 32);
#pragma unroll
      for (int pq = 0; pq < 2; ++pq)
#pragma unroll
          for (int r = 0; r < 4; ++r) { const int col = cw_ + 16 * pq + 4 * g + r; mk[pq][r] = ((col >= cs_) && (col < cs_ + 16)) ? 0.f : -3.0e38f; } }
    int cur_b = -1, cur_h = -1, lo_row = 0, hi_row = 0;
    for (int it = 0; it < per + nctx_it; ++it) {
        bool isctx, valid; int b, h, gr0 = 0, hb = 0;
        if (it < per) { const int ul = obid() * per + it; valid = ul < 2048; isctx = false; b = ul >> 10; h = (ul >> 7) & 7; gr0 = (ul & 127) * 2; }
        else { const int uc = (G - 1 - obid()) + (it - per) * G;        valid = uc < 32; isctx = true; b = uc >> 4; h = (uc >> 1) & 7; hb = uc & 1; }
        if (!valid) continue;
        const int tokb = b * T, tokc = NLAT + b * CTXL;
        const int need_lo = min(max(gr0 - 4, 0), 248), need_hi = min(max(gr0 + 1 - 4, 0), 248) + 8;
        if (b != cur_b || h != cur_h) {
#pragma unroll
            for (int c = tid; c < 256 * 8; c += NTHR) { const int R = c >> 3, ch = c & 7;
                const u32x4_t v = *(const u32x4_t*)(PR + (size_t)(tokc + R) * IN_W + C_V + h * 64 + ch * 8), k = *(const u32x4_t*)(PR + (size_t)(tokc + R) * IN_W + C_K + h * 64 + ch * 8);
                *(LAS u32x4_t*)(lds + (NA_CTX_ROW + R) * NA_VSTRIDE + ch * 16) = v; *(LAS u32x4_t*)(lds + NA_CK_OFF + R * 128 + 16 * (ch ^ ((R >> 1) & 7))) = k; }
            if (tid < 465) rpbl[tid] = p.na_rpb[(size_t)(l * 8 + h) * 465 + tid] * 1.44269504f;
            cur_b = b; cur_h = h; lo_row = 0; hi_row = 0;
        }
        if (!isctx) {
            for (int R = need_lo; R < need_hi; ++R)
                if (R < lo_row || R >= hi_row) { const u32x4_t v = *(const u32x4_t*)(PR + (size_t)(tokb + R * 64 + (tid >> 3)) * IN_W + C_V + h * 64 + (tid & 7) * 8);
                    *(LAS u32x4_t*)(lds + ((R % NA_NSLOT) * 64 + (tid >> 3)) * NA_VSTRIDE + (tid & 7) * 16) = v; }
            lo_row = need_lo; hi_row = need_hi;
        }
        asm volatile("s_waitcnt lgkmcnt(0)" ::: "memory"); __builtin_amdgcn_s_barrier(); asm volatile("" ::: "memory");
        int nx_lo = 0, nx_n = 0; u32x4_t vn0 = (u32x4_t){0u, 0u, 0u, 0u}, vn1 = vn0;
        if (!isctx && it + 1 < per) { const int ul1 = obid() * per + it + 1;
            if (ul1 < 2048 && (ul1 >> 7) == ((obid() * per + it) >> 7)) { const int g1 = (ul1 & 127) * 2; const int nhi = min(max(g1 + 1 - 4, 0), 248) + 8;
                nx_lo = hi_row; nx_n = nhi - hi_row;
                if (nx_n > 0) vn0 = *(const u32x4_t*)(PR + (size_t)(tokb + nx_lo * 64 + (tid >> 3)) * IN_W + C_V + h * 64 + (tid & 7) * 8);
                if (nx_n > 1) vn1 = *(const u32x4_t*)(PR + (size_t)(tokb + (nx_lo + 1) * 64 + (tid >> 3)) * IN_W + C_V + h * 64 + (tid & 7) * 8); } }
        const int gr = gr0 + rsel, rs_ = min(max(gr - 4, 0), 248);
        const int tq = isctx ? (tokc + hb * 128 + wave * 16 + lq) : (tokb + gr * 64 + qt * 16 + lq);
        const int cw0 = min(max(qt * 16 - 8, 0), 32);
        const int tokl = tokb + rs_ * 64;
        const int qq = lq >> 2, pp4 = lq & 3;
        f32x4_t O[4]; float mrow = -3.0e38f, lrow = 0.f;
#pragma unroll
        for (int c = 0; c < 4; ++c) O[c] = (f32x4_t){0.f, 0.f, 0.f, 0.f};
        const bf16_t* qp = PR + (size_t)tq * IN_W + C_Q + h * 64 + g * 8;
        const s16x8_t qf0 = *(const s16x8_t*)qp, qf1 = *(const s16x8_t*)(qp + 32);
        s16x8_t kfa[8], kfb[8];
#pragma unroll
        for (int k8 = 0; k8 < 8; ++k8) asm volatile("" : "=v"(kfa[k8]), "=v"(kfb[k8]));
        if (!isctx) {
#pragma unroll
            for (int k8 = 0; k8 < 8; ++k8) { const int tk = tokl + (k8 >> 1) * 64 + cw0 + 16 * (k8 & 1) + lq; const bf16_t* kp = PR + (size_t)tk * IN_W + C_K + h * 64 + g * 8;
                kfa[k8] = *(const s16x8_t*)kp; kfb[k8] = *(const s16x8_t*)(kp + 32); } }
        __builtin_amdgcn_sched_barrier(0);
#define NA_TRRD(BUF, KB_) do { const int kb = (KB_); const int R0 = (ROW0_OF_KB_EXPR); \
                const unsigned a0 = vbase + (unsigned)((R0 + qq) * NA_VSTRIDE + pp4 * 8), a1 = a0 + 16 * NA_VSTRIDE; \
                vl[BUF][0] = tr_read<0>(a0); vl[BUF][1] = tr_read<32>(a0); vl[BUF][2] = tr_read<64>(a0); vl[BUF][3] = tr_read<96>(a0); \
                vh[BUF][0] = tr_read<0>(a1); vh[BUF][1] = tr_read<32>(a1); vh[BUF][2] = tr_read<64>(a1); vh[BUF][3] = tr_read<96>(a1); } while (0)
#define NA_MERGE_PV() do { \
            mx = x4_max(mx); \
            const float mnew = fmaxf(mrow, mx), resc = __builtin_amdgcn_exp2f(mrow - mnew); f32x4_t lsv = (f32x4_t){0.f, 0.f, 0.f, 0.f}; \
            f32x2_t nm2 = (f32x2_t){-mnew, -mnew}; asm volatile("" : "+v"(nm2)); const f32x4_t nm4 = (f32x4_t){nm2[0], nm2[1], nm2[0], nm2[1]}; \
            _Pragma("unroll") for (int kt = 0; kt < 16; ++kt) { f32x4_t d = sc[kt] + nm4; d[0] = __builtin_amdgcn_exp2f(d[0]); d[1] = __builtin_amdgcn_exp2f(d[1]); d[2] = __builtin_amdgcn_exp2f(d[2]); d[3] = __builtin_amdgcn_exp2f(d[3]); sc[kt] = d; lsv += d; } \
            float ls = (lsv[0] + lsv[1]) + (lsv[2] + lsv[3]); \
            ls = x4_sum(ls); lrow = lrow * resc + ls; mrow = mnew; \
            _Pragma("unroll") for (int c = 0; c < 4; ++c) O[c] = O[c] * resc; \
            s16x4_t vl[2][4], vh[2][4]; \
            NA_TRRD(0, 0); \
            _Pragma("unroll") for (int kb_ = 0; kb_ < 8; ++kb_) { \
                asm volatile("s_waitcnt lgkmcnt(0)" ::: "memory"); __builtin_amdgcn_sched_barrier(0); \
                if (kb_ < 7) NA_TRRD((kb_ + 1) & 1, kb_ + 1);                \
                s16x8_t pf; \
                { const unsigned u0 = pk_bf16(sc[2 * kb_][0], sc[2 * kb_][1]), u1 = pk_bf16(sc[2 * kb_][2], sc[2 * kb_][3]), u2 = pk_bf16(sc[2 * kb_ + 1][0], sc[2 * kb_ + 1][1]), u3 = pk_bf16(sc[2 * kb_ + 1][2], sc[2 * kb_ + 1][3]); \
                  pf = __builtin_bit_cast(s16x8_t, make_uint4(u0, u1, u2, u3)); } \
                O[0] = __builtin_amdgcn_mfma_f32_16x16x32_bf16(NA_PK(vl[kb_ & 1][0], vh[kb_ & 1][0]), pf, O[0], 0, 0, 0); \
                O[1] = __builtin_amdgcn_mfma_f32_16x16x32_bf16(NA_PK(vl[kb_ & 1][1], vh[kb_ & 1][1]), pf, O[1], 0, 0, 0); \
                O[2] = __builtin_amdgcn_mfma_f32_16x16x32_bf16(NA_PK(vl[kb_ & 1][2], vh[kb_ & 1][2]), pf, O[2], 0, 0, 0); \
                O[3] = __builtin_amdgcn_mfma_f32_16x16x32_bf16(NA_PK(vl[kb_ & 1][3], vh[kb_ & 1][3]), pf, O[3], 0, 0, 0); \
                __builtin_amdgcn_sched_barrier(0); } } while (0)
#define NA_PK(L, H) (s16x8_t){L[0], L[1], L[2], L[3], H[0], H[1], H[2], H[3]}
        {
            f32x4_t sc[16];
            const unsigned sw = (unsigned)((lq >> 1) & 7);
            const LAS unsigned char* ka = lds + NA_CK_OFF + lq * 128 + 16 * ((unsigned)g ^ sw); const LAS unsigned char* kb2 = lds + NA_CK_OFF + lq * 128 + 16 * ((unsigned)(4 + g) ^ sw);
#pragma unroll
            for (int q4 = 0; q4 < 4; ++q4) {
                s16x8_t c0[4], c1[4];
#pragma unroll
                for (int k4 = 0; k4 < 4; ++k4) { const int kt = q4 * 4 + k4; c0[k4] = *(const LAS s16x8_t*)(ka + 2048 * kt); c1[k4] = *(const LAS s16x8_t*)(kb2 + 2048 * kt); }
#pragma unroll
                for (int k4 = 0; k4 < 4; ++k4) { f32x4_t acc = (f32x4_t){0.f, 0.f, 0.f, 0.f};
                    acc = __builtin_amdgcn_mfma_f32_16x16x32_bf16(c0[k4], qf0, acc, 0, 0, 0);
                    acc = __builtin_amdgcn_mfma_f32_16x16x32_bf16(c1[k4], qf1, acc, 0, 0, 0);
                    sc[q4 * 4 + k4] = acc; }
            }
            float mx = -3.0e38f;
#pragma unroll
            for (int kt = 0; kt < 16; ++kt)
#pragma unroll
                for (int r = 0; r < 4; ++r) mx = fmaxf(mx, sc[kt][r]);
            mx *= 0.125f * 1.44269504f;
#pragma unroll
            for (int kt = 0; kt < 16; ++kt) sc[kt] = sc[kt] * (0.125f * 1.44269504f);
#define ROW0_OF_KB_EXPR (NA_CTX_ROW + 32 * kb + 4 * g)
            NA_MERGE_PV();
#undef ROW0_OF_KB_EXPR
        }
        if (!isctx) {
            f32x4_t sc[16];
#pragma unroll
            for (int k8 = 0; k8 < 8; ++k8) { f32x4_t acc = (f32x4_t){0.f, 0.f, 0.f, 0.f};
                acc = __builtin_amdgcn_mfma_f32_16x16x32_bf16(kfa[k8], qf0, acc, 0, 0, 0);
                acc = __builtin_amdgcn_mfma_f32_16x16x32_bf16(kfb[k8], qf1, acc, 0, 0, 0);
                sc[k8] = acc; }
            __builtin_amdgcn_sched_barrier(0);
#pragma unroll
            for (int k8 = 0; k8 < 8; ++k8) { const int kt = 8 + k8;
                const int tk = tokl + (kt >> 1) * 64 + cw0 + 16 * (kt & 1) + lq; const bf16_t* kp = PR + (size_t)tk * IN_W + C_K + h * 64 + g * 8;
                kfa[k8] = *(const s16x8_t*)kp; kfb[k8] = *(const s16x8_t*)(kp + 32); }
            __builtin_amdgcn_sched_barrier(0);
#pragma unroll
            for (int k8 = 0; k8 < 8; ++k8) { f32x4_t acc = (f32x4_t){0.f, 0.f, 0.f, 0.f};
                acc = __builtin_amdgcn_mfma_f32_16x16x32_bf16(kfa[k8], qf0, acc, 0, 0, 0);
                acc = __builtin_amdgcn_mfma_f32_16x16x32_bf16(kfb[k8], qf1, acc, 0, 0, 0);
                sc[8 + k8] = acc; }
            __builtin_amdgcn_sched_barrier(0);
            float mx = -3.0e38f;
            const int gc = qt * 16 + lq;
            const LAS float* rb_ = rpbl + ((rs_ - gr + 7) * 31 + (cw0 + 4 * g - gc + 15));
#pragma unroll
            for (int kq = 0; kq < 4; ++kq) {
                float bq[16];
#pragma unroll
                for (int e = 0; e < 16; ++e) { const int kt = 4 * kq + (e >> 2), r = e & 3; bq[e] = rb_[31 * (kt >> 1) + 16 * (kt & 1) + r]; }
                asm volatile("" : "+v"(bq[0]), "+v"(bq[1]), "+v"(bq[2]), "+v"(bq[3]), "+v"(bq[4]), "+v"(bq[5]), "+v"(bq[6]), "+v"(bq[7]),
                                  "+v"(bq[8]), "+v"(bq[9]), "+v"(bq[10]), "+v"(bq[11]), "+v"(bq[12]), "+v"(bq[13]), "+v"(bq[14]), "+v"(bq[15]));
#pragma unroll
                for (int e4 = 0; e4 < 4; ++e4) { const int kt = 4 * kq + e4;
                    const f32x4_t b4 = (f32x4_t){bq[4 * e4], bq[4 * e4 + 1], bq[4 * e4 + 2], bq[4 * e4 + 3]} + mk[kt & 1];
                    const f32x4_t sv = sc[kt] * (0.125f * 1.44269504f) + b4; sc[kt] = sv;
                    mx = fmaxf(fmaxf(mx, sv[0]), sv[1]); mx = fmaxf(fmaxf(mx, sv[2]), sv[3]); }
            }
#define ROW0_OF_KB_EXPR (((rs_ + kb) % NA_NSLOT) * 64 + cw0 + 4 * g)
            NA_MERGE_PV();
#undef ROW0_OF_KB_EXPR
        }
#undef NA_PK
#undef NA_MERGE_PV
#undef NA_TRRD
        { const float inv = 1.0f / lrow; float ss = 0.f;
#pragma unroll
          for (int c = 0; c < 4; ++c) { O[c] = O[c] * inv; ss += O[c][0] * O[c][0] + O[c][1] * O[c][1] + O[c][2] * O[c][2] + O[c][3] * O[c][3]; }
          ss = x4_sum(ss); const float rn = rsqrtf(ss * (1.0f / 64.0f) + EPS);
          const float* og = p.out_norm_g + (size_t)l * D + 512 + h * 64 + 4 * g; bf16_t* yp = Y + (size_t)tq * D + 512 + h * 64 + 4 * g;
#pragma unroll
          for (int c = 0; c < 4; ++c) { const float4 gv = *(const float4*)(og + 16 * c);
              uint2 w; w.x = pk_bf16(O[c][0] * rn * gv.x, O[c][1] * rn * gv.y); w.y = pk_bf16(O[c][2] * rn * gv.z, O[c][3] * rn * gv.w);
              *(uint2*)(yp + 16 * c) = w; } }
        asm volatile("s_waitcnt lgkmcnt(0)" ::: "memory"); __builtin_amdgcn_s_barrier(); asm volatile("" ::: "memory");
        if (nx_n > 0) *(LAS u32x4_t*)(lds + (((nx_lo) % NA_NSLOT) * 64 + (tid >> 3)) * NA_VSTRIDE + (tid & 7) * 16) = vn0;
        if (nx_n > 1) *(LAS u32x4_t*)(lds + (((nx_lo + 1) % NA_NSLOT) * 64 + (tid >> 3)) * NA_VSTRIDE + (tid & 7) * 16) = vn1;
        if (nx_n > 0) hi_row = nx_lo + nx_n;
    }
    __syncthreads();
}
__device__ __forceinline__ void phase_sgu(const P& p, int l, LAS unsigned char* lds) {
    const bf16_t* PR = (const bf16_t*)(p.ws + WS_PROJ); bf16_t* Y = (bf16_t*)(p.ws + WS_YCAT);
    const bf16_t* WB = (const bf16_t*)(p.ws + WS_SGUW) + (size_t)l * 4 * 128 * 128;
    const int tid = otid(), wave = __builtin_amdgcn_readfirstlane(tid >> 6), lane = tid & 63, g = lane >> 4, lq = lane & 15;
    const unsigned vbase = (unsigned)(uintptr_t)lds;
    const int nitem = (((l == DEPTH - 1) ? NLAT : NTOK) / 128) * 4;
    for (int item = obid(); item < nitem; item += ogrid()) {
        const int chunk = item >> 2, grp = item & 3, row0 = chunk * 128;
        { const int tok = tid >> 2, cg = (tid & 3) * 16;
          const bf16_t* src = PR + (size_t)(row0 + tok) * IN_W + C_SV + grp * 64 + cg;
          float f[16]; { float a[8], b[8]; unpack8(((const uint4*)src)[0], a); unpack8(((const uint4*)src)[1], b);
#pragma unroll
              for (int j = 0; j < 8; ++j) { f[j] = gelu_tanh(a[j]); f[8 + j] = gelu_tanh(b[j]); } }
          float ss = 0.f;
#pragma unroll
          for (int j = 0; j < 16; ++j) ss += f[j] * f[j];
          ss += __shfl_xor(ss, 1); ss += __shfl_xor(ss, 2);
          const float rs = rsqrtf(ss * (1.0f / 64.0f) + EPS);
          const float* gn = p.sgu_norm_g + (size_t)l * 256 + grp * 64 + cg;
          unsigned o[8];
#pragma unroll
          for (int j = 0; j < 8; ++j) o[j] = pk_bf16(f[2 * j] * rs * gn[2 * j], f[2 * j + 1] * rs * gn[2 * j + 1]);
          LAS u32x4_t* dst = (LAS u32x4_t*)(lds + tok * NA_VSTRIDE + cg * 2);
          dst[0] = (u32x4_t){o[0], o[1], o[2], o[3]}; dst[1] = (u32x4_t){o[4], o[5], o[6], o[7]}; }
        __syncthreads();
        const int tokp = row0 + wave * 16 + lq;
        f32x4_t O[4];
#pragma unroll
        for (int c = 0; c < 4; ++c) O[c] = (f32x4_t){0.f, 0.f, 0.f, 0.f};
        const bf16_t* wp = WB + ((size_t)grp * 128 + wave * 16 + lq) * 128 + g * 8;
        const int qq = lq >> 2, pp4 = lq & 3;
#pragma unroll
        for (int ks = 0; ks < 4; ++ks) {
            const s16x8_t wf = *(const s16x8_t*)(wp + 32 * ks);
            const unsigned a0 = vbase + (unsigned)((32 * ks + 8 * g + qq) * NA_VSTRIDE + pp4 * 8), a1 = a0 + 4 * NA_VSTRIDE;
            const s16x4_t l0 = tr_read<0>(a0), l1 = tr_read<32>(a0), l2 = tr_read<64>(a0), l3 = tr_read<96>(a0);
            const s16x4_t h0 = tr_read<0>(a1), h1 = tr_read<32>(a1), h2 = tr_read<64>(a1), h3 = tr_read<96>(a1);
            asm volatile("s_waitcnt lgkmcnt(0)" ::: "memory"); __builtin_amdgcn_sched_barrier(0);
#define SG_PK(L, H) (s16x8_t){L[0], L[1], L[2], L[3], H[0], H[1], H[2], H[3]}
            O[0] = __builtin_amdgcn_mfma_f32_16x16x32_bf16(SG_PK(l0, h0), wf, O[0], 0, 0, 0);
            O[1] = __builtin_amdgcn_mfma_f32_16x16x32_bf16(SG_PK(l1, h1), wf, O[1], 0, 0, 0);
            O[2] = __builtin_amdgcn_mfma_f32_16x16x32_bf16(SG_PK(l2, h2), wf, O[2], 0, 0, 0);
            O[3] = __builtin_amdgcn_mfma_f32_16x16x32_bf16(SG_PK(l3, h3), wf, O[3], 0, 0, 0);
#undef SG_PK
        }
        const float bias = p.sgu_b[(size_t)(l * 4 + grp) * 128 + wave * 16 + lq];
        const bf16_t* up = PR + (size_t)tokp * IN_W + C_SU + grp * 64 + 4 * g;
        float ss = 0.f;
#pragma unroll
        for (int c = 0; c < 4; ++c) { const uint2 uu = *(const uint2*)(up + 16 * c);
            O[c][0] = gelu_tanh(bf_lo(uu.x)) * (O[c][0] + bias); O[c][1] = gelu_tanh(bf_hi(uu.x)) * (O[c][1] + bias);
            O[c][2] = gelu_tanh(bf_lo(uu.y)) * (O[c][2] + bias); O[c][3] = gelu_tanh(bf_hi(uu.y)) * (O[c][3] + bias);
            ss += O[c][0] * O[c][0] + O[c][1] * O[c][1] + O[c][2] * O[c][2] + O[c][3] * O[c][3]; }
        ss = x4_sum(ss); const float rn = rsqrtf(ss * (1.0f / 64.0f) + EPS);
        const float* og = p.out_norm_g + (size_t)l * D + 256 + grp * 64 + 4 * g; bf16_t* yp = Y + (size_t)tokp * D + 256 + grp * 64 + 4 * g;
#pragma unroll
        for (int c = 0; c < 4; ++c) { const float4 gv = *(const float4*)(og + 16 * c);
            uint2 w; w.x = pk_bf16(O[c][0] * rn * gv.x, O[c][1] * rn * gv.y); w.y = pk_bf16(O[c][2] * rn * gv.z, O[c][3] * rn * gv.w);
            *(uint2*)(yp + 16 * c) = w; }
        __syncthreads();
    }
}
__device__ __forceinline__ float vmaxf(float a, float b) { float r; asm("v_max_f32 %0, %1, %2" : "=v"(r) : "v"(a), "v"(b)); return r; }
__device__ __forceinline__ float vminf(float a, float b) { float r; asm("v_min_f32 %0, %1, %2" : "=v"(r) : "v"(a), "v"(b)); return r; }
__device__ __forceinline__ float vmed3f(float a, float b, float c) { float r; asm("v_med3_f32 %0, %1, %2, %3" : "=v"(r) : "v"(a), "v"(b), "v"(c)); return r; }
template <int A, int B> __device__ __forceinline__ void ce_desc(float (&v)[16]) { const float x = v[A], y = v[B]; v[A] = vmaxf(x, y); v[B] = vminf(x, y); }
__device__ __forceinline__ void sort16_desc(float (&v)[16]) {
    ce_desc<0, 13>(v); ce_desc<1, 12>(v); ce_desc<2, 15>(v); ce_desc<3, 14>(v); ce_desc<4, 8>(v); ce_desc<5, 6>(v); ce_desc<7, 11>(v); ce_desc<9, 10>(v);
    ce_desc<0, 5>(v); ce_desc<1, 7>(v); ce_desc<2, 9>(v); ce_desc<3, 4>(v); ce_desc<6, 13>(v); ce_desc<8, 14>(v); ce_desc<10, 15>(v); ce_desc<11, 12>(v);
    ce_desc<0, 1>(v); ce_desc<2, 3>(v); ce_desc<4, 5>(v); ce_desc<6, 8>(v); ce_desc<7, 9>(v); ce_desc<10, 11>(v); ce_desc<12, 13>(v); ce_desc<14, 15>(v);
    ce_desc<0, 2>(v); ce_desc<1, 3>(v); ce_desc<4, 10>(v); ce_desc<5, 11>(v); ce_desc<6, 7>(v); ce_desc<8, 9>(v); ce_desc<12, 14>(v); ce_desc<13, 15>(v);
    ce_desc<1, 2>(v); ce_desc<3, 12>(v); ce_desc<4, 6>(v); ce_desc<5, 7>(v); ce_desc<8, 10>(v); ce_desc<9, 11>(v); ce_desc<13, 14>(v);
    ce_desc<1, 4>(v); ce_desc<2, 6>(v); ce_desc<5, 8>(v); ce_desc<7, 10>(v); ce_desc<9, 13>(v); ce_desc<11, 14>(v);
    ce_desc<2, 4>(v); ce_desc<3, 6>(v); ce_desc<9, 12>(v); ce_desc<11, 13>(v);
    ce_desc<3, 5>(v); ce_desc<6, 8>(v); ce_desc<7, 9>(v); ce_desc<10, 12>(v);
    ce_desc<3, 4>(v); ce_desc<5, 6>(v); ce_desc<7, 8>(v); ce_desc<9, 10>(v); ce_desc<11, 12>(v);
    ce_desc<6, 7>(v); ce_desc<8, 9>(v);
}
template <int J, int I> __device__ __forceinline__ void bm_step(float (&v)[16]) { if constexpr ((I ^ J) > I) ce_desc<I, (I ^ J)>(v); }
template <int J, int... I> __device__ __forceinline__ void bm_layer(float (&v)[16], std::integer_sequence<int, I...>) { (bm_step<J, I>(v), ...); }
__device__ __forceinline__ void bmerge16_desc(float (&v)[16]) {
    using S = std::make_integer_sequence<int, 16>; bm_layer<8>(v, S{}); bm_layer<4>(v, S{}); bm_layer<2>(v, S{}); bm_layer<1>(v, S{}); }
template <int... I> __device__ __forceinline__ void mtop_(float (&A)[16], const float (&B)[16], std::integer_sequence<int, I...>) { ((A[I] = vmaxf(A[I], B[15 - I])), ...); }
__device__ __forceinline__ void merge_top16(float (&A)[16], const float (&B)[16]) {
    mtop_(A, B, std::make_integer_sequence<int, 16>{}); bmerge16_desc(A); }
constexpr int TK_ROW = 272;
__device__ __forceinline__ void phase_topk(const P& p, int l, LAS unsigned char* lds) {
    const bf16_t* Q = (const bf16_t*)(p.ws + WS_Q); const bf16_t* SK = (const bf16_t*)(p.ws + WS_SUBK) + (size_t)l * 8 * 2 * 128 * 128;
    int* PIDX = (int*)(p.ws + WS_PIDX); float* PG = (float*)(p.ws + WS_PG); float* PUS = (float*)(p.ws + WS_YCAT);
    const float* US = (const float*)(p.ws + WS_US) + (size_t)l * 16384; const float* VS = (const float*)(p.ws + WS_VS) + (size_t)l * 16384;
    const int tid = otid(), wave = __builtin_amdgcn_readfirstlane(tid >> 6), lane = tid & 63, g = lane >> 4, lq = lane & 15;
    const int h = obid() & 7, ngrp = ogrid() >> 3, grp = obid() >> 3;
    if (grp < ngrp) {
        const u32x4_t* src = (const u32x4_t*)(SK + (size_t)h * 2 * 128 * 128);
#pragma unroll
        for (int c = tid; c < 256 * 16; c += NTHR) { const int row = c >> 4, ch = c & 15; *(LAS u32x4_t*)(lds + row * TK_ROW + ch * 16) = src[c]; }
    }
    __syncthreads();
    const int wid = wave * ngrp + grp, nwid = ngrp * NWAVE;
    const int h4_nrow = (l == DEPTH - 1) ? NLAT : NTOK;
    if (wave < 4) h4_rows(p, l, obid() * NWAVE + wave, ogrid() * NWAVE, h4_nrow);
    s16x8_t qn[2][4];
    { const int t0 = (grp < ngrp && wid < NTOK / 16) ? wid : 0; const bf16_t* qp = Q + ((size_t)h * NTOK + t0 * 16 + lq) * 256 + g * 8;
#pragma unroll
      for (int pp = 0; pp < 2; ++pp)
#pragma unroll
          for (int ks = 0; ks < 4; ++ks) qn[pp][ks] = *(const s16x8_t*)(qp + pp * 128 + 32 * ks); }
    const int ntile = ((l == DEPTH - 1) ? NLAT : NTOK) / 16;
    for (int tile0 = (grp < ngrp ? wid : NTOK); tile0 < ntile; tile0 += 4 * nwid) {
        float top0[16], top1[16];
#pragma unroll
        for (int i = 0; i < 16; ++i) { top0[i] = 0.f; top1[i] = 0.f; }
        for (int j = 0; j < 4; ++j) {
            const int tile = tile0 + j * nwid;
            if (tile >= ntile) break;
            s16x8_t qc[2][4];
#pragma unroll
            for (int pp = 0; pp < 2; ++pp)
#pragma unroll
                for (int ks = 0; ks < 4; ++ks) qc[pp][ks] = qn[pp][ks];
            { const int tn = (tile + nwid < ntile) ? tile + nwid : tile; const bf16_t* qp = Q + ((size_t)h * NTOK + tn * 16 + lq) * 256 + g * 8;
#pragma unroll
              for (int pp = 0; pp < 2; ++pp)
#pragma unroll
                  for (int ks = 0; ks < 4; ++ks) qn[pp][ks] = *(const s16x8_t*)(qp + pp * 128 + 32 * ks); }
            float own[2][16];
            s16x8_t fr[2][8];
#define TK_RD(STEP, F) do { _Pragma("unroll") for (int t_ = 0; t_ < 2; ++t_) { const LAS unsigned char* kp_ = lds + (((STEP) >> 2) * 128 + (2 * ((STEP) & 3) + t_) * 16 + lq) * TK_ROW + g * 16; \
                _Pragma("unroll") for (int ks = 0; ks < 4; ++ks) F[t_ * 4 + ks] = *(const LAS s16x8_t*)(kp_ + 64 * ks); } } while (0)
            TK_RD(0, fr[0]);
            __builtin_amdgcn_sched_barrier(0);
#pragma unroll
            for (int pp = 0; pp < 2; ++pp) {
                float sc[32];
#pragma unroll
                for (int s2 = 0; s2 < 4; ++s2) {
                    const int step = pp * 4 + s2;
                    if (step < 7) TK_RD(step + 1, fr[(step + 1) & 1]);
                    __builtin_amdgcn_sched_barrier(0);
                    f32x4_t acc0 = (f32x4_t){0.f, 0.f, 0.f, 0.f}, acc1 = (f32x4_t){0.f, 0.f, 0.f, 0.f};
#pragma unroll
                    for (int ks = 0; ks < 4; ++ks) { acc0 = __builtin_amdgcn_mfma_f32_16x16x32_bf16(fr[step & 1][ks], qc[pp][ks], acc0, 0, 0, 0);
                                                     acc1 = __builtin_amdgcn_mfma_f32_16x16x32_bf16(fr[step & 1][4 + ks], qc[pp][ks], acc1, 0, 0, 0); }
#pragma unroll
                    for (int r = 0; r < 4; ++r) { sc[s2 * 8 + r] = __uint_as_float((__float_as_uint(acc0[r]) & ~127u) | (unsigned)(s2 * 32 + 4 * g + r));
                                                  sc[s2 * 8 + 4 + r] = __uint_as_float((__float_as_uint(acc1[r]) & ~127u) | (unsigned)(s2 * 32 + 16 + 4 * g + r)); }
                    __builtin_amdgcn_sched_barrier(0);
                }
                float A[16], B[16];
#pragma unroll
                for (int i = 0; i < 16; ++i) { A[i] = sc[i]; B[i] = sc[16 + i]; }
                sort16_desc(A); sort16_desc(B);
                merge_top16(A, B);
#pragma unroll
                for (int i = 0; i < 16; ++i) own[pp][i] = A[i];
            }
#undef TK_RD
            float X[16], Y[16];
#pragma unroll
            for (int i = 0; i < 16; ++i) { auto r = __builtin_amdgcn_permlane16_swap(__float_as_uint(own[0][i]), __float_as_uint(own[1][i]), false, false); X[i] = __uint_as_float(r[0]); Y[i] = __uint_as_float(r[1]); }
            merge_top16(X, Y);
#pragma unroll
            for (int i = 0; i < 16; ++i) { auto r = __builtin_amdgcn_permlane32_swap(__float_as_uint(X[i]), __float_as_uint(X[i]), false, false); X[i] = __uint_as_float(r[0]); Y[i] = __uint_as_float(r[1]); }
            merge_top16(X, Y);
            const bool mine = (g == j);
#pragma unroll
            for (int i = 0; i < 16; ++i) { auto r = __builtin_amdgcn_permlane16_swap(__float_as_uint(X[i]), __float_as_uint(X[i]), false, false);
                top0[i] = mine ? __uint_as_float(r[0]) : top0[i]; top1[i] = mine ? __uint_as_float(r[1]) : top1[i]; }
        }
        const int mytile = tile0 + g * nwid, tok = mytile * 16 + lq;
        unsigned ia7[16], jb[16];
#pragma unroll
        for (int i = 0; i < 16; ++i) { ia7[i] = (__float_as_uint(top0[i]) & 127u) << 7; jb[i] = __float_as_uint(top1[i]) & 127u; }
#define CAND(a, b) __uint_as_float((__float_as_uint(top0[a] + top1[b]) & ~16383u) | (ia7[a] | jb[b]))
        float L0[16], L1[16], L2[16], L3[16];
#pragma unroll
        for (int i = 0; i < 16; ++i) L0[i] = CAND(0, i);
#pragma unroll
        for (int i = 0; i < 8; ++i) L1[i] = CAND(1, i);
#pragma unroll
        for (int i = 8; i < 16; ++i) L1[i] = -3.0e38f;
        L2[0] = CAND(2, 0); L2[1] = CAND(2, 1); L2[2] = CAND(2, 2); L2[3] = CAND(2, 3); L2[4] = CAND(2, 4); L2[5] = CAND(3, 0); L2[6] = CAND(3, 1); L2[7] = CAND(3, 2);
        L2[8] = CAND(3, 3); L2[9] = CAND(4, 0); L2[10] = CAND(4, 1); L2[11] = CAND(4, 2); L2[12] = CAND(5, 0); L2[13] = CAND(5, 1); L2[14] = CAND(6, 0); L2[15] = CAND(6, 1);
        {
          float S[9]; const float x71 = CAND(7, 1);
#pragma unroll
          for (int i = 0; i < 9; ++i) S[i] = CAND(7 + i, 0);
          L3[0] = S[0];
#pragma unroll
          for (int i = 1; i < 9; ++i) L3[i] = vmed3f(S[i - 1], S[i], x71);
          L3[9] = vminf(S[8], x71); }
#pragma unroll
        for (int i = 10; i < 16; ++i) L3[i] = -3.0e38f;
#undef CAND
        sort16_desc(L2);
        merge_top16(L0, L1); merge_top16(L2, L3); merge_top16(L0, L2);
        float e[16], sum = 0.f; const float mx = __uint_as_float(__float_as_uint(L0[0]) & ~16383u);
#pragma unroll
        for (int i = 0; i < 16; ++i) { e[i] = __expf(__uint_as_float(__float_as_uint(L0[i]) & ~16383u) - mx); sum += e[i]; }
        const float inv = 1.0f / sum;
        if (mytile < ntile) {
            int* ip = PIDX + (size_t)tok * 128 + h * 16; float* gp = PG + (size_t)tok * 128 + h * 16; float* up = PUS + (size_t)tok * 128 + h * 16;
#pragma unroll
            for (int i = 0; i < 4; ++i) {
                const int ea = (int)(__float_as_uint(L0[4 * i]) & 16383u), eb = (int)(__float_as_uint(L0[4 * i + 1]) & 16383u), ec = (int)(__float_as_uint(L0[4 * i + 2]) & 16383u), ed = (int)(__float_as_uint(L0[4 * i + 3]) & 16383u);
                *(int4*)(ip + 4 * i) = make_int4((int)((pk_bf16(0.f, US[ea]) & 0xffff0000u) | (unsigned)ea), (int)((pk_bf16(0.f, US[eb]) & 0xffff0000u) | (unsigned)eb),
                                                 (int)((pk_bf16(0.f, US[ec]) & 0xffff0000u) | (unsigned)ec), (int)((pk_bf16(0.f, US[ed]) & 0xffff0000u) | (unsigned)ed));
                *(float4*)(gp + 4 * i) = make_float4(e[4 * i] * inv * VS[ea], e[4 * i + 1] * inv * VS[eb], e[4 * i + 2] * inv * VS[ec], e[4 * i + 3] * inv * VS[ed]);
}
        }
    }
    if (wave >= 4) h4_rows(p, l, obid() * NWAVE + wave, ogrid() * NWAVE, h4_nrow);
}
template <int CTRL> __device__ __forceinline__ float dppf(float x) { return __builtin_bit_cast(float, __builtin_amdgcn_mov_dpp(__builtin_bit_cast(int, x), CTRL, 0xf, 0xf, true)); }
struct PeerGeom { int slice_lo, nslice, wid, nworkers; };
__device__ __forceinline__ PeerGeom peer_geom(LAS unsigned char* lds, int wave) {
    volatile LAS unsigned* st = (volatile LAS unsigned*)(lds + ST_OFF);
    const unsigned nx = st[1], rank = st[4], dense = st[6], base = st[7], total = st[8];
    PeerGeom g;
    if (nx == 8u && total > 0u && base + rank < total) { g.slice_lo = (int)(dense & 3u); g.nslice = 1; g.wid = (int)(base + rank) * NWAVE + wave; g.nworkers = (int)total * NWAVE; }
    else { g.slice_lo = 0; g.nslice = 4; g.wid = obid() * NWAVE + wave; g.nworkers = ogrid() * NWAVE; }
    return g;
}
template <bool VP> struct PeerRaw { int2 e2; float2 g2; uint4 h[4]; };
template <bool VP> __device__ __forceinline__ void peer_load_raw(PeerRaw<VP>& R, int t, int lane, int colbase, const int* PIDX, const float* PG, const float* UP, const bf16_t* H) {
    R.e2 = *(const int2*)(PIDX + (size_t)t * 128 + 2 * lane);
    if (VP) R.g2 = *(const float2*)(PG + (size_t)t * 128 + 2 * lane);
    if (!VP) { const uint4* hp = (const uint4*)(H + (size_t)t * D + colbase); R.h[0] = hp[0]; R.h[1] = hp[1]; R.h[2] = hp[2]; R.h[3] = hp[3]; }
}
template <bool VP> __device__ __forceinline__ void peer_stage(const PeerRaw<VP>& R, LAS float* lw, int lane, int rg, int (&E)[16], float (&W)[16]) {
    *(LAS f32x2_t*)(lw + 2 * lane) = (f32x2_t){__int_as_float(R.e2.x), __int_as_float(R.e2.y)};
    if (VP) *(LAS f32x2_t*)(lw + 128 + 2 * lane) = (f32x2_t){R.g2.x, R.g2.y};
    __builtin_amdgcn_wave_barrier();
#pragma unroll
    for (int i = 0; i < 4; ++i) { const f32x4_t v = *(LAS f32x4_t*)(lw + 16 * rg + 4 * i); E[4 * i] = __float_as_int(v[0]); E[4 * i + 1] = __float_as_int(v[1]); E[4 * i + 2] = __float_as_int(v[2]); E[4 * i + 3] = __float_as_int(v[3]); }
    if (VP) {
#pragma unroll
        for (int i = 0; i < 4; ++i) { const f32x4_t v = *(LAS f32x4_t*)(lw + 128 + 16 * rg + 4 * i); W[4 * i] = v[0]; W[4 * i + 1] = v[1]; W[4 * i + 2] = v[2]; W[4 * i + 3] = v[3]; } }
    __builtin_amdgcn_wave_barrier();
}
__device__ __forceinline__ void unpack32_bf16(const uint4 (&h)[4], float (&f)[32]) {
#pragma unroll
    for (int i = 0; i < 4; ++i) { float a[8]; unpack8(h[i], a);
#pragma unroll
        for (int j = 0; j < 8; ++j) f[8 * i + j] = a[j]; }
}
typedef _Float16 h2_t __attribute__((ext_vector_type(2)));
__device__ __forceinline__ void cvt32_fp4_h2(const u32x4_t w, h2_t (&f)[16]) {
#pragma unroll
    for (int d = 0; d < 4; ++d) {
        f[4 * d + 0] = __builtin_bit_cast(h2_t, __builtin_amdgcn_cvt_scalef32_pk_f16_fp4(w[d], 1.0f, 0)); f[4 * d + 1] = __builtin_bit_cast(h2_t, __builtin_amdgcn_cvt_scalef32_pk_f16_fp4(w[d], 1.0f, 1));
        f[4 * d + 2] = __builtin_bit_cast(h2_t, __builtin_amdgcn_cvt_scalef32_pk_f16_fp4(w[d], 1.0f, 2)); f[4 * d + 3] = __builtin_bit_cast(h2_t, __builtin_amdgcn_cvt_scalef32_pk_f16_fp4(w[d], 1.0f, 3)); }
}
__device__ __forceinline__ void pack32_h2(const float (&f)[32], h2_t (&h)[16]) {
#pragma unroll
    for (int i = 0; i < 16; ++i) h[i] = __builtin_bit_cast(h2_t, __builtin_amdgcn_cvt_pkrtz(f[2 * i], f[2 * i + 1]));
}
constexpr int PEER_STAGE_OFF = 131072 + 1024;
template <bool VP> __device__ __forceinline__ void peer_rows4(const u32x4_t (&r)[4], int i0, const h2_t (&hf)[16], const float (&W)[16], float (&acc)[16], h2_t (&acc2)[16]) {
#pragma unroll
    for (int k = 0; k < 4; ++k) { h2_t f[16]; cvt32_fp4_h2(r[k], f);
        if (VP) { const h2_t wk = __builtin_bit_cast(h2_t, __builtin_amdgcn_cvt_pkrtz(W[i0 + k], W[i0 + k]));
#pragma unroll
            for (int j = 0; j < 16; ++j) acc2[j] = f[j] * wk + acc2[j];
            asm volatile("" : "+v"(acc2[0]), "+v"(acc2[1]), "+v"(acc2[2]), "+v"(acc2[3]), "+v"(acc2[4]), "+v"(acc2[5]), "+v"(acc2[6]), "+v"(acc2[7]), "+v"(acc2[8]), "+v"(acc2[9]), "+v"(acc2[10]), "+v"(acc2[11]), "+v"(acc2[12]), "+v"(acc2[13]), "+v"(acc2[14]), "+v"(acc2[15]));
        } else { h2_t d0 = {0, 0}, d1 = d0, d2 = d0, d3 = d0;
#pragma unroll
            for (int j = 0; j < 4; ++j) { d0 = f[j] * hf[j] + d0; d1 = f[4 + j] * hf[4 + j] + d1; d2 = f[8 + j] * hf[8 + j] + d2; d3 = f[12 + j] * hf[12 + j] + d3; }
            const h2_t dd = (d0 + d1) + (d2 + d3);
            float d = (float)dd.x + (float)dd.y;
            asm volatile("" : "+v"(d)); acc[i0 + k] = d; } }
}
typedef unsigned u32x2_t __attribute__((ext_vector_type(2)));
__device__ __forceinline__ void ld8_nowait(u32x2_t& d, const void* q) { asm volatile("global_load_dwordx2 %0, %1, off" : "=v"(d) : "v"(q) : "memory"); }
__device__ __forceinline__ void ld16_nowait(u32x4_t& d, const void* q) { asm volatile("global_load_dwordx4 %0, %1, off" : "=v"(d) : "v"(q) : "memory"); }
template <bool VP> __device__ __forceinline__ void phase_peer(const P& p, int l, LAS unsigned char* lds) {
    const int tid = otid(), wave = __builtin_amdgcn_readfirstlane(tid >> 6), lane = tid & 63, rg = lane >> 3, pc = lane & 7;
    const bool last = (l == DEPTH - 1); const int ntok = last ? NLAT : NTOK;
    const unsigned char* T4 = p.ws + (VP ? WS_VT : WS_UT) + (size_t)l * 16384 * 512;
    const int* PIDX = (const int*)(p.ws + WS_PIDX); const float* PG = (const float*)(p.ws + (VP ? WS_PG : WS_YCAT)); const bf16_t* H = (const bf16_t*)(p.ws + WS_H);
    float* UP = (float*)(p.ws + WS_PROJ); bf16_t* X = (bf16_t*)(p.ws + WS_XRES); const float* MOD = (const float*)(p.ws + WS_MOD);
    LAS float* lwb = (LAS float*)(lds + PEER_STAGE_OFF + wave * 2048);
    LAS unsigned char* ring = lds + wave * 16384;
    const PeerGeom G = peer_geom(lds, wave);
    const bool b3 = (lane & 8) != 0, b2 = (lane & 4) != 0, b1 = (lane & 2) != 0, b0 = (lane & 1) != 0;
    for (int si = 0; si < G.nslice; ++si) {
        const int s = G.slice_lo + si, colbase = 256 * s + 32 * pc;
        if (G.wid >= ntok) continue;
        const int ntk = (ntok - 1 - G.wid) / G.nworkers + 1;
        const unsigned char* T4c = T4 + 128 * s + 16 * pc;
        PeerRaw<VP> R; int E0[16], En[16]; float W[16], Wn[16]; h2_t hf[16], hfn[16];
#pragma unroll
        for (int i = 0; i < 16; ++i) { W[i] = 0.f; Wn[i] = 0.f; hf[i] = (h2_t){0, 0}; hfn[i] = (h2_t){0, 0}; }
        peer_load_raw<VP>(R, G.wid, lane, colbase, PIDX, PG, UP, H);
        if (!VP) { float t32[32]; unpack32_bf16(R.h, t32); pack32_h2(t32, hf); }
        peer_stage<VP>(R, lwb, lane, rg, E0, W);
#pragma unroll
        for (int i = 0; i < 16; ++i) __builtin_amdgcn_global_load_lds((const unsigned*)(T4c + ((unsigned)E0[i] << 9)), (LAS unsigned*)(ring + i * 1024), 16, 0, 0);
        { const int t1 = G.wid + ((1 < ntk) ? 1 : 0) * G.nworkers; peer_load_raw<VP>(R, t1, lane, colbase, PIDX, PG, UP, H); }
        if (!VP) { float t32[32]; unpack32_bf16(R.h, t32); pack32_h2(t32, hfn); }
        peer_stage<VP>(R, lwb + 256, lane, rg, En, Wn);
        for (int j = 0; j < ntk; ++j) {
            const int t = G.wid + j * G.nworkers;
            const int j2 = (j + 2 < ntk) ? j + 2 : ntk - 1; const int t2 = G.wid + j2 * G.nworkers;
            u32x2_t e2r, g2r = (u32x2_t){0u, 0u}; u32x4_t z4 = (u32x4_t){0u, 0u, 0u, 0u}, hr[4] = {z4, z4, z4, z4}, gvr = z4; u32x2_t xvr = (u32x2_t){0u, 0u};
            ld8_nowait(e2r, PIDX + (size_t)t2 * 128 + 2 * lane);
            if (VP) ld8_nowait(g2r, PG + (size_t)t2 * 128 + 2 * lane);
            else { const bf16_t* hp = H + (size_t)t2 * D + colbase; ld16_nowait(hr[0], hp); ld16_nowait(hr[1], hp + 8); ld16_nowait(hr[2], hp + 16); ld16_nowait(hr[3], hp + 24); }
            if (VP) { const int col = colbase + 4 * rg; ld8_nowait(xvr, X + (size_t)t * D + col); ld16_nowait(gvr, MOD + (size_t)(l * 3 + row_sel(t)) * MODW + 5 * D + col); }
            else { u32x2_t g8; ld8_nowait(g8, PG + (size_t)t * 128 + 2 * lane); gvr[0] = g8[0]; gvr[1] = g8[1]; }
            float acc[16]; h2_t acc2[16];
#pragma unroll
            for (int i = 0; i < 16; ++i) { acc[i] = 0.f; acc2[i] = (h2_t){0, 0}; }
#pragma unroll
            for (int g4 = 0; g4 < 4; ++g4) {
                __builtin_amdgcn_sched_barrier(0);
                asm volatile("s_waitcnt vmcnt(12)" ::: "memory");
                u32x4_t r[4];
#pragma unroll
                for (int k = 0; k < 4; ++k) r[k] = *(LAS u32x4_t*)(ring + (4 * g4 + k) * 1024 + lane * 16);
                asm volatile("s_waitcnt lgkmcnt(0)" ::: "memory");
#pragma unroll
                for (int k = 0; k < 4; ++k) __builtin_amdgcn_global_load_lds((const unsigned*)(T4c + ((unsigned)En[4 * g4 + k] << 9)), (LAS unsigned*)(ring + (4 * g4 + k) * 1024), 16, 0, 0);
                __builtin_amdgcn_sched_barrier(0);
                peer_rows4<VP>(r, 4 * g4, hf, W, acc, acc2);
            }
            __builtin_amdgcn_sched_barrier(0);
            asm volatile("s_waitcnt vmcnt(16)" : "+v"(e2r), "+v"(g2r), "+v"(xvr), "+v"(gvr), "+v"(hr[0]), "+v"(hr[1]), "+v"(hr[2]), "+v"(hr[3]) :: "memory");
            if (!VP) {
#pragma unroll
                for (int k = 0; k < 8; ++k) { const float tt = b2 ? acc[k + 8] : acc[k], ss = b2 ? acc[k] : acc[k + 8]; acc[k] = tt + dppf<0x141>(ss); }
#pragma unroll
                for (int k = 0; k < 4; ++k) { const float tt = b1 ? acc[k + 4] : acc[k], ss = b1 ? acc[k] : acc[k + 4]; acc[k] = tt + dppf<0x4E>(ss); }
#pragma unroll
                for (int k = 0; k < 2; ++k) { const float tt = b0 ? acc[k + 2] : acc[k], ss = b0 ? acc[k] : acc[k + 2]; acc[k] = tt + dppf<0xB1>(ss); }
                *(float2*)(UP + ((size_t)s * NTOK + t) * 128 + 2 * lane) = make_float2(acc[0] * __uint_as_float(gvr[0]), acc[1] * __uint_as_float(gvr[1]));
            } else {
                float av[32];
#pragma unroll
                for (int k = 0; k < 16; ++k) { av[2 * k] = (float)acc2[k].x; av[2 * k + 1] = (float)acc2[k].y; }
#pragma unroll
                for (int k = 0; k < 16; ++k) { auto r = __builtin_amdgcn_permlane32_swap(__float_as_uint(av[k]), __float_as_uint(av[k + 16]), false, false); av[k] = __uint_as_float(r[0]) + __uint_as_float(r[1]); }
#pragma unroll
                for (int k = 0; k < 8; ++k) { auto r = __builtin_amdgcn_permlane16_swap(__float_as_uint(av[k]), __float_as_uint(av[k + 8]), false, false); av[k] = __uint_as_float(r[0]) + __uint_as_float(r[1]); }
#pragma unroll
                for (int k = 0; k < 4; ++k) { const float tt = b3 ? av[k + 4] : av[k], ss = b3 ? av[k] : av[k + 4]; acc[k] = tt + dppf<0x128>(ss); }
                const int col = colbase + 4 * rg; uint2* xp = (uint2*)(X + (size_t)t * D + col);
                float4 xv = make_float4(bf_lo(xvr[0]), bf_hi(xvr[0]), bf_lo(xvr[1]), bf_hi(xvr[1]));
                xv.x = fmaf(__uint_as_float(gvr[0]), acc[0], xv.x); xv.y = fmaf(__uint_as_float(gvr[1]), acc[1], xv.y); xv.z = fmaf(__uint_as_float(gvr[2]), acc[2], xv.z); xv.w = fmaf(__uint_as_float(gvr[3]), acc[3], xv.w);
                *xp = make_uint2(pk_bf16(xv.x, xv.y), pk_bf16(xv.z, xv.w));
            }
#pragma unroll
            for (int i = 0; i < 16; ++i) W[i] = Wn[i];
            if (!VP) {
#pragma unroll
                for (int i = 0; i < 16; ++i) hf[i] = hfn[i]; }
            R.e2 = make_int2((int)e2r[0], (int)e2r[1]); R.g2 = make_float2(__uint_as_float(g2r[0]), __uint_as_float(g2r[1]));
            if (!VP) { const uint4 hh[4] = {make_uint4(hr[0][0], hr[0][1], hr[0][2], hr[0][3]), make_uint4(hr[1][0], hr[1][1], hr[1][2], hr[1][3]), make_uint4(hr[2][0], hr[2][1], hr[2][2], hr[2][3]), make_uint4(hr[3][0], hr[3][1], hr[3][2], hr[3][3])};
                float t32[32]; unpack32_bf16(hh, t32); pack32_h2(t32, hfn); }
            peer_stage<VP>(R, lwb + 256 * (j & 1), lane, rg, En, Wn);
        }
        asm volatile("s_waitcnt vmcnt(0)" ::: "memory");
    }
}
typedef int i32x8_t __attribute__((ext_vector_type(8)));
template <int C> __device__ __forceinline__ void fp4x3_pair(unsigned w, unsigned& a0, unsigned& a1, unsigned& a2) {
    const float x0 = bf_lo(w), x1 = bf_hi(w);
    a0 = __builtin_amdgcn_cvt_scalef32_pk_fp4_f32(a0, x0 * 0.5f, x1 * 0.5f, 1.0f, C);
    const f32x2_t q0 = __builtin_amdgcn_cvt_scalef32_pk_f32_fp4(a0, 1.0f, C);
    const float r0 = x0 - 2.0f * q0.x, r1 = x1 - 2.0f * q0.y;
    a1 = __builtin_amdgcn_cvt_scalef32_pk_fp4_f32(a1, r0 * 4.0f, r1 * 4.0f, 1.0f, C);
    const f32x2_t q1 = __builtin_amdgcn_cvt_scalef32_pk_f32_fp4(a1, 1.0f, C);
    a2 = __builtin_amdgcn_cvt_scalef32_pk_fp4_f32(a2, (r0 - 0.25f * q1.x) * 32.0f, (r1 - 0.25f * q1.y) * 32.0f, 1.0f, C);
}
__device__ __forceinline__ void h2_to_fp4x3(const u32x4_t (&raw)[4], i32x8_t& t0, i32x8_t& t1, i32x8_t& t2) {
#pragma unroll
    for (int d = 0; d < 4; ++d) { unsigned a0 = 0u, a1 = 0u, a2 = 0u;
        fp4x3_pair<0>(raw[d][0], a0, a1, a2); fp4x3_pair<1>(raw[d][1], a0, a1, a2); fp4x3_pair<2>(raw[d][2], a0, a1, a2); fp4x3_pair<3>(raw[d][3], a0, a1, a2);
        t0[d] = (int)a0; t1[d] = (int)a1; t2[d] = (int)a2; t0[4 + d] = 0; t1[4 + d] = 0; t2[4 + d] = 0; }
}
__device__ __forceinline__ void phase_peer_u(const P& p, int l, LAS unsigned char* lds) {
    const int tid = otid(), wave = __builtin_amdgcn_readfirstlane(tid >> 6), lane = tid & 63, r16 = lane & 15, kq = lane >> 4;
    const bool last = (l == DEPTH - 1); const int ntok = last ? NLAT : NTOK;
    const unsigned char* T4 = p.ws + WS_UT + (size_t)l * 16384 * 512;
    const unsigned char* PIDXb = p.ws + WS_PIDX; const unsigned char* PUSb = p.ws + WS_YCAT; const unsigned char* H4 = p.ws + WS_H4;
    float* UP = (float*)(p.ws + WS_PROJ);
    LAS unsigned char* meta = lds + PEER_STAGE_OFF + wave * 2560;
    LAS unsigned char* ring = lds + wave * 16384;
    const PeerGeom G = peer_geom(lds, wave);
    const int isel = r16 & 3;
    const int dm = lane >> 3, di = lane & 7;
    const int pc0 = (di - (dm >> 1)) & 7, pc1 = (di - (dm >> 1) - 4) & 7;
    const int rm = r16 & 7, rsl = r16 >> 3;
    const int rd0 = (8 * rm + ((kq + (rm >> 1) + 4 * rsl) & 7)) * 16, rd1 = (8 * rm + ((kq + 4 + (rm >> 1) + 4 * rsl) & 7)) * 16;
    for (int si = 0; si < G.nslice; ++si) {
        const int s = G.slice_lo + si;
        if (G.wid >= ntok) continue;
        const int ntk = (ntok - 1 - G.wid) / G.nworkers + 1;
        const unsigned char* T4a = T4 + (size_t)s * TSLICE + 16 * pc0; const unsigned char* T4b = T4 + (size_t)s * TSLICE + 16 * pc1;
#define PU_META(K) do { const int tk_ = G.wid + ((K) < ntk ? (K) : ntk - 1) * G.nworkers; LAS unsigned char* ms_ = meta + ((K) & 1) * 1280; \
            if (lane < 48) __builtin_amdgcn_global_load_lds((const unsigned*)(lane < 32 ? PIDXb + (size_t)tk_ * 512 + 16 * lane : H4 + (size_t)tk_ * 1536 + 128 * s + (lane < 40 ? 16 * (lane - 32) : 512 + 16 * (lane - 40))), (LAS unsigned*)ms_, 16, 0, 0); \
            } while (0)
#define PU_IDS(K, E) do { const LAS unsigned char* ms_ = meta + ((K) & 1) * 1280 + 32 * dm; _Pragma("unroll") for (int q4 = 0; q4 < 4; ++q4) { const u32x4_t ev = *(const LAS u32x4_t*)(ms_ + 256 * (q4 >> 1) + 16 * (q4 & 1)); \
            E[4 * q4] = (int)(ev[0] & 16383u); E[4 * q4 + 1] = (int)(ev[1] & 16383u); E[4 * q4 + 2] = (int)(ev[2] & 16383u); E[4 * q4 + 3] = (int)(ev[3] & 16383u); } } while (0)
#define PU_REGS(K, B0_, B1_, U0_, U1_) do { const LAS unsigned char* ms_ = meta + ((K) & 1) * 1280; \
            B0_[0] = *(const LAS u32x4_t*)(ms_ + 512 + 16 * kq); B0_[1] = *(const LAS u32x4_t*)(ms_ + 512 + 64 + 16 * kq); B1_[0] = *(const LAS u32x4_t*)(ms_ + 640 + 16 * kq); B1_[1] = *(const LAS u32x4_t*)(ms_ + 640 + 64 + 16 * kq); \
            U0_ = *(const LAS u32x4_t*)(ms_ + 32 * (4 * kq + isel)) & 0xffff0000u; U1_ = *(const LAS u32x4_t*)(ms_ + 32 * (4 * kq + isel) + 16) & 0xffff0000u; } while (0)
        int En[16]; u32x4_t Bc0[2], Bc1[2], Uc0, Uc1;
        PU_META(0); PU_META(1);
        asm volatile("s_waitcnt vmcnt(0)" ::: "memory");
        __builtin_amdgcn_sched_barrier(0);
        PU_IDS(0, En); PU_REGS(0, Bc0, Bc1, Uc0, Uc1);
        asm volatile("s_waitcnt lgkmcnt(0)" : "+v"(Bc0[0]), "+v"(Bc0[1]), "+v"(Bc1[0]), "+v"(Bc1[1]), "+v"(Uc0), "+v"(Uc1) :: "memory");
        __builtin_amdgcn_sched_barrier(0);
#pragma unroll
        for (int gI = 0; gI < 8; ++gI) {
            __builtin_amdgcn_global_load_lds((const unsigned*)(T4a + ((unsigned)En[gI] << 7)), (LAS unsigned*)(ring + (2 * gI) * 1024), 16, 0, 0);
            __builtin_amdgcn_global_load_lds((const unsigned*)(T4b + ((unsigned)En[8 + gI] << 7)), (LAS unsigned*)(ring + (2 * gI + 1) * 1024), 16, 0, 0); }
        __builtin_amdgcn_sched_barrier(0);
        for (int j = 0; j < ntk; ++j) {
            const int t = G.wid + j * G.nworkers;
            PU_META(j + 2);
            __builtin_amdgcn_sched_barrier(0);
            u32x4_t Bn0[2], Bn1[2], Un0, Un1;
            f32x4_t acc[8];
#pragma unroll
            for (int gI = 0; gI < 8; ++gI) acc[gI] = (f32x4_t){0.f, 0.f, 0.f, 0.f};
#pragma unroll
            for (int gI = 0; gI < 8; ++gI) {
                __builtin_amdgcn_sched_barrier(0);
                asm volatile("s_waitcnt vmcnt(15)" ::: "memory");
                __builtin_amdgcn_sched_barrier(0);
                if (gI == 0) { PU_IDS(j + 1, En); PU_REGS(j + 1, Bn0, Bn1, Un0, Un1); }
                const u32x4_t r0 = *(LAS u32x4_t*)(ring + (2 * gI + rsl) * 1024 + rd0), r1 = *(LAS u32x4_t*)(ring + (2 * gI + rsl) * 1024 + rd1);
                if (gI == 0) asm volatile("s_waitcnt lgkmcnt(0)" : "+v"(Bn0[0]), "+v"(Bn0[1]), "+v"(Bn1[0]), "+v"(Bn1[1]), "+v"(Un0), "+v"(Un1) :: "memory");
                else asm volatile("s_waitcnt lgkmcnt(0)" ::: "memory");
                __builtin_amdgcn_global_load_lds((const unsigned*)(T4a + ((unsigned)En[gI] << 7)), (LAS unsigned*)(ring + (2 * gI) * 1024), 16, 0, 0);
                __builtin_amdgcn_global_load_lds((const unsigned*)(T4b + ((unsigned)En[8 + gI] << 7)), (LAS unsigned*)(ring + (2 * gI + 1) * 1024), 16, 0, 0);
                __builtin_amdgcn_sched_barrier(0);
                const i32x8_t A0 = {(int)r0[0], (int)r0[1], (int)r0[2], (int)r0[3], 0, 0, 0, 0}, A1 = {(int)r1[0], (int)r1[1], (int)r1[2], (int)r1[3], 0, 0, 0, 0};
                const i32x8_t B00 = {(int)Bc0[0][0], (int)Bc0[0][1], (int)Bc0[0][2], (int)Bc0[0][3], 0, 0, 0, 0}, B10 = {(int)Bc1[0][0], (int)Bc1[0][1], (int)Bc1[0][2], (int)Bc1[0][3], 0, 0, 0, 0};
                const i32x8_t B01 = {(int)Bc0[1][0], (int)Bc0[1][1], (int)Bc0[1][2], (int)Bc0[1][3], 0, 0, 0, 0}, B11 = {(int)Bc1[1][0], (int)Bc1[1][1], (int)Bc1[1][2], (int)Bc1[1][3], 0, 0, 0, 0};
                acc[gI] = __builtin_amdgcn_mfma_scale_f32_16x16x128_f8f6f4(A0, B00, acc[gI], 4, 4, 0, 127, 0, 128);
                acc[gI] = __builtin_amdgcn_mfma_scale_f32_16x16x128_f8f6f4(A0, B10, acc[gI], 4, 4, 0, 127, 0, 125);
                acc[gI] = __builtin_amdgcn_mfma_scale_f32_16x16x128_f8f6f4(A1, B01, acc[gI], 4, 4, 0, 127, 0, 128);
                acc[gI] = __builtin_amdgcn_mfma_scale_f32_16x16x128_f8f6f4(A1, B11, acc[gI], 4, 4, 0, 127, 0, 125);
            }
            __builtin_amdgcn_sched_barrier(0);
            { float v[8];
#pragma unroll
              for (int gI = 0; gI < 8; ++gI) v[gI] = isel == 0 ? acc[gI][0] : (isel == 1 ? acc[gI][1] : (isel == 2 ? acc[gI][2] : acc[gI][3]));
              if (r16 < 4) { uint4* up = (uint4*)((bf16_t*)UP + ((size_t)s * NTOK + t) * 128 + 8 * (4 * kq + isel));
                  *up = make_uint4(pk_bf16(v[0] * __uint_as_float(Uc0[0]), v[1] * __uint_as_float(Uc0[1])), pk_bf16(v[2] * __uint_as_float(Uc0[2]), v[3] * __uint_as_float(Uc0[3])),
                                   pk_bf16(v[4] * __uint_as_float(Uc1[0]), v[5] * __uint_as_float(Uc1[1])), pk_bf16(v[6] * __uint_as_float(Uc1[2]), v[7] * __uint_as_float(Uc1[3]))); } }
            Bc0[0] = Bn0[0]; Bc0[1] = Bn0[1]; Bc1[0] = Bn1[0]; Bc1[1] = Bn1[1]; Uc0 = Un0; Uc1 = Un1;
        }
        asm volatile("s_waitcnt vmcnt(0)" ::: "memory");
#undef PU_META
#undef PU_IDS
#undef PU_REGS
    }
}
__device__ __forceinline__ void phase_peer_w(const P& p, int l) {
    const float* UP = (const float*)(p.ws + WS_PROJ); float* PG = (float*)(p.ws + WS_PG);
    const int ntok = (l == DEPTH - 1) ? NLAT : NTOK;
    const size_t n4 = (size_t)ntok * 32, stride = (size_t)ogrid() * NTHR;
    for (size_t i = (size_t)obid() * NTHR + otid(); i < n4; i += stride) {
        float4 a = ((const float4*)UP)[i];
#pragma unroll
        for (int s = 1; s < 4; ++s) { const float4 b = ((const float4*)UP)[(size_t)s * NTOK * 32 + i]; a.x += b.x; a.y += b.y; a.z += b.z; a.w += b.w; }
        float4 g = ((float4*)PG)[i];
        g.x *= gelu_tanh(a.x); g.y *= gelu_tanh(a.y); g.z *= gelu_tanh(a.z); g.w *= gelu_tanh(a.w);
        ((float4*)PG)[i] = g;
    }
}
__device__ __forceinline__ void phase_peer_w4(const P& p, int l) {
    const bf16_t* UP = (const bf16_t*)(p.ws + WS_PROJ); const float* PG = (const float*)(p.ws + WS_PG); unsigned char* PW4 = p.ws + WS_PW4;
    const int ntok = (l == DEPTH - 1) ? NLAT : NTOK;
    const int lane = otid() & 63, gw = obid() * NWAVE + owave(), nw = ogrid() * NWAVE;
    const int k0 = 2 * lane, p0 = 16 * (k0 & 7) + (k0 >> 3), p1 = 16 * ((k0 + 1) & 7) + ((k0 + 1) >> 3);
    for (int tb = gw; tb < ntok; tb += 4 * nw) {
        float u0[4][4], u1[4][4], g0[4], g1[4];
#pragma unroll
        for (int q = 0; q < 4; ++q) { const int t = min(tb + q * nw, ntok - 1);
#pragma unroll
            for (int sl = 0; sl < 4; ++sl) { const bf16_t* u = UP + ((size_t)sl * NTOK + t) * 128; u0[q][sl] = bf1(u[p0]); u1[q][sl] = bf1(u[p1]); }
            g0[q] = PG[(size_t)t * 128 + p0]; g1[q] = PG[(size_t)t * 128 + p1]; }
#pragma unroll
        for (int q = 0; q < 4; ++q) { const int t = tb + q * nw;
            const float a0 = (u0[q][0] + u0[q][1]) + (u0[q][2] + u0[q][3]), a1 = (u1[q][0] + u1[q][1]) + (u1[q][2] + u1[q][3]);
            const float w0 = g0[q] * gelu_tanh(a0), w1 = g1[q] * gelu_tanh(a1);
            const float am = fmaxf(wave_max(fmaxf(fabsf(w0), fabsf(w1))), 1e-30f), inv = 6.0f / am;
            const float b0 = w0 * inv, b1 = w1 * inv;
            const unsigned t0 = __builtin_amdgcn_cvt_scalef32_pk_fp4_f32(0u, b0, b1, 1.0f, 0);
            const auto q0 = __builtin_amdgcn_cvt_scalef32_pk_f32_fp4(t0, 1.0f, 0);
            const unsigned t1 = __builtin_amdgcn_cvt_scalef32_pk_fp4_f32(0u, (b0 - q0[0]) * 4.0f, (b1 - q0[1]) * 4.0f, 1.0f, 0);
            if (t < ntok) { PW4[(size_t)t * 144 + lane] = (unsigned char)(t0 & 0xffu); PW4[(size_t)t * 144 + 64 + lane] = (unsigned char)(t1 & 0xffu);
                if (lane == 0) *(float*)(PW4 + (size_t)t * 144 + 128) = am * (1.0f / 6.0f); } }
    }
}
template <int OFF> __device__ __forceinline__ u32x2_t tr4_read(unsigned ad) { u32x2_t r; asm volatile("ds_read_b64_tr_b4 %0, %1 offset:%2" : "=&v"(r) : "v"(ad), "i"(OFF) : "memory"); return r; }
__device__ __forceinline__ void ld4_nowait(unsigned& d, const void* q) { asm volatile("global_load_dword %0, %1, off" : "=v"(d) : "v"(q) : "memory"); }
__device__ __forceinline__ void ld2_nowait(unsigned& d, const void* q) { asm volatile("global_load_ushort %0, %1, off" : "=v"(d) : "v"(q) : "memory"); }
template <int HH, int A2, int Q> __device__ __forceinline__ void pv_read(u32x2_t (&lo)[2][4], u32x2_t (&hi)[2][4], unsigned rb, const unsigned (&po)[2][2]) {
    lo[A2][Q] = tr4_read<8192 * HH + 8 * (Q & 1)>(rb + po[A2][Q >> 1]); hi[A2][Q] = tr4_read<8192 * HH + 2048 + 8 * (Q & 1)>(rb + po[A2][Q >> 1]); }
__device__ __forceinline__ void phase_peer_v(const P& p, int l, LAS unsigned char* lds) {
    const int tid = otid(), wave = __builtin_amdgcn_readfirstlane(tid >> 6), lane = tid & 63, n16 = lane & 15, kg = lane >> 4, dm = lane >> 3, di = lane & 7;
    const bool last = (l == DEPTH - 1); const int ntok = last ? NLAT : NTOK;
    const unsigned char* T4 = p.ws + WS_VT + (size_t)l * 16384 * 512;
    const unsigned char* PIDXb = p.ws + WS_PIDX; const unsigned char* PW4 = p.ws + WS_PW4;
    bf16_t* X = (bf16_t*)(p.ws + WS_XRES); const float* MOD = (const float*)(p.ws + WS_MOD); float* SSP = (float*)(p.ws + WS_SSP) + (size_t)((l + 1) & 3) * 4 * NTOK;
    LAS unsigned char* meta = lds + PEER_STAGE_OFF + wave * 2560;
    LAS unsigned char* ring = lds + wave * 16384;
    const PeerGeom G = peer_geom(lds, wave);
    const int pc0 = (di - (dm >> 1)) & 7, pc1 = (di - (dm >> 1) - 4) & 7;
    const int tm = n16 & 7, trot = (tm >> 1) + 4 * (n16 >> 3), ub = kg >> 1;
    const unsigned rb = (unsigned)(uintptr_t)ring + (unsigned)((4 * (kg & 1) + (n16 >> 3)) * 1024 + 128 * tm);
    unsigned po[2][2];
#pragma unroll
    for (int a = 0; a < 2; ++a)
#pragma unroll
        for (int qh = 0; qh < 2; ++qh) po[a][qh] = (unsigned)(((4 * ub + 2 * a + qh + trot) & 7) * 16);
    const bool rowok = (((n16 >> 1) & 1) == ub);
    const int scA = (n16 & 1) ? 125 : 127;
    const int aoff = 512 + 64 * (n16 & 1) + 16 * (kg & 1);
    for (int si = 0; si < G.nslice; ++si) {
        const int s = G.slice_lo + si;
        if (G.wid >= ntok) continue;
        const int ntk = (ntok - 1 - G.wid) / G.nworkers + 1;
        const unsigned char* T4a = T4 + (size_t)s * TSLICE + 16 * pc0; const unsigned char* T4b = T4 + (size_t)s * TSLICE + 16 * pc1;
        float gt[3][4];
#pragma unroll
        for (int sel = 0; sel < 3; ++sel)
#pragma unroll
            for (int c4 = 0; c4 < 4; ++c4) gt[sel][c4] = MOD[(size_t)(l * 3 + sel) * MODW + 5 * D + 256 * s + 64 * c4 + lane];
        asm volatile("s_waitcnt vmcnt(0)" : "+v"(gt[0][0]), "+v"(gt[0][1]), "+v"(gt[0][2]), "+v"(gt[0][3]), "+v"(gt[1][0]), "+v"(gt[1][1]), "+v"(gt[1][2]), "+v"(gt[1][3]), "+v"(gt[2][0]), "+v"(gt[2][1]), "+v"(gt[2][2]), "+v"(gt[2][3]) :: "memory");
#define PV_META(K) do { const int tk_ = G.wid + ((K) < ntk ? (K) : ntk - 1) * G.nworkers; LAS unsigned char* ms_ = meta + ((K) & 1) * 1280; \
            if (lane < 41) __builtin_amdgcn_global_load_lds((const unsigned*)(lane < 32 ? PIDXb + (size_t)tk_ * 512 + 16 * lane : PW4 + (size_t)tk_ * 144 + 16 * (lane - 32)), (LAS unsigned*)ms_, 16, 0, 0); \
            if (lane < 32) __builtin_amdgcn_global_load_lds((const unsigned*)((const unsigned char*)(X + (size_t)tk_ * D + 256 * s) + 16 * lane), (LAS unsigned*)(ms_ + 768), 16, 0, 0); } while (0)
#define PV_IDS(K, E) do { const LAS unsigned char* ms_ = meta + ((K) & 1) * 1280 + 64 * dm; _Pragma("unroll") for (int q4 = 0; q4 < 4; ++q4) { const u32x4_t ev = *(const LAS u32x4_t*)(ms_ + 16 * q4); \
            E[4 * q4] = (int)(ev[0] & 16383u); E[4 * q4 + 1] = (int)(ev[1] & 16383u); E[4 * q4 + 2] = (int)(ev[2] & 16383u); E[4 * q4 + 3] = (int)(ev[3] & 16383u); } } while (0)
#define PV_REGS(K, A_, X_, S_) do { const LAS unsigned char* ms_ = meta + ((K) & 1) * 1280; A_[0] = *(const LAS u32x4_t*)(ms_ + aoff); A_[1] = *(const LAS u32x4_t*)(ms_ + aoff + 32); \
            S_ = *(const LAS float*)(ms_ + 640); _Pragma("unroll") for (int c4 = 0; c4 < 4; ++c4) X_[c4] = (unsigned)*(const LAS unsigned short*)(ms_ + 768 + 2 * (64 * c4 + lane)); } while (0)
        int En[16]; u32x4_t Ac[2]; unsigned xc[4]; float sgc;
        PV_META(0); PV_META(1);
        asm volatile("s_waitcnt vmcnt(0)" ::: "memory");
        __builtin_amdgcn_sched_barrier(0);
        PV_IDS(0, En); PV_REGS(0, Ac, xc, sgc);
        asm volatile("s_waitcnt lgkmcnt(0)" : "+v"(Ac[0]), "+v"(Ac[1]), "+v"(xc[0]), "+v"(xc[1]), "+v"(xc[2]), "+v"(xc[3]), "+v"(sgc) :: "memory");
        __builtin_amdgcn_sched_barrier(0);
#pragma unroll
        for (int sl = 0; sl < 16; ++sl) __builtin_amdgcn_global_load_lds((const unsigned*)(((sl & 1) ? T4b : T4a) + ((unsigned)En[sl] << 7)), (LAS unsigned*)(ring + sl * 1024), 16, 0, 0);
        __builtin_amdgcn_sched_barrier(0);
        for (int j = 0; j < ntk; ++j) {
            const int t = G.wid + j * G.nworkers;
            PV_META(j + 2);
            __builtin_amdgcn_sched_barrier(0);
            f32x4_t acc[2] = {(f32x4_t){0.f, 0.f, 0.f, 0.f}, (f32x4_t){0.f, 0.f, 0.f, 0.f}};
            u32x4_t An[2]; unsigned xn[4]; float sgn;
#pragma unroll
            for (int hh = 0; hh < 2; ++hh) {
                __builtin_amdgcn_sched_barrier(0);
                asm volatile("s_waitcnt vmcnt(10)" ::: "memory");
                __builtin_amdgcn_sched_barrier(0);
                if (hh == 0) { PV_IDS(j + 1, En); PV_REGS(j + 1, An, xn, sgn); }
                u32x2_t lo[2][4], hi[2][4];
                if (hh == 0) { pv_read<0, 0, 0>(lo, hi, rb, po); pv_read<0, 1, 0>(lo, hi, rb, po); pv_read<0, 0, 1>(lo, hi, rb, po); pv_read<0, 1, 1>(lo, hi, rb, po);
                               pv_read<0, 0, 2>(lo, hi, rb, po); pv_read<0, 1, 2>(lo, hi, rb, po); pv_read<0, 0, 3>(lo, hi, rb, po); pv_read<0, 1, 3>(lo, hi, rb, po); }
                else         { pv_read<1, 0, 0>(lo, hi, rb, po); pv_read<1, 1, 0>(lo, hi, rb, po); pv_read<1, 0, 1>(lo, hi, rb, po); pv_read<1, 1, 1>(lo, hi, rb, po);
                               pv_read<1, 0, 2>(lo, hi, rb, po); pv_read<1, 1, 2>(lo, hi, rb, po); pv_read<1, 0, 3>(lo, hi, rb, po); pv_read<1, 1, 3>(lo, hi, rb, po); }
                asm volatile("s_waitcnt lgkmcnt(0)" : "+v"(lo[0][0]), "+v"(lo[0][1]), "+v"(lo[0][2]), "+v"(lo[0][3]), "+v"(lo[1][0]), "+v"(lo[1][1]), "+v"(lo[1][2]), "+v"(lo[1][3]),
                                                      "+v"(hi[0][0]), "+v"(hi[0][1]), "+v"(hi[0][2]), "+v"(hi[0][3]), "+v"(hi[1][0]), "+v"(hi[1][1]), "+v"(hi[1][2]), "+v"(hi[1][3]) :: "memory");
                __builtin_amdgcn_sched_barrier(0);
#pragma unroll
                for (int sl = 0; sl < 8; ++sl) __builtin_amdgcn_global_load_lds((const unsigned*)((((8 * hh + sl) & 1) ? T4b : T4a) + ((unsigned)En[8 * hh + sl] << 7)), (LAS unsigned*)(ring + (8 * hh + sl) * 1024), 16, 0, 0);
                __builtin_amdgcn_sched_barrier(0);
#pragma unroll
                for (int q = 0; q < 4; ++q) {
                    const bool ok = rowok && ((n16 >> 2) == q);
                    const i32x8_t Aq = {ok ? (int)Ac[hh][0] : 0, ok ? (int)Ac[hh][1] : 0, ok ? (int)Ac[hh][2] : 0, ok ? (int)Ac[hh][3] : 0, 0, 0, 0, 0};
#pragma unroll
                    for (int a = 0; a < 2; ++a) {
                        const i32x8_t B = {(int)lo[a][q][0], (int)lo[a][q][1], (int)hi[a][q][0], (int)hi[a][q][1], 0, 0, 0, 0};
                        acc[a] = __builtin_amdgcn_mfma_scale_f32_16x16x128_f8f6f4(Aq, B, acc[a], 4, 4, 0, scA, 0, 127); }
                }
            }
            __builtin_amdgcn_sched_barrier(0);
            { const int sel = row_sel(t); float ssq = 0.f;
#pragma unroll
              for (int c4 = 0; c4 < 4; ++c4) { const int a = c4 & 1, u = c4 >> 1; const float r = acc[a][2 * u] + acc[a][2 * u + 1];
                  const float gate = sel == 0 ? gt[0][c4] : (sel == 1 ? gt[1][c4] : gt[2][c4]);
                  const float xv = fmaf(gate * sgc, r, __uint_as_float(xc[c4] << 16));
                  const unsigned xb = pk_bf16(xv, 0.f) & 0xffffu; const float xr = __uint_as_float(xb << 16); ssq = fmaf(xr, xr, ssq);
                  X[(size_t)t * D + 256 * s + 64 * c4 + lane] = (bf16_t)xb; }
              if (!last) {
                  ssq += dppf<0xB1>(ssq); ssq += dppf<0x4E>(ssq); ssq += dppf<0x141>(ssq); ssq += dppf<0x140>(ssq); ssq = x4_sum(ssq);
                  if (lane == 0) SSP[(size_t)t * 4 + s] = ssq; } }
            Ac[0] = An[0]; Ac[1] = An[1]; sgc = sgn;
#pragma unroll
            for (int c4 = 0; c4 < 4; ++c4) xc[c4] = xn[c4];
        }
        asm volatile("s_waitcnt vmcnt(0)" ::: "memory");
#undef PV_META
#undef PV_IDS
#undef PV_REGS
    }
}
__device__ __forceinline__ void phase_final(const P& p) {
    const bf16_t* X = (const bf16_t*)(p.ws + WS_XRES);
    const int lane = otid() & 63, gw = obid() * NWAVE + owave(), nw = ogrid() * NWAVE;
    for (int r = gw; r < NLAT; r += nw) {
        const bf16_t* xr = X + (size_t)r * D; float4 v[4]; float ss = 0.f;
#pragma unroll
        for (int i = 0; i < 4; ++i) { const uint2 w = *(const uint2*)(xr + i * 256 + lane * 4); v[i] = make_float4(bf_lo(w.x), bf_hi(w.x), bf_lo(w.y), bf_hi(w.y)); ss += v[i].x * v[i].x + v[i].y * v[i].y + v[i].z * v[i].z + v[i].w * v[i].w; }
        ss = wave_sum(ss); const float rs = rsqrtf(ss * (1.0f / D) + EPS);
#pragma unroll
        for (int i = 0; i < 4; ++i) { const int col = i * 256 + lane * 4; const float4 gv = *(const float4*)(p.final_norm_g + col);
            float4 o; o.x = v[i].x * rs * gv.x; o.y = v[i].y * rs * gv.y; o.z = v[i].z * rs * gv.z; o.w = v[i].w * rs * gv.w;
            *(float4*)(p.out + (size_t)r * D + col) = o; }
    }
}
__device__ __forceinline__ bool gemm_has_slack(int ntiles) {
    const int G = ogrid(), c = obid(); const int mine = c < ntiles ? (ntiles - c + G - 1) / G : 0, most = (ntiles + G - 1) / G;
    return mine < most;
}
__device__ __forceinline__ void gemm_slack_work(const P& p, int l, LAS unsigned char* lds, bool before) {
    if (((obid() & 1) != 0) != before) return;
    if (l + 1 < DEPTH) deferred_drain(p, l + 1, lds, 1);
    else if (before) { for (int i = 0; i < 3; ++i) __builtin_amdgcn_s_sleep(127); }
}
__device__ __forceinline__ void phase_gemm_in(const P& p, int l, LAS unsigned char* lds) {
    pg8::Gemm g{(const bf16_t*)(p.ws + WS_H), (const bf16_t*)(p.ws + WS_WIN) + (size_t)l * IN_W * D, NTOK, IN_W, D};
    pg8::StaticOrder S; S.init(NTOK, IN_W, ogrid(), obid());
    pg8::EpiStoreBf16 E{(bf16_t*)(p.ws + WS_PROJ), IN_W};
    const bool slack = gemm_has_slack((NTOK / 256) * (IN_W / 256));
    if (slack) gemm_slack_work(p, l, lds, true);
    if (l == 0) pg8::gemm_phase<pg8::EpiStoreBf16, pg8::StaticOrder, false>(lds, g, S, E, nullptr);
    else {
        pg8::Gemm g3{(const bf16_t*)(p.ws + WS_XRES), (const bf16_t*)(p.ws + WS_WIN3) + (size_t)(l - 1) * 3 * IN_W * D, NTOK, IN_W, D, (size_t)IN_W * D * 2};
        pg8::EpiScaleBias<4> E3{(bf16_t*)(p.ws + WS_PROJ), IN_W, (const float*)(p.ws + WS_SSP) + (size_t)l * 4 * NTOK, (const float*)(p.ws + WS_BIASP) + (size_t)l * 3 * 2 * IN_W, 0};
        pg8::gemm_phase<pg8::EpiScaleBias<4>, pg8::StaticOrder, false>(lds, g3, S, E3, nullptr); }
    if (slack) gemm_slack_work(p, l, lds, false);
}
__device__ __forceinline__ void phase_gemm_out(const P& p, int l, LAS unsigned char* lds) {
    const int M = (l == DEPTH - 1) ? NLAT : NTOK;
    pg8::Gemm g{(const bf16_t*)(p.ws + WS_YCAT), (const bf16_t*)(p.ws + WS_WOUT) + (size_t)l * D * D, M, D, D};
    pg8::StaticOrder S; S.init(M, D, ogrid(), obid());
    pg8::EpiResid E{(bf16_t*)(p.ws + WS_XRES), l == 0 ? p.x : (const float*)nullptr, l == 0 ? p.ctx : (const float*)nullptr, D, (const float*)(p.ws + WS_MOD) + (size_t)l * 3 * MODW + 2 * D, MODW, (float*)(p.ws + WS_SSP2)};
    const bool slack = gemm_has_slack((M / 256) * (D / 256));
    if (slack) gemm_slack_work(p, l, lds, true);
    pg8::gemm_phase<pg8::EpiResid, pg8::StaticOrder, false>(lds, g, S, E, nullptr);
    if (slack) gemm_slack_work(p, l, lds, false);
}
__device__ __forceinline__ void phase_gemm_q(const P& p, int l, LAS unsigned char* lds) {
    const int M = (l == DEPTH - 1) ? NLAT : NTOK;
    pg8::Gemm g{(const bf16_t*)(p.ws + WS_XRES), (const bf16_t*)(p.ws + WS_WQ3) + (size_t)l * 3 * QW * D, M, QW, D, (size_t)QW * D * 2};
    pg8::StaticOrder S; S.init(M, QW, ogrid(), obid());
    pg8::EpiScaleBias<16> E{(bf16_t*)(p.ws + WS_Q), QW, (const float*)(p.ws + WS_SSP2), (const float*)(p.ws + WS_BIASP2) + (size_t)l * 3 * 2 * QW, NTOK};
    const bool slack = gemm_has_slack((M / 256) * (QW / 256));
    if (slack) gemm_slack_work(p, l, lds, true);
    pg8::gemm_phase<pg8::EpiScaleBias<16>, pg8::StaticOrder, false>(lds, g, S, E, nullptr);
    if (slack) gemm_slack_work(p, l, lds, false);
}


#define XB_TMO      128
#define XB_XCNT(j)  (256  + 64 * (j))
#define XB_XSUB(j)  (1280 + 64 * (j))
#define XB_XGEN(j)  (2304 + 64 * (j))
#define XB_TOP      3328
#define XB_TOPGEN   3392
#define XCD_BAR_WORDS 3456
#define XB_SPIN_CAP (1u << 18)

__device__ __forceinline__ unsigned xb_ld(unsigned* p)              { return __hip_atomic_load(p, __ATOMIC_RELAXED, __HIP_MEMORY_SCOPE_AGENT); }
__device__ __forceinline__ unsigned xb_add(unsigned* p, unsigned v) { return __hip_atomic_fetch_add(p, v, __ATOMIC_RELAXED, __HIP_MEMORY_SCOPE_AGENT); }
__device__ __forceinline__ unsigned xb_xcc_id() { return (unsigned)__builtin_amdgcn_s_getreg((3 << 11) | 20) & 0xFu; }
#define XB_SPIN(cond, bar) do { unsigned _sp = 0; while (cond) { __builtin_amdgcn_s_sleep(1); \
    if ((++_sp & 255u) == 0u) { if (xb_ld(&(bar)[XB_TMO])) break; if (_sp > XB_SPIN_CAP) { atomicAdd(&(bar)[XB_TMO], 1u); break; } } } } while (0)
struct XcdBarrier {
    unsigned* bar; unsigned x;
    volatile LAS unsigned* st;
};

__device__ __forceinline__ XcdBarrier xcd_barrier_post(unsigned* bar, volatile LAS unsigned* st) {
    XcdBarrier b; b.bar = bar; b.x = xb_xcc_id(); b.st = st;
    if (hw_tid() == 0) (void)xb_add(&bar[XB_XCNT(b.x)], 1u);
    return b;
}
__device__ __forceinline__ void xcd_barrier_complete(unsigned* bar, unsigned x, unsigned& nloc, unsigned& nx) {
    const unsigned G = (unsigned)ogrid();
    unsigned sum, cnt, mine, sp = 0u;
    for (;;) {
        sum = 0u; cnt = 0u; mine = 0u;
#pragma unroll
        for (unsigned j = 0; j < 16; ++j) { const unsigned c = xb_ld(&bar[XB_XCNT(j)]); sum += c; cnt += (c > 0u) ? 1u : 0u; mine = (j == x) ? c : mine; }
        if (sum == G) break;
        __builtin_amdgcn_s_sleep(1);
        if ((++sp & 255u) == 0u) { if (xb_ld(&bar[XB_TMO])) break; if (sp > XB_SPIN_CAP) { atomicAdd(&bar[XB_TMO], 1u); break; } }
    }
    nloc = mine > 0u ? mine : 1u; nx = cnt > 0u ? cnt : 1u;
}

__device__ __forceinline__ void xcd_barrier(const XcdBarrier& b) {
    asm volatile("s_waitcnt vmcnt(0)" ::: "memory");
    __syncthreads();
    if (hw_tid() == 0) {
        unsigned* bar = b.bar;
        __builtin_amdgcn_s_waitcnt(0);
        unsigned nloc = b.st[0], nx = b.st[1];
        if (nloc == 0u) { xcd_barrier_complete(bar, b.x, nloc, nx); b.st[0] = nloc; b.st[1] = nx; }
        const unsigned old = xb_add(&bar[XB_XSUB(b.x)], 1u);
        const unsigned gen = old / nloc;
        if (old + 1u == (gen + 1u) * nloc) {
            __builtin_amdgcn_fence(__ATOMIC_RELEASE, "agent");
            asm volatile("s_waitcnt vmcnt(0)" ::: "memory");
            const unsigned og = xb_add(&bar[XB_TOP], 1u);
            const unsigned tg = og / nx;
            if (og + 1u == (tg + 1u) * nx) xb_add(&bar[XB_TOPGEN], 1u);
            else XB_SPIN(xb_ld(&bar[XB_TOPGEN]) == tg, bar);
            __builtin_amdgcn_fence(__ATOMIC_ACQUIRE, "agent");
            xb_add(&bar[XB_XGEN(b.x)], 1u);
            asm volatile("s_waitcnt vmcnt(0)" ::: "memory");
        } else {
            XB_SPIN(xb_ld(&bar[XB_XGEN(b.x)]) == gen, bar);
            __builtin_amdgcn_fence(__ATOMIC_ACQUIRE, "agent");
            asm volatile("s_waitcnt vmcnt(0)" ::: "memory");
        }
    }
    __syncthreads();
}

__global__ void __launch_bounds__(NTHR, 2) k_mega(P p) {
    extern __shared__ __attribute__((aligned(16))) unsigned char shm[];
    LAS unsigned char* lds = (LAS unsigned char*)shm;
    volatile LAS unsigned* st = (volatile LAS unsigned*)(lds + ST_OFF);
    if (threadIdx.x < 16) st[threadIdx.x] = 0u;
    st[WTAB_WORD + ((unsigned)__builtin_amdgcn_s_getreg((5 << 11) | 4))] = threadIdx.x >> 6;
    __syncthreads();
    (void)xcd_barrier_post((unsigned*)(p.ws + WS_CTL), st);
    if (hw_tid() == 0) st[4] = xb_add((unsigned*)(p.ws + WS_CTL) + 4096 + 64 * xb_xcc_id(), 1u);
#define GRID_BAR() do { XcdBarrier b_; { size_t z_ = 0; asm volatile("" : "+s"(z_)); b_.bar = (unsigned*)(p.ws + z_ + WS_CTL); } b_.x = xb_xcc_id(); \
        b_.st = (volatile LAS unsigned*)((LAS unsigned char*)shm + ST_OFF); xcd_barrier(b_); } while (0)
    { P q = p; { size_t z_ = 0; asm volatile("" : "+s"(z_)); q.ws = p.ws + z_; } phase_prologue(q, lds); }
    { P q = p; { size_t z_ = 0; asm volatile("" : "+s"(z_)); q.ws = p.ws + z_; } phase_adaln(q, lds); }
    GRID_BAR();
    if (hw_tid() == 0) {
        unsigned cnt[16], dense = 0u, npop = 0u; const unsigned x = xb_xcc_id();
        for (unsigned j = 0; j < 16u; ++j) { cnt[j] = xb_ld((unsigned*)(p.ws + WS_CTL) + XB_XCNT(j)); if (cnt[j] > 0u) { if (j < x) ++dense; ++npop; } }
        unsigned base = 0u, total = 0u, k = 0u;
        for (unsigned j = 0; j < 16u; ++j) if (cnt[j] > 0u) { if ((k & 3u) == (dense & 3u)) { if (k < dense) base += cnt[j]; total += cnt[j]; } ++k; }
        st[6] = dense; st[7] = base; st[8] = (npop == 8u) ? total : 0u; }
    __syncthreads();
    { P q = p; { size_t z_ = 0; asm volatile("" : "+s"(z_)); q.ws = p.ws + z_; } phase_norm(q, 0, 0);
      for (int c = 256 + 120 + obid(); c < DEF_NCHUNK; c += ogrid()) { __syncthreads(); deferred_chunk(q, 0, c, lds); } }
    GRID_BAR();
    for (int l = 0; l < DEPTH; ++l) {
        { P q = p; { size_t z_ = 0; asm volatile("" : "+s"(z_)); q.ws = p.ws + z_; } phase_gemm_in(q, l, lds); }
        GRID_BAR();
        { P q = p; { size_t z_ = 0; asm volatile("" : "+s"(z_)); q.ws = p.ws + z_; } phase_conv(q, l); }
        { P q = p; { size_t z_ = 0; asm volatile("" : "+s"(z_)); q.ws = p.ws + z_; } phase_sgu(q, l, lds); }
        { P q = p; { size_t z_ = 0; asm volatile("" : "+s"(z_)); q.ws = p.ws + z_; } phase_na(q, l, lds); }
        GRID_BAR();
        { P q = p; { size_t z_ = 0; asm volatile("" : "+s"(z_)); q.ws = p.ws + z_; } phase_gemm_out(q, l, lds); }
        GRID_BAR();
        { P q = p; { size_t z_ = 0; asm volatile("" : "+s"(z_)); q.ws = p.ws + z_; } phase_gemm_q(q, l, lds); }
        GRID_BAR();
        { P q = p; { size_t z_ = 0; asm volatile("" : "+s"(z_)); q.ws = p.ws + z_; } phase_topk(q, l, lds); }
        GRID_BAR();
        { P q = p; { size_t z_ = 0; asm volatile("" : "+s"(z_)); q.ws = p.ws + z_; } phase_peer_u(q, l, lds); }
        GRID_BAR();
        { P q = p; { size_t z_ = 0; asm volatile("" : "+s"(z_)); q.ws = p.ws + z_; } phase_peer_w4(q, l); }
        GRID_BAR();
        { P q = p; { size_t z_ = 0; asm volatile("" : "+s"(z_)); q.ws = p.ws + z_; } phase_peer_v(q, l, lds); if (l + 1 < DEPTH) deferred_drain(q, l + 1, lds, 1 << 30); }
        GRID_BAR();
        if (l + 1 == DEPTH) { P q = p; { size_t z_ = 0; asm volatile("" : "+s"(z_)); q.ws = p.ws + z_; } phase_final(q); }
    }
}

extern "C" void kernel_launch(void* const* d_in, const int* in_sizes, int n_in, void* d_out, int out_size, void* d_ws, size_t ws_size, hipStream_t stream) {
    static int grid = 0;
    if (grid == 0) {
        if (n_in != 21 || ws_size < WS_END) { fprintf(stderr, "kernel_launch: expected 21 inputs and >= %zu bytes of workspace, got %d and %zu\n", (size_t)WS_END, n_in, ws_size); grid = -1; return; }
        int dev = 0, cus = 0, per_cu = 0;
        if (hipGetDevice(&dev) != hipSuccess || hipDeviceGetAttribute(&cus, hipDeviceAttributeMultiprocessorCount, dev) != hipSuccess || cus <= 0) cus = 256;
        if (hipFuncSetAttribute((const void*)k_mega, hipFuncAttributeMaxDynamicSharedMemorySize, LDS_BYTES) != hipSuccess) { fprintf(stderr, "kernel_launch: hipFuncSetAttribute failed\n"); grid = -1; return; }
        if (hipOccupancyMaxActiveBlocksPerMultiprocessor(&per_cu, (const void*)k_mega, NTHR, LDS_BYTES) != hipSuccess || per_cu < 1) { fprintf(stderr, "kernel_launch: occupancy query reports %d workgroups per CU\n", per_cu); per_cu = 1; }
        (void)hipGetLastError();
        grid = cus;
    }
    if (grid < 0) return;
    (void)hipMemsetAsync((unsigned char*)d_ws + WS_CTL, 0, 65536, stream);
    P p{};
    const float** pf = (const float**)&p;
    for (int i = 0; i < 21; ++i) pf[i] = (const float*)d_in[i];
    p.out = (float*)d_out; p.ws = (unsigned char*)d_ws;
    hipLaunchKernelGGL(k_mega, dim3(grid), dim3(NTHR), LDS_BYTES, stream, p);
}
```
